# Optimizing an MI355X kernel written in HIP

```python
import math
import jax, jax.numpy as jnp
from jax import lax
import numpy as np

D_MODEL = 1024
BATCH = 8
SEQ = 2048
DEPTH = 4
DEC_BATCH = 128
DEC_SEQ = 8
PAST_LEN = 16384
PAGE_SIZE = 128

D_SSM = D_MODEL // 2
SSM_GROUP = 16
SSM_GROUPS = D_SSM // SSM_GROUP
SSM_STATE = 64
RET_HEADS = 4
RET_DK = D_MODEL // (2 * RET_HEADS)
RET_DV = 2 * RET_DK
RET_CHUNK = 128
ROPE_BASE = 10000.0
D_FF = ((8 * D_MODEL // 3 + 127) // 128) * 128
CONV_W = 3
EPS = 1e-6
QK_W = RET_HEADS * RET_DK
V_W = RET_HEADS * RET_DV
IN_COLS = D_SSM + 2 * QK_W + 2 * V_W + 2 * D_MODEL
SPLITS = (D_SSM, D_SSM + QK_W, D_SSM + 2 * QK_W, D_SSM + 2 * QK_W + V_W,
          D_SSM + 2 * QK_W + 2 * V_W, D_SSM + 2 * QK_W + 2 * V_W + D_MODEL)

kernel_name = "hybrid_s5_retention_convffn_step"


def rmsnorm(x, g):
    xf = x.astype(jnp.float32)
    y = xf * lax.rsqrt(jnp.mean(xf * xf, axis=-1, keepdims=True) + EPS)
    return (y * g.astype(jnp.float32)).astype(x.dtype)


def rotary(x, pos):
    half = x.shape[-1] // 2
    inv = ROPE_BASE ** (-jnp.arange(half, dtype=jnp.float32) / half)
    ang = pos[:, None] * inv[None, :]
    cos = jnp.cos(ang)[None, :, None, :]
    sin = jnp.sin(ang)[None, :, None, :]
    xf = x.astype(jnp.float32)
    x1, x2 = xf[..., :half], xf[..., half:]
    return jnp.concatenate([x1 * cos - x2 * sin, x1 * sin + x2 * cos], axis=-1)


def s5_scan(u, s0, lam_re, lam_im, log_dt, b_re, b_im, c_re, c_im, d):
    bsz, L, _ = u.shape
    uf = u.astype(jnp.float32)
    ug = uf.reshape(bsz, L, SSM_GROUPS, SSM_GROUP)
    lam = lax.complex(lam_re.astype(jnp.float32), lam_im.astype(jnp.float32))
    dt = jnp.exp(log_dt.astype(jnp.float32))[:, None]
    lam_bar = jnp.exp(lam * dt)
    b = lax.complex(b_re.astype(jnp.float32), b_im.astype(jnp.float32))
    b_bar = ((lam_bar - 1.0) / lam)[..., None] * b
    bu = jnp.einsum('gpc,blgc->blgp', b_bar, ug.astype(jnp.complex64))
    bu = bu.at[:, 0].add(lam_bar[None] * s0)
    a = jnp.broadcast_to(lam_bar, bu.shape)

    def combine(e1, e2):
        a1, b1 = e1
        a2, b2 = e2
        return a1 * a2, a2 * b1 + b2

    _, s = lax.associative_scan(combine, (a, bu), axis=1)
    y = (jnp.einsum('gcp,blgp->blgc', c_re.astype(jnp.float32), jnp.real(s))
         - jnp.einsum('gcp,blgp->blgc', c_im.astype(jnp.float32), jnp.imag(s)))
    y = y.reshape(bsz, L, D_SSM) + d.astype(jnp.float32) * uf
    return y.astype(u.dtype), s[:, -1]


def retention(q, k, v, r0):
    bsz, L, H, dk = q.shape
    dv = v.shape[-1]
    c = RET_CHUNK if L % RET_CHUNK == 0 else L
    n = L // c
    log_g = jnp.log1p(-jnp.exp2(-5.0 - jnp.arange(H, dtype=jnp.float32)))
    idx = jnp.arange(c, dtype=jnp.float32)
    rel = idx[:, None] - idx[None, :]
    intra = jnp.where(rel >= 0, jnp.exp(jnp.maximum(rel, 0.0)[None] * log_g[:, None, None]), 0.0)
    inner = jnp.exp((idx[None, :] + 1.0) * log_g[:, None])
    tail = jnp.exp((c - 1.0 - idx[None, :]) * log_g[:, None])
    chunk_decay = jnp.exp(c * log_g)

    def to_chunks(t):
        return t.reshape(bsz, n, c, H, t.shape[-1]).transpose(1, 0, 3, 2, 4)

    qc, kc, vc = to_chunks(q), to_chunks(k), to_chunks(v.astype(jnp.float32))

    def step(r, inp):
        qi, ki, vi = inp
        sc = jnp.einsum('bhid,bhjd->bhij', qi, ki) * intra[None]
        o = (jnp.einsum('bhij,bhjv->bhiv', sc, vi)
             + jnp.einsum('bhid,bhdv->bhiv', qi, r) * inner[None, :, :, None])
        r_new = (r * chunk_decay[None, :, None, None]
                 + jnp.einsum('bhjd,bhjv->bhdv', ki * tail[None, :, :, None], vi))
        return r_new, o

    r, o = lax.scan(step, r0, (qc, kc, vc))
    o = o.transpose(1, 0, 3, 2, 4).reshape(bsz, L, H, dv)
    return o, r


def decoder_layer(x, pos, ssm_s0, ret_s0, conv_buf,
                  norm_mix, w_in, lam_re, lam_im, log_dt, b_re, b_im, c_re, c_im, d,
                  w_glu, w_ssm_out, w_ret_out, w_o, norm_ffn, w_up, conv_w, conv_b, w_down):
    bsz, L, _ = x.shape
    h = rmsnorm(x, norm_mix)
    z = h @ w_in
    u, q, k, v, g_ret, g_a, g_b = jnp.split(z, SPLITS, axis=-1)
    ya, ssm_last = s5_scan(u, ssm_s0, lam_re, lam_im, log_dt, b_re, b_im, c_re, c_im, d)
    ya = jax.nn.gelu(ya)
    ya = ya * jax.nn.sigmoid(ya @ w_glu)
    ya = ya @ w_ssm_out
    qr = rotary(q.reshape(bsz, L, RET_HEADS, RET_DK), pos)
    kr = rotary(k.reshape(bsz, L, RET_HEADS, RET_DK), pos) * (RET_DK ** -0.5)
    o, ret_last = retention(qr, kr, v.reshape(bsz, L, RET_HEADS, RET_DV), ret_s0)
    o = o * lax.rsqrt(jnp.mean(o * o, axis=-1, keepdims=True) + EPS)
    o = jax.nn.silu(g_ret) * o.reshape(bsz, L, V_W).astype(x.dtype)
    yb = o @ w_ret_out
    mix = jax.nn.sigmoid(g_a) * ya + jax.nn.sigmoid(g_b) * yb
    x = x + mix @ w_o
    h2 = rmsnorm(x, norm_ffn)
    up = h2 @ w_up
    hp = jnp.concatenate([conv_buf.astype(up.dtype), up], axis=1)
    hc = conv_b
    for j in range(CONV_W):
        hc = hc + conv_w[j] * hp[:, j:j + L]
    new_buf = hp[:, L:]
    val, gate = jnp.split(hc, 2, axis=-1)
    x = x + (jax.nn.silu(gate) * val) @ w_down
    return x, ssm_last, ret_last, new_buf


def setup_inputs(seed: int = 0) -> dict:
    key = jax.random.key(seed)
    ks = iter(jax.random.split(key, 32))

    def nrm(shape, scale):
        return scale * jax.random.normal(next(ks), shape, jnp.float32)

    L = DEPTH
    G, P = SSM_GROUPS, SSM_STATE
    x_prompt = nrm((BATCH, SEQ, D_MODEL), 1.0)
    x_sample = nrm((DEC_BATCH, DEC_SEQ, D_MODEL), 1.0)
    state_ssm_re = nrm((L, DEC_BATCH, G, P), 0.3)
    state_ssm_im = nrm((L, DEC_BATCH, G, P), 0.3)
    state_ret = nrm((L, DEC_BATCH, RET_HEADS, RET_DK, RET_DV), 0.5)
    state_conv = nrm((L, DEC_BATCH, CONV_W - 1, 2 * D_FF), 1.0)
    norm_mix = 1.0 + nrm((L, D_MODEL), 0.02)
    w_in = nrm((L, D_MODEL, IN_COLS), D_MODEL ** -0.5)
    ssm_lam_re = -0.5 + nrm((L, G, P), 0.01)
    ssm_lam_im = math.pi * jnp.arange(P, dtype=jnp.float32) + nrm((L, G, P), 0.01)
    ssm_log_dt = jax.random.uniform(next(ks), (L, G), jnp.float32, math.log(1e-3), math.log(1e-1))
    ssm_b_re = nrm((L, G, P, SSM_GROUP), (2 * SSM_GROUP) ** -0.5)
    ssm_b_im = nrm((L, G, P, SSM_GROUP), (2 * SSM_GROUP) ** -0.5)
    ssm_c_re = nrm((L, G, SSM_GROUP, P), (2 * P) ** -0.5)
    ssm_c_im = nrm((L, G, SSM_GROUP, P), (2 * P) ** -0.5)
    ssm_d = nrm((L, D_SSM), 0.5)
    w_glu = nrm((L, D_SSM, D_SSM), D_SSM ** -0.5)
    w_ssm_out = nrm((L, D_SSM, D_MODEL), D_SSM ** -0.5)
    w_ret_out = nrm((L, V_W, D_MODEL), V_W ** -0.5)
    w_o = nrm((L, D_MODEL, D_MODEL), D_MODEL ** -0.5)
    norm_ffn = 1.0 + nrm((L, D_MODEL), 0.02)
    w_up = nrm((L, D_MODEL, 2 * D_FF), D_MODEL ** -0.5)
    conv_w = nrm((L, CONV_W, 2 * D_FF), CONV_W ** -0.5)
    conv_b = nrm((L, 2 * D_FF), 0.02)
    w_down = nrm((L, D_FF, D_MODEL), D_FF ** -0.5)
    norm_final = 1.0 + nrm((D_MODEL,), 0.02)
    return {"x_prompt": x_prompt, "x_sample": x_sample,
            "state_ssm_re": state_ssm_re, "state_ssm_im": state_ssm_im,
            "state_ret": state_ret, "state_conv": state_conv,
            "norm_mix": norm_mix, "w_in": w_in,
            "ssm_lam_re": ssm_lam_re, "ssm_lam_im": ssm_lam_im, "ssm_log_dt": ssm_log_dt,
            "ssm_b_re": ssm_b_re, "ssm_b_im": ssm_b_im, "ssm_c_re": ssm_c_re, "ssm_c_im": ssm_c_im,
            "ssm_d": ssm_d, "w_glu": w_glu, "w_ssm_out": w_ssm_out, "w_ret_out": w_ret_out,
            "w_o": w_o, "norm_ffn": norm_ffn, "w_up": w_up, "conv_w": conv_w, "conv_b": conv_b,
            "w_down": w_down, "norm_final": norm_final}


def reference(x_prompt, x_sample, state_ssm_re, state_ssm_im, state_ret, state_conv,
              norm_mix, w_in, ssm_lam_re, ssm_lam_im, ssm_log_dt, ssm_b_re, ssm_b_im,
              ssm_c_re, ssm_c_im, ssm_d, w_glu, w_ssm_out, w_ret_out, w_o, norm_ffn,
              w_up, conv_w, conv_b, w_down, norm_final):
    pos_p = jnp.arange(SEQ, dtype=jnp.float32)
    pos_s = PAST_LEN + jnp.arange(DEC_SEQ, dtype=jnp.float32)
    bp = x_prompt.shape[0]
    xp, xs = x_prompt, x_sample
    ssm_re_p, ssm_im_p, ret_p, conv_p = [], [], [], []
    ssm_re_s, ssm_im_s, ret_s, conv_s = [], [], [], []
    for l in range(DEPTH):
        lw = (norm_mix[l], w_in[l], ssm_lam_re[l], ssm_lam_im[l], ssm_log_dt[l],
              ssm_b_re[l], ssm_b_im[l], ssm_c_re[l], ssm_c_im[l], ssm_d[l],
              w_glu[l], w_ssm_out[l], w_ret_out[l], w_o[l], norm_ffn[l],
              w_up[l], conv_w[l], conv_b[l], w_down[l])
        s0_p = jnp.zeros((bp, SSM_GROUPS, SSM_STATE), jnp.complex64)
        r0_p = jnp.zeros((bp, RET_HEADS, RET_DK, RET_DV), jnp.float32)
        c0_p = jnp.zeros((bp, CONV_W - 1, 2 * D_FF), xp.dtype)
        xp, sp, rp, cp = decoder_layer(xp, pos_p, s0_p, r0_p, c0_p, *lw)
        ssm_re_p.append(jnp.real(sp).astype(state_ssm_re.dtype))
        ssm_im_p.append(jnp.imag(sp).astype(state_ssm_im.dtype))
        ret_p.append(rp.astype(state_ret.dtype))
        conv_p.append(cp.astype(state_conv.dtype))
        s0_s = lax.complex(state_ssm_re[l].astype(jnp.float32), state_ssm_im[l].astype(jnp.float32))
        r0_s = state_ret[l].astype(jnp.float32)
        xs, ss, rs, cs = decoder_layer(xs, pos_s, s0_s, r0_s, state_conv[l], *lw)
        ssm_re_s.append(jnp.real(ss).astype(state_ssm_re.dtype))
        ssm_im_s.append(jnp.imag(ss).astype(state_ssm_im.dtype))
        ret_s.append(rs.astype(state_ret.dtype))
        conv_s.append(cs.astype(state_conv.dtype))
    y_prompt = rmsnorm(xp, norm_final)
    y_sample = rmsnorm(xs, norm_final)
    return (y_prompt, y_sample,
            jnp.stack(ssm_re_p), jnp.stack(ssm_im_p), jnp.stack(ret_p), jnp.stack(conv_p),
            jnp.stack(ssm_re_s), jnp.stack(ssm_im_s), jnp.stack(ret_s), jnp.stack(conv_s))
```

```cpp
#include <hip/hip_runtime.h>
#include <hip/hip_cooperative_groups.h>
#include <cstdio>
#include <cstdint>
namespace cg = cooperative_groups;

#ifndef USE_CG
#define USE_CG 0
#endif

#define LAS __attribute__((address_space(3)))
typedef unsigned short bf16_t;
typedef short bf16x8 __attribute__((ext_vector_type(8)));
typedef float f32x4 __attribute__((ext_vector_type(4)));
typedef float f32x16 __attribute__((ext_vector_type(16)));
typedef unsigned u32x4 __attribute__((ext_vector_type(4)));
typedef unsigned u32x2 __attribute__((ext_vector_type(2)));

constexpr int DM = 1024, MP = 16384, MS = 1024, MT = MP + MS, DEPTH = 4;
constexpr int INC = 5632, DFF = 2816, DSSM = 512;
constexpr int ZQ = 512, ZK = 1024, ZV = 1536, ZGR = 2560, ZGA = 3584, ZGB = 4608;
constexpr float EPSF = 1e-6f;
constexpr size_t O_YP = 0, O_YS = 16777216, O_SRP = 17825792, O_SIP = 17891328, O_RP = 17956864, O_CP = 22151168,
                 O_SRS = 22511616, O_SIS = 23560192, O_RS = 24608768, O_CS = 91717632;
constexpr size_t WS_CTL = 0;
constexpr size_t WS_WT = 65536;
constexpr size_t LW_IN = 0, LW_UP = 11534336, LW_DOWN = LW_UP + 11534336, LW_O = LW_DOWN + 5767168, LW_RET = LW_O + 2097152,
                 LW_SSM = LW_RET + 2097152, LW_GLU = LW_SSM + 2097152, LW_SIZE = LW_GLU + 524288;
constexpr size_t WS_S5T = WS_WT + 4 * LW_SIZE;
constexpr size_t S5_MB = 0, S5_BMT = 4194304, S5_CMT = S5_BMT + 131072, S5_LAM = S5_CMT + 131072, S5_LAM32 = S5_LAM + 16384, S5_SIZE = S5_LAM32 + 16384;
constexpr size_t WS_ROPE = WS_S5T + 4 * S5_SIZE;
constexpr size_t WS_X = WS_ROPE + 1052672;
constexpr size_t WS_H = WS_X + (size_t)MT * 1024 * 4;
constexpr size_t WS_Z = WS_H + (size_t)MT * 1024 * 2;
constexpr size_t WS_YA = WS_Z + (size_t)MT * INC * 2;
constexpr size_t WS_YA2 = WS_YA + (size_t)MT * 512 * 2;
constexpr size_t WS_O = WS_YA2 + (size_t)MT * 1024 * 2;
constexpr size_t WS_MIX = WS_O + (size_t)MT * 1024 * 2;
constexpr size_t WS_ACT = WS_MIX + (size_t)MT * 1024 * 2;
constexpr size_t WS_SIN = WS_ACT + (size_t)MT * DFF * 2;
constexpr size_t WS_RT = WS_SIN + (size_t)8 * 32 * 64 * 128 * 4;
constexpr size_t WS_E = WS_RT + (size_t)32 * 16 * 256 * 128 * 2;
constexpr size_t WS_END = WS_E + (size_t)8 * 32 * 8 * 128 * 4;

constexpr int LDS_BYTES = 147456;
constexpr int LDS_BARW = LDS_BYTES - 16;

#define GAS __attribute__((address_space(1)))
struct KP { const float* in[26]; float* out; unsigned char* ws; };
#if defined(__HIP_DEVICE_COMPILE__)
struct KPG { const GAS float* in[26]; GAS float* out; GAS unsigned char* ws; };
constexpr int LDS_TAB = LDS_BYTES - 16 - 256;
__device__ __forceinline__ unsigned long long ld_tab(const unsigned char* lds, int i) {
    unsigned off = (unsigned)(LDS_TAB + 8 * i); asm volatile("" : "+v"(off));
    const unsigned long long v = *(const LAS unsigned long long*)((const LAS unsigned char*)lds + off);
    const unsigned lo = __builtin_amdgcn_readfirstlane((unsigned)v), hi = __builtin_amdgcn_readfirstlane((unsigned)(v >> 32));
    return ((unsigned long long)hi << 32) | lo;
}
__device__ __forceinline__ KPG load_kp(const unsigned char* lds) {
    KPG q; asm volatile("" ::: "memory");
#pragma unroll
    for (int i = 0; i < 26; ++i) q.in[i] = (const GAS float*)ld_tab(lds, i);
    q.out = (GAS float*)ld_tab(lds, 26); q.ws = (GAS unsigned char*)ld_tab(lds, 27);
    return q;
}
__device__ __forceinline__ int fresh_tid() { int t = threadIdx.x; asm volatile("" : "+v"(t)); return t; }
__device__ __forceinline__ int fresh_bid() { int b = blockIdx.x; asm volatile("" : "+s"(b)); return b; }

__device__ __forceinline__ float bf2f(bf16_t b) { return __uint_as_float(((unsigned)b) << 16); }
__device__ __forceinline__ float bflo(unsigned w) { return __uint_as_float(w << 16); }
__device__ __forceinline__ float bfhi(unsigned w) { return __uint_as_float(w & 0xffff0000u); }
__device__ __forceinline__ bf16_t f2bf(float f) { unsigned u = __float_as_uint(f); u += 0x7FFFu + ((u >> 16) & 1u); return (bf16_t)(u >> 16); }
__device__ __forceinline__ unsigned pk2(float lo, float hi) { unsigned r; asm volatile("v_cvt_pk_bf16_f32 %0, %1, %2" : "=v"(r) : "v"(lo), "v"(hi)); return r; }
template <int CTRL> __device__ __forceinline__ float dppf(float x) { return __uint_as_float((unsigned)__builtin_amdgcn_update_dpp(0, (int)__float_as_uint(x), CTRL, 0xf, 0xf, false)); }
__device__ __forceinline__ float row_sum16(float x) {
    x += dppf<0xB1>(x); x += dppf<0x4E>(x); x += dppf<0x141>(x); x += dppf<0x140>(x); return x;
}
__device__ __forceinline__ float wave_sum(float v) {
    const float r = row_sum16(v);
    return (__builtin_amdgcn_readlane(r, 0) + __builtin_amdgcn_readlane(r, 16)) + (__builtin_amdgcn_readlane(r, 32) + __builtin_amdgcn_readlane(r, 48));
}
__device__ __forceinline__ float xor32(float x, int half) { const unsigned u = __float_as_uint(x); auto r = __builtin_amdgcn_permlane32_swap(u, u, false, false); return __uint_as_float(half ? r[0] : r[1]); }
__device__ __forceinline__ float sigmoidf_(float x) { return __builtin_amdgcn_rcpf(1.0f + __expf(-x)); }
__device__ __forceinline__ float siluf_(float x) { return x * __builtin_amdgcn_rcpf(1.0f + __expf(-x)); }
__device__ __forceinline__ float gelu_tanh(float x) { const float u = 0.7978845608028654f * (x + 0.044715f * x * x * x); return x * __builtin_amdgcn_rcpf(1.0f + __expf(-2.0f * u)); }
__device__ __forceinline__ void sincos_rev(float rev, float& s, float& c) {
    const float f = rev - rintf(rev);
    s = __builtin_amdgcn_sinf(f); c = __builtin_amdgcn_cosf(f);
}
#define LDS_WAIT() asm volatile("s_waitcnt lgkmcnt(0)" ::: "memory")
#define MFMA16(a, b, c) __builtin_amdgcn_mfma_f32_16x16x32_bf16((a), (b), (c), 0, 0, 0)
#define MFMA32(a, b, c) __builtin_amdgcn_mfma_f32_32x32x16_bf16((a), (b), (c), 0, 0, 0)
#define MFMA_SETTLE() do { __builtin_amdgcn_sched_barrier(0); asm volatile("s_nop 15\n\ts_nop 15\n\ts_nop 15\n\ts_nop 15" ::: "memory"); __builtin_amdgcn_sched_barrier(0); } while (0)

#define XB_TMO      128
#define XB_XCNT(j)  (256  + 64 * (j))
#define XB_XSUB(j)  (1280 + 64 * (j))
#define XB_XGEN(j)  (2304 + 64 * (j))
#define XB_TOP      3328
#define XB_TOPGEN   3392
#define XCD_BAR_WORDS 3456
#define XB_SPIN_CAP (1u << 22)
__device__ __forceinline__ unsigned xb_ld(unsigned* p)              { return __hip_atomic_load(p, __ATOMIC_RELAXED, __HIP_MEMORY_SCOPE_AGENT); }
__device__ __forceinline__ unsigned xb_add(unsigned* p, unsigned v) { return __hip_atomic_fetch_add(p, v, __ATOMIC_RELAXED, __HIP_MEMORY_SCOPE_AGENT); }
__device__ __forceinline__ unsigned xb_xcc_id() { return (unsigned)__builtin_amdgcn_s_getreg((3 << 11) | 20) & 0xFu; }
#define XB_SPIN(cond, bar) do { unsigned _sp = 0; while (cond) { __builtin_amdgcn_s_sleep(1); \
    if ((++_sp & 255u) == 0u) { if (xb_ld(&(bar)[XB_TMO])) break; if (_sp > XB_SPIN_CAP) { atomicAdd(&(bar)[XB_TMO], 1u); break; } } } } while (0)
struct XcdBarrier { unsigned* bar; unsigned x; volatile LAS unsigned* st; };
__device__ __forceinline__ XcdBarrier xcd_barrier_post(unsigned* bar, volatile LAS unsigned* st) {
    XcdBarrier b; b.bar = bar; b.x = xb_xcc_id(); b.st = st;
    if (threadIdx.x == 0) (void)xb_add(&bar[XB_XCNT(b.x)], 1u);
    return b;
}
__device__ __forceinline__ void xcd_barrier_complete(unsigned* bar, unsigned x, unsigned& nloc, unsigned& nx) {
    const unsigned G = gridDim.x * gridDim.y * gridDim.z;
    unsigned sum, cnt, mine, sp = 0u;
    for (;;) {
        sum = 0u; cnt = 0u; mine = 0u;
#pragma unroll
        for (unsigned j = 0; j < 16; ++j) { const unsigned c = xb_ld(&bar[XB_XCNT(j)]); sum += c; cnt += (c > 0u) ? 1u : 0u; mine = (j == x) ? c : mine; }
        if (sum == G) break;
        __builtin_amdgcn_s_sleep(1);
        if ((++sp & 255u) == 0u) { if (xb_ld(&bar[XB_TMO])) break; if (sp > XB_SPIN_CAP) { atomicAdd(&bar[XB_TMO], 1u); break; } }
    }
    nloc = mine > 0u ? mine : 1u; nx = cnt > 0u ? cnt : 1u;
}
__device__ __forceinline__ void xcd_barrier(const XcdBarrier& b) {
    asm volatile("s_waitcnt vmcnt(0)" ::: "memory");
    __syncthreads();
    if (threadIdx.x == 0) {
        unsigned* bar = b.bar;
        __builtin_amdgcn_s_waitcnt(0);
        unsigned nloc = b.st[0], nx = b.st[1];
        if (nloc == 0u) { xcd_barrier_complete(bar, b.x, nloc, nx); b.st[0] = nloc; b.st[1] = nx; }
        const unsigned old = xb_add(&bar[XB_XSUB(b.x)], 1u);
        const unsigned gen = old / nloc;
        if (old + 1u == (gen + 1u) * nloc) {
            __builtin_amdgcn_fence(__ATOMIC_RELEASE, "agent");
            asm volatile("s_waitcnt vmcnt(0)" ::: "memory");
            const unsigned og = xb_add(&bar[XB_TOP], 1u);
            const unsigned tg = og / nx;
            if (og + 1u == (tg + 1u) * nx) xb_add(&bar[XB_TOPGEN], 1u);
            else XB_SPIN(xb_ld(&bar[XB_TOPGEN]) == tg, bar);
            __builtin_amdgcn_fence(__ATOMIC_ACQUIRE, "agent");
            xb_add(&bar[XB_XGEN(b.x)], 1u);
            asm volatile("s_waitcnt vmcnt(0)" ::: "memory");
        } else {
            XB_SPIN(xb_ld(&bar[XB_XGEN(b.x)]) == gen, bar);
            __builtin_amdgcn_fence(__ATOMIC_ACQUIRE, "agent");
            asm volatile("s_waitcnt vmcnt(0)" ::: "memory");
        }
    }
    __syncthreads();
}

namespace pg8 {
constexpr int BM = 256, BK = 64, HALF = 128, HTB = HALF * BK * 2, STAGE_BYTES = 8 * HTB, NXCD = 8, WGM = 8;
__device__ __forceinline__ int lds_byte(int r, int c) { const int st = (r >> 4) * 2 + (c >> 5), rr = r & 15, cc = c & 31, ob = rr * 64 + cc * 2; return st * 1024 + (ob ^ (((ob >> 9) & 1) << 5)); }
__device__ __forceinline__ void stage_rc(int b, int& R, int& C) { const int st = b / 1024, sb = b % 1024, swz = sb ^ (((sb >> 9) & 1) << 5); R = (st >> 1) * 16 + swz / 64; C = (st & 1) * 32 + (swz % 64) / 2; }
__device__ __forceinline__ int perm32(int rho) { const int n = rho >> 4, i = rho & 15; return 8 * (i >> 2) + 4 * n + (i & 3); }

struct Unit { const char* A; const char* B; int nt, mode, pm, pn; };
struct Sched {
    const char *A0, *B0, *A1, *B1; int nt0, nt1, ld, nM, nN, G, c;
    __device__ __forceinline__ bool next(int i, Unit& u) const {
        const int dual = (A1 != nullptr) ? 1 : 0; const int ti = dual ? (i >> 1) : i, sub = dual ? (i & 1) : 0;
        const int nwg = nM * nN; const long L = (long)ti * G + c; if (L >= nwg) return false;
        int wgid = (int)L; { const int q = nwg / NXCD, r = nwg % NXCD, xcd = wgid % NXCD, off = wgid / NXCD; wgid = (xcd < r ? xcd * (q + 1) : r * (q + 1) + (xcd - r) * q) + off; }
        const int nig = WGM * nN, gid = wgid / nig, fm = gid * WGM, gsz = (nM - fm) < WGM ? (nM - fm) : WGM;
        u.pm = fm + ((wgid % nig) % gsz); u.pn = (wgid % nig) / gsz;
        const size_t tstep = (size_t)BM * ld * 2;
        u.A = (sub ? A1 : A0) + (size_t)u.pm * tstep; u.B = (sub ? B1 : B0) + (size_t)u.pn * tstep; u.nt = sub ? nt1 : nt0; u.mode = dual ? (sub ? 2 : 1) : 0;
        return true;
    }
};
typedef f32x4 Acc[2][2][4][2];

template <class Epi>
__device__ __forceinline__ void gemm_phase(LAS unsigned char* lds, const Sched& S, const Epi& E) {
    const int tid = fresh_tid(), wid = __builtin_amdgcn_readfirstlane(tid >> 6), lane = tid & 63, wr = wid >> 2, wc = wid & 3, fr = lane & 15, fq = lane >> 4;
    const int ld = S.ld;
    unsigned voffA[2], voffB[2];
#pragma unroll
    for (int i = 0; i < 2; ++i) { int R, C; stage_rc(tid * 16 + i * 8192, R, C); const int Rb = (R & ~31) + perm32(R & 31);
        voffA[i] = (unsigned)(R * ld + C) * 2u; voffB[i] = (unsigned)(Rb * ld + C) * 2u; }
    const size_t kstep = (size_t)(BK * 2);
    const size_t hstep = (size_t)HALF * ld * 2;
    const unsigned ldsw = (unsigned)wid * 1024u;
    const int aoff = lds_byte(wr * 64 + fr, fq * 8), boff = lds_byte(wc * 32 + fr, fq * 8);
#define PG8_SA(b, h) (((b) * 2 + (h)) * HTB)
#define PG8_SB(b, h) ((4 + (b) * 2 + (h)) * HTB)
#define PG8_STAGE(bufoff, gbase, voff) do { _Pragma("unroll") for (int _i = 0; _i < 2; ++_i) \
        __builtin_amdgcn_global_load_lds((const unsigned*)((const char*)(gbase) + (voff)[_i]), (LAS unsigned*)(lds + (bufoff) + ldsw + _i * 8192), 16, 0, 0); } while (0)
#define PG8_LDA(dst, b, h) do { _Pragma("unroll") for (int m = 0; m < 4; ++m) _Pragma("unroll") for (int k = 0; k < 2; ++k) dst[m][k] = *(const LAS bf16x8*)(lds + PG8_SA(b, h) + aoff + m * 2048 + k * 1024); } while (0)
#define PG8_LDB(dst, b, h) do { _Pragma("unroll") for (int n = 0; n < 2; ++n) _Pragma("unroll") for (int k = 0; k < 2; ++k) dst[n][k] = *(const LAS bf16x8*)(lds + PG8_SB(b, h) + boff + n * 2048 + k * 1024); } while (0)
#define PG8_MMA(ai, bj, At, Bt) do { __builtin_amdgcn_s_setprio(1); _Pragma("unroll") for (int m = 0; m < 4; ++m) _Pragma("unroll") for (int n = 0; n < 2; ++n) _Pragma("unroll") for (int k = 0; k < 2; ++k) \
        acc[ai][bj][m][n] = __builtin_amdgcn_mfma_f32_16x16x32_bf16(Bt[n][k], At[m][k], acc[ai][bj][m][n], 0, 0, 0); __builtin_amdgcn_s_setprio(0); } while (0)
#define PG8_WAIT_V(n) asm volatile("s_waitcnt vmcnt(" #n ")" ::: "memory")
#define PG8_WAIT_L(n) asm volatile("s_waitcnt lgkmcnt(" #n ")" ::: "memory")
#define PG8_BAR __builtin_amdgcn_s_barrier()
#define PG8_SCHED __builtin_amdgcn_sched_barrier(0)
    Unit cur, nxt; int ui = 0;
    if (!S.next(0, cur)) return;
    Acc acc;
#pragma unroll
    for (int a = 0; a < 2; ++a)
#pragma unroll
        for (int b = 0; b < 2; ++b)
#pragma unroll
            for (int m = 0; m < 4; ++m)
#pragma unroll
                for (int n = 0; n < 2; ++n) acc[a][b][m][n] = (f32x4){0.f, 0.f, 0.f, 0.f};
    bf16x8 At[4][2], B0[2][2], B1[2][2];
    const char* cA = cur.A; const char* cB = cur.B;
    PG8_STAGE(PG8_SB(0, 0), cB, voffB); PG8_STAGE(PG8_SA(0, 0), cA, voffA); PG8_STAGE(PG8_SB(0, 1), cB + hstep, voffB); PG8_STAGE(PG8_SA(0, 1), cA + hstep, voffA);
    if (wr == 1) PG8_BAR;
    PG8_WAIT_V(4); PG8_BAR;
    PG8_STAGE(PG8_SB(1, 0), cB + kstep, voffB); PG8_STAGE(PG8_SA(1, 0), cA + kstep, voffA); PG8_STAGE(PG8_SB(1, 1), cB + hstep + kstep, voffB);
    PG8_WAIT_V(6); PG8_BAR;
    for (;;) {
        const bool has_next = S.next(ui + 1, nxt);
        const char* nA = has_next ? nxt.A : cA; const char* nB = has_next ? nxt.B : cB;
        const int nt = cur.nt;
        for (int t = 0; t < nt; t += 2) {
            const bool last = (t == nt - 2);
            const char* a1 = cA + (size_t)(t + 1) * kstep;
            const char* a2 = last ? nA : cA + (size_t)(t + 2) * kstep; const char* b2 = last ? nB : cB + (size_t)(t + 2) * kstep;
            const char* a3 = a2 + kstep; const char* b3 = b2 + kstep;
            PG8_LDB(B0, 0, 0); PG8_SCHED; PG8_LDA(At, 0, 0); PG8_STAGE(PG8_SA(1, 1), a1 + hstep, voffA);
            PG8_WAIT_L(8); PG8_BAR; PG8_WAIT_L(0); PG8_MMA(0, 0, At, B0); PG8_BAR; PG8_SCHED;
            PG8_LDB(B1, 0, 1); PG8_STAGE(PG8_SB(0, 0), b2, voffB);
            PG8_BAR; PG8_WAIT_L(0); PG8_MMA(0, 1, At, B1); PG8_BAR;
            PG8_LDA(At, 0, 1); PG8_STAGE(PG8_SA(0, 0), a2, voffA);
            PG8_BAR; PG8_WAIT_L(0); PG8_MMA(1, 0, At, B0); PG8_BAR; PG8_SCHED;
            PG8_STAGE(PG8_SB(0, 1), b2 + hstep, voffB);
            PG8_WAIT_V(6); PG8_BAR; PG8_MMA(1, 1, At, B1); PG8_BAR;
            PG8_LDB(B0, 1, 0); PG8_SCHED; PG8_LDA(At, 1, 0); PG8_STAGE(PG8_SA(0, 1), a2 + hstep, voffA);
            PG8_WAIT_L(8); PG8_BAR; PG8_WAIT_L(0); PG8_MMA(0, 0, At, B0); PG8_BAR; PG8_SCHED;
            PG8_LDB(B1, 1, 1); PG8_STAGE(PG8_SB(1, 0), b3, voffB);
            PG8_BAR; PG8_WAIT_L(0); PG8_MMA(0, 1, At, B1); PG8_BAR;
            PG8_LDA(At, 1, 1); PG8_STAGE(PG8_SA(1, 0), a3, voffA);
            PG8_BAR; PG8_WAIT_L(0); PG8_MMA(1, 0, At, B0); PG8_BAR; PG8_SCHED;
            PG8_STAGE(PG8_SB(1, 1), b3 + hstep, voffB);
            PG8_WAIT_V(6); PG8_BAR; PG8_MMA(1, 1, At, B1); PG8_BAR;
        }
        MFMA_SETTLE();
        E(acc, cur, wr, wc, fr, fq);
        if (!has_next) break;
        if (cur.mode != 1) {
#pragma unroll
            for (int a = 0; a < 2; ++a)
#pragma unroll
                for (int b = 0; b < 2; ++b)
#pragma unroll
                    for (int m = 0; m < 4; ++m)
#pragma unroll
                        for (int n = 0; n < 2; ++n) acc[a][b][m][n] = (f32x4){0.f, 0.f, 0.f, 0.f};
        }
        cur = nxt; cA = nA; cB = nB; ++ui;
    }
    PG8_WAIT_V(0);
    if (wr == 0) PG8_BAR;
    PG8_BAR;
#undef PG8_SA
#undef PG8_SB
#undef PG8_STAGE
#undef PG8_LDA
#undef PG8_LDB
#undef PG8_MMA
#undef PG8_WAIT_V
#undef PG8_WAIT_L
#undef PG8_BAR
#undef PG8_SCHED
}

#define EPI_ROWS_BEGIN \
    _Pragma("unroll") for (int ai = 0; ai < 2; ++ai) _Pragma("unroll") for (int m = 0; m < 4; ++m) { const int row = u.pm * 256 + ai * 128 + wr * 64 + m * 16 + fr; \
    _Pragma("unroll") for (int bj = 0; bj < 2; ++bj) { const int col = u.pn * 256 + bj * 128 + wc * 32 + 8 * fq; f32x4& v0 = acc[ai][bj][m][0]; f32x4& v1 = acc[ai][bj][m][1];
#define EPI_ROWS_END } __builtin_amdgcn_sched_barrier(0); }

struct EpiStoreBf16 {
    bf16_t* O; int ldc;
    __device__ __forceinline__ void operator()(Acc& acc, const Unit& u, int wr, int wc, int fr, int fq) const {
        EPI_ROWS_BEGIN
            u32x4 w; w.x = pk2(v0[0], v0[1]); w.y = pk2(v0[2], v0[3]); w.z = pk2(v1[0], v1[1]); w.w = pk2(v1[2], v1[3]);
            *(u32x4*)(O + (size_t)row * ldc + col) = w;
        EPI_ROWS_END
    }
};
struct EpiGlu {
    const bf16_t* ya; bf16_t* ya2;
    __device__ __forceinline__ void operator()(Acc& acc, const Unit& u, int wr, int wc, int fr, int fq) const {
        EPI_ROWS_BEGIN
            const u32x4 y = *(const u32x4*)(ya + (size_t)row * 512 + col);
            u32x4 w;
            w.x = pk2(bflo(y.x) * sigmoidf_(v0[0]), bfhi(y.x) * sigmoidf_(v0[1]));
            w.y = pk2(bflo(y.y) * sigmoidf_(v0[2]), bfhi(y.y) * sigmoidf_(v0[3]));
            w.z = pk2(bflo(y.z) * sigmoidf_(v1[0]), bfhi(y.z) * sigmoidf_(v1[1]));
            w.w = pk2(bflo(y.w) * sigmoidf_(v1[2]), bfhi(y.w) * sigmoidf_(v1[3]));
            *(u32x4*)(ya2 + (size_t)row * 1024 + col) = w;
        EPI_ROWS_END
    }
};
struct EpiMix {
    const bf16_t* z; bf16_t* mix;
    __device__ __forceinline__ void operator()(Acc& acc, const Unit& u, int wr, int wc, int fr, int fq) const {
        if (u.mode == 1) {
            EPI_ROWS_BEGIN
                const u32x4 ga = *(const u32x4*)(z + (size_t)row * INC + ZGA + col);
                const u32x4 gb = *(const u32x4*)(z + (size_t)row * INC + ZGB + col);
#define RATIO(a, b) ((1.0f + __expf(-(b))) * __builtin_amdgcn_rcpf(1.0f + __expf(-(a))))
                v0[0] *= RATIO(bflo(ga.x), bflo(gb.x)); v0[1] *= RATIO(bfhi(ga.x), bfhi(gb.x));
                v0[2] *= RATIO(bflo(ga.y), bflo(gb.y)); v0[3] *= RATIO(bfhi(ga.y), bfhi(gb.y));
                v1[0] *= RATIO(bflo(ga.z), bflo(gb.z)); v1[1] *= RATIO(bfhi(ga.z), bfhi(gb.z));
                v1[2] *= RATIO(bflo(ga.w), bflo(gb.w)); v1[3] *= RATIO(bfhi(ga.w), bfhi(gb.w));
#undef RATIO
            EPI_ROWS_END
        } else {
            EPI_ROWS_BEGIN
                const u32x4 gb = *(const u32x4*)(z + (size_t)row * INC + ZGB + col);
                u32x4 w;
                w.x = pk2(v0[0] * sigmoidf_(bflo(gb.x)), v0[1] * sigmoidf_(bfhi(gb.x)));
                w.y = pk2(v0[2] * sigmoidf_(bflo(gb.y)), v0[3] * sigmoidf_(bfhi(gb.y)));
                w.z = pk2(v1[0] * sigmoidf_(bflo(gb.z)), v1[1] * sigmoidf_(bfhi(gb.z)));
                w.w = pk2(v1[2] * sigmoidf_(bflo(gb.w)), v1[3] * sigmoidf_(bfhi(gb.w)));
                *(u32x4*)(mix + (size_t)row * 1024 + col) = w;
            EPI_ROWS_END
        }
    }
};
struct EpiRes {
    const float* xinP; const float* xinS; float* xout;
    __device__ __forceinline__ void operator()(Acc& acc, const Unit& u, int wr, int wc, int fr, int fq) const {
        EPI_ROWS_BEGIN
            const float* xi = (row < MP ? xinP + (size_t)row * 1024 : xinS + (size_t)(row - MP) * 1024) + col;
            const f32x4 a = *(const f32x4*)xi, b = *(const f32x4*)(xi + 4);
            float* xo = xout + (size_t)row * 1024 + col;
            *(f32x4*)xo = a + v0; *(f32x4*)(xo + 4) = b + v1;
        EPI_ROWS_END
    }
};
struct EpiUp {
    bf16_t* up; float* convP; float* convS;
    __device__ __forceinline__ void operator()(Acc& acc, const Unit& u, int wr, int wc, int fr, int fq) const {
        EPI_ROWS_BEGIN
            u32x4 w; w.x = pk2(v0[0], v0[1]); w.y = pk2(v0[2], v0[3]); w.z = pk2(v1[0], v1[1]); w.w = pk2(v1[2], v1[3]);
            *(u32x4*)(up + (size_t)row * INC + col) = w;
            float* cp = nullptr;
            if (row < MP) { const int t = row & 2047; if (t >= 2046) cp = convP + ((size_t)((row >> 11) * 2 + (t - 2046))) * INC + col; }
            else { const int r2 = row - MP, t = r2 & 7; if (t >= 6) cp = convS + ((size_t)((r2 >> 3) * 2 + (t - 6))) * INC + col; }
            if (cp) { *(f32x4*)cp = v0; *(f32x4*)(cp + 4) = v1; }
        EPI_ROWS_END
    }
};
}

__device__ __forceinline__ void transpose_item(const float* W, int K, int N, bf16_t* WT, int ldd, const float* gk, float* scr, int item, int lane) {
    const int nblk = N / 32, kb = item / nblk, nb = item % nblk, k0 = 64 * kb, n0 = 32 * nb;
#pragma unroll 8
    for (int i = 0; i < 32; ++i) { const int kk = 2 * i + (lane >> 5); float v = W[(size_t)(k0 + kk) * N + n0 + (lane & 31)]; if (gk) v *= gk[k0 + kk]; scr[kk * 33 + (lane & 31)] = v; }
    LDS_WAIT();
    const int c = lane & 7;
#pragma unroll
    for (int j = 0; j < 4; ++j) { const int n = (lane >> 3) + 8 * j; const float* s = scr + (8 * c) * 33 + n;
        u32x4 o; o.x = pk2(s[0 * 33], s[1 * 33]); o.y = pk2(s[2 * 33], s[3 * 33]); o.z = pk2(s[4 * 33], s[5 * 33]); o.w = pk2(s[6 * 33], s[7 * 33]);
        *(u32x4*)(WT + (size_t)(n0 + n) * ldd + k0 + 8 * c) = o; }
    LDS_WAIT();
}

__device__ __forceinline__ void rms_row_to_bf16(const float* xrow, bf16_t* orow, int lane) {
    const f32x4* xr = (const f32x4*)xrow + lane;
    f32x4 v[4]; float s = 0.f;
#pragma unroll
    for (int j = 0; j < 4; ++j) { v[j] = xr[64 * j]; s += (v[j].x * v[j].x + v[j].y * v[j].y) + (v[j].z * v[j].z + v[j].w * v[j].w); }
    const float rstd = rsqrtf(wave_sum(s) * (1.f / 1024.f) + EPSF);
    u32x2* o8 = (u32x2*)orow + lane;
#pragma unroll
    for (int j = 0; j < 4; ++j) { u32x2 w; w.x = pk2(v[j].x * rstd, v[j].y * rstd); w.y = pk2(v[j].z * rstd, v[j].w * rstd); o8[64 * j] = w; }
}

__device__ __forceinline__ void phase_rmsnorm(const KPG& p, int l, int wave, int lane) {
    const float* xb = (const float*)(p.ws + WS_X); bf16_t* h = (bf16_t*)(p.ws + WS_H);
    for (int row = fresh_bid() * 8 + wave; row < MT; row += gridDim.x * 8) {
        const float* xr = (l == 0) ? (row < MP ? p.in[0] + (size_t)row * 1024 : p.in[1] + (size_t)(row - MP) * 1024) : xb + (size_t)row * 1024;
        rms_row_to_bf16(xr, h + (size_t)row * 1024, lane);
    }
}

__device__ __forceinline__ void phase_prologue(const KPG& p, int l, unsigned char* lds, int wave, int lane) {
    float* scr = (float*)(lds + wave * 8448);
    const int gw = fresh_bid() * 8 + wave, NGW = gridDim.x * 8;
    constexpr int I_IN = 16 * 176, I_UP = 16 * 176, I_DN = 44 * 32, I_O = 16 * 32, I_RET = 16 * 32, I_SSM = 8 * 32, I_GLU = 8 * 16;
    constexpr int I_L = I_IN + I_UP + I_DN + I_O + I_RET + I_SSM + I_GLU;
    for (int it = gw; it < I_L; it += NGW) {
        int r = it;
        unsigned char* wl = p.ws + WS_WT + (size_t)l * LW_SIZE;
        if (r < I_IN) { transpose_item(p.in[7] + (size_t)l * 1024 * INC, 1024, INC, (bf16_t*)(wl + LW_IN), 1024, p.in[6] + l * 1024, scr, r, lane); continue; } r -= I_IN;
        if (r < I_UP) { transpose_item(p.in[21] + (size_t)l * 1024 * INC, 1024, INC, (bf16_t*)(wl + LW_UP), 1024, p.in[20] + l * 1024, scr, r, lane); continue; } r -= I_UP;
        if (r < I_DN) { transpose_item(p.in[24] + (size_t)l * DFF * 1024, DFF, 1024, (bf16_t*)(wl + LW_DOWN), DFF, nullptr, scr, r, lane); continue; } r -= I_DN;
        if (r < I_O) { transpose_item(p.in[19] + (size_t)l * 1024 * 1024, 1024, 1024, (bf16_t*)(wl + LW_O), 1024, nullptr, scr, r, lane); continue; } r -= I_O;
        if (r < I_RET) { transpose_item(p.in[18] + (size_t)l * 1024 * 1024, 1024, 1024, (bf16_t*)(wl + LW_RET), 1024, nullptr, scr, r, lane); continue; } r -= I_RET;
        if (r < I_SSM) { transpose_item(p.in[17] + (size_t)l * 512 * 1024, 512, 1024, (bf16_t*)(wl + LW_SSM), 1024, nullptr, scr, r, lane); continue; } r -= I_SSM;
        transpose_item(p.in[16] + (size_t)l * 512 * 512, 512, 512, (bf16_t*)(wl + LW_GLU), 512, nullptr, scr, r, lane);
    }
    const int gt = fresh_bid() * 512 + fresh_tid(), NGT = gridDim.x * 512;
    for (int it = gt; it < 32 * 64; it += NGT) {
        const int pp = it & 63, g = (it >> 6) & 31;
        const int gi = l * 32 + g, pi = gi * 64 + pp;
        const float dt = __expf(p.in[10][gi]), lr = p.in[8][pi], li = p.in[9][pi];
        float s1, c1; sincos_rev(li * dt * 0.15915494309189535f, s1, c1);
        const float m1 = __expf(lr * dt); const float lbr = m1 * c1, lbi = m1 * s1;
        const float nr = lbr - 1.0f, ni = lbi, den = 1.0f / (lr * lr + li * li);
        const float cr = (nr * lr + ni * li) * den, ci = (ni * lr - nr * li) * den;
        unsigned char* st = p.ws + WS_S5T + (size_t)l * S5_SIZE;
        const float* bre = p.in[11] + (size_t)pi * 16; const float* bim = p.in[12] + (size_t)pi * 16;
        bf16_t* bmre = (bf16_t*)(st + S5_BMT) + (size_t)(g * 128 + pp) * 16; bf16_t* bmim = (bf16_t*)(st + S5_BMT) + (size_t)(g * 128 + 64 + pp) * 16;
#pragma unroll
        for (int c = 0; c < 16; ++c) { const float br = bre[c], bi = bim[c]; bmre[c] = f2bf(cr * br - ci * bi); bmim[c] = f2bf(cr * bi + ci * br); }
        float2* lam = (float2*)(st + S5_LAM) + g * 64 + pp; *lam = make_float2(lbr, lbi);
        float s32, c32; sincos_rev(32.0f * li * dt * 0.15915494309189535f, s32, c32); const float m32 = __expf(32.0f * lr * dt);
        float2* lam32 = (float2*)(st + S5_LAM32) + g * 64 + pp; *lam32 = make_float2(m32 * c32, m32 * s32);
    }
    for (int it = gt; it < 32 * 16 * 128; it += NGT) {
        const int pq = it & 127, c = (it >> 7) & 15, g = (it >> 11) & 31;
        const size_t src = ((size_t)((l * 32 + g) * 16 + c)) * 64 + (pq & 63);
        const float v = pq < 64 ? p.in[13][src] : -p.in[14][src];
        ((bf16_t*)(p.ws + WS_S5T + (size_t)l * S5_SIZE + S5_CMT))[(g * 16 + c) * 128 + pq] = f2bf(v);
    }
    if (l == 0) for (int it = gt; it < 2056 * 64; it += NGT) {
        const int j = it & 63, pi = it >> 6; const double pos = (double)(pi < 2048 ? pi : 16384 + pi - 2048);
        double inv = 1.0, r = 0.86596432336006535;
        int e = j;
#pragma unroll
        for (int b = 0; b < 6; ++b) { if (e & 1) inv *= r; r *= r; e >>= 1; }
        const double rev = pos * inv * 0.15915494309189535; const double fr_ = rev - __builtin_rint(rev);
        const float f = (float)fr_;
        ((float2*)(p.ws + WS_ROPE))[it] = make_float2(__builtin_amdgcn_cosf(f), __builtin_amdgcn_sinf(f));
    }
}

template <bool SAMPLE>
__device__ __forceinline__ void s5_tile(const KPG& p, int l, int g, int row0, int bseq, int chunk, bf16_t* Sl, int lane) {
    const bf16_t* z = (const bf16_t*)(p.ws + WS_Z); bf16_t* ya = (bf16_t*)(p.ws + WS_YA);
    const unsigned char* st = p.ws + WS_S5T + (size_t)l * S5_SIZE;
    const int half = lane >> 5, li = lane & 31;
    const bf16x8 uf = *(const bf16x8*)(z + (size_t)(row0 + li) * INC + g * 16 + 8 * half);
    f32x16 acc[4];
#pragma unroll
    for (int ct = 0; ct < 4; ++ct) {
        const bf16x8 bfr = *(const bf16x8*)((const bf16_t*)(st + S5_BMT) + (size_t)(g * 128 + ct * 32 + li) * 16 + 8 * half);
        f32x16 zz;
#pragma unroll
        for (int e = 0; e < 16; ++e) zz[e] = 0.f;
        acc[ct] = MFMA32(uf, bfr, zz);
    }
    MFMA_SETTLE();
    float2 lm[2]; lm[0] = ((const float2*)(st + S5_LAM))[g * 64 + li]; lm[1] = ((const float2*)(st + S5_LAM))[g * 64 + 32 + li];
    float sr[2] = {0.f, 0.f}, si[2] = {0.f, 0.f};
    const float* sin_ = (const float*)(p.ws + WS_SIN);
#pragma unroll
    for (int k = 0; k < 4; ++k) {
        if (SAMPLE || k == 0) {
#pragma unroll
            for (int pt = 0; pt < 2; ++pt) {
                if (SAMPLE) { const size_t o = ((size_t)((l * 128 + bseq + k) * 32 + g)) * 64 + pt * 32 + li; sr[pt] = p.in[2][o]; si[pt] = p.in[3][o]; }
                else {
                    const int sc = chunk >> 3, jj = chunk & 7;
                    const float2 l32 = ((const float2*)(st + S5_LAM32))[g * 64 + pt * 32 + li];
                    const float2 l64 = make_float2(l32.x * l32.x - l32.y * l32.y, 2.0f * l32.x * l32.y);
                    const float2 l128 = make_float2(l64.x * l64.x - l64.y * l64.y, 2.0f * l64.x * l64.y);
                    const float2 l256 = make_float2(l128.x * l128.x - l128.y * l128.y, 2.0f * l128.x * l128.y);
                    const float* Eb = (const float*)(p.ws + WS_E) + ((size_t)((bseq * 32 + g) * 8)) * 128 + pt * 32 + li;
                    float Sr = 0.f, Si = 0.f;
#pragma unroll
                    for (int i = 0; i < 7; ++i) { if (i < sc) { const float er = Eb[i * 128], ei = Eb[i * 128 + 64]; const float tr = l256.x * Sr - l256.y * Si + er, ti = l256.x * Si + l256.y * Sr + ei; Sr = tr; Si = ti; } }
                    float rr = 1.0f, ri = 0.0f;
                    if (jj & 1) { const float tr = rr * l32.x - ri * l32.y, ti = rr * l32.y + ri * l32.x; rr = tr; ri = ti; }
                    if (jj & 2) { const float tr = rr * l64.x - ri * l64.y, ti = rr * l64.y + ri * l64.x; rr = tr; ri = ti; }
                    if (jj & 4) { const float tr = rr * l128.x - ri * l128.y, ti = rr * l128.y + ri * l128.x; rr = tr; ri = ti; }
                    const size_t o = ((size_t)((bseq * 32 + g) * 64 + chunk)) * 128 + pt * 32 + li;
                    sr[pt] = sin_[o] + (rr * Sr - ri * Si); si[pt] = sin_[o + 64] + (rr * Si + ri * Sr);
                }
            }
        }
#pragma unroll
        for (int hh = 0; hh < 2; ++hh) {
            const bool mine = (half == hh);
            float tr_[2] = {sr[0], sr[1]}, ti_[2] = {si[0], si[1]};
#pragma unroll
            for (int q = 0; q < 4; ++q)
#pragma unroll
                for (int pt = 0; pt < 2; ++pt) {
                    const float tr = lm[pt].x * tr_[pt] - lm[pt].y * ti_[pt] + acc[pt][4 * k + q];
                    const float ti = lm[pt].x * ti_[pt] + lm[pt].y * tr_[pt] + acc[2 + pt][4 * k + q];
                    tr_[pt] = tr; ti_[pt] = ti;
                    acc[pt][4 * k + q] = mine ? tr : acc[pt][4 * k + q]; acc[2 + pt][4 * k + q] = mine ? ti : acc[2 + pt][4 * k + q];
                }
#pragma unroll
            for (int pt = 0; pt < 2; ++pt) { sr[pt] = mine ? tr_[pt] : sr[pt]; si[pt] = mine ? ti_[pt] : si[pt]; }
            if (SAMPLE && hh == 1) {
                if (mine) {
#pragma unroll
                    for (int pt = 0; pt < 2; ++pt) { const size_t o = ((size_t)((l * 128 + bseq + k) * 32 + g)) * 64 + pt * 32 + li;
                        p.out[O_SRS + o] = sr[pt]; p.out[O_SIS + o] = si[pt]; }
                }
            }
#pragma unroll
            for (int pt = 0; pt < 2; ++pt) { const float orr = xor32(sr[pt], half), oii = xor32(si[pt], half); sr[pt] = mine ? sr[pt] : orr; si[pt] = mine ? si[pt] : oii; }
        }
    }
    if (!SAMPLE && chunk == 63 && half == 0) {
#pragma unroll
        for (int pt = 0; pt < 2; ++pt) { const size_t o = ((size_t)((l * 8 + bseq) * 32 + g)) * 64 + pt * 32 + li; p.out[O_SRP + o] = sr[pt]; p.out[O_SIP + o] = si[pt]; }
    }
#pragma unroll
    for (int ct = 0; ct < 4; ++ct)
#pragma unroll
        for (int r = 0; r < 16; ++r) { const int t = (r & 3) + 8 * (r >> 2) + 4 * half; Sl[t * 136 + ct * 32 + li] = f2bf(acc[ct][r]); }
    LDS_WAIT();
    const int fr = lane & 15, fq = lane >> 4;
    bf16x8 cf[4];
#pragma unroll
    for (int ks = 0; ks < 4; ++ks) cf[ks] = *(const bf16x8*)((const bf16_t*)(st + S5_CMT) + (size_t)(g * 16 + fr) * 128 + ks * 32 + 8 * fq);
    const float dv = p.in[15][l * 512 + g * 16 + fr];
#pragma unroll
    for (int rt = 0; rt < 2; ++rt) {
        f32x4 y = {0.f, 0.f, 0.f, 0.f};
#pragma unroll
        for (int ks = 0; ks < 4; ++ks) { const bf16x8 a = *(const bf16x8*)(Sl + (rt * 16 + fr) * 136 + ks * 32 + 8 * fq); y = MFMA16(a, cf[ks], y); }
        MFMA_SETTLE();
#pragma unroll
        for (int r = 0; r < 4; ++r) { const int tok = row0 + rt * 16 + 4 * fq + r; const float uu = bf2f(z[(size_t)tok * INC + g * 16 + fr]);
            ya[(size_t)tok * 512 + g * 16 + fr] = f2bf(gelu_tanh(y[r] + dv * uu)); }
    }
    LDS_WAIT();
}

__device__ __forceinline__ void s5_m1(const KPG& p, int l, int b, int g, int sc, int lane) {
    const bf16_t* z = (const bf16_t*)(p.ws + WS_Z);
    const unsigned char* st = p.ws + WS_S5T + (size_t)l * S5_SIZE;
    const int half = lane >> 5, li = lane & 31;
    bf16x8 bfr[4];
#pragma unroll
    for (int ct = 0; ct < 4; ++ct) bfr[ct] = *(const bf16x8*)((const bf16_t*)(st + S5_BMT) + (size_t)(g * 128 + ct * 32 + li) * 16 + 8 * half);
    float2 lm[2]; lm[0] = ((const float2*)(st + S5_LAM))[g * 64 + li]; lm[1] = ((const float2*)(st + S5_LAM))[g * 64 + 32 + li];
    float sr[2] = {0.f, 0.f}, si[2] = {0.f, 0.f};
    float* sin_ = (float*)(p.ws + WS_SIN);
    for (int j = 0; j < 8; ++j) {
        const int chunk = sc * 8 + j, row0 = b * 2048 + chunk * 32;
        const bf16x8 uf = *(const bf16x8*)(z + (size_t)(row0 + li) * INC + g * 16 + 8 * half);
        if (half == 0) {
#pragma unroll
            for (int pt = 0; pt < 2; ++pt) { const size_t o = ((size_t)((b * 32 + g) * 64 + chunk)) * 128 + pt * 32 + li; sin_[o] = sr[pt]; sin_[o + 64] = si[pt]; }
        }
        f32x16 acc[4];
#pragma unroll
        for (int ct = 0; ct < 4; ++ct) {
            f32x16 zz;
#pragma unroll
            for (int e = 0; e < 16; ++e) zz[e] = 0.f;
            acc[ct] = MFMA32(uf, bfr[ct], zz);
        }
        MFMA_SETTLE();
#pragma unroll
        for (int k = 0; k < 4; ++k)
#pragma unroll
            for (int hh = 0; hh < 2; ++hh) {
                const bool mine = (half == hh);
                float tr_[2] = {sr[0], sr[1]}, ti_[2] = {si[0], si[1]};
#pragma unroll
                for (int q = 0; q < 4; ++q)
#pragma unroll
                    for (int pt = 0; pt < 2; ++pt) {
                        const float tr = lm[pt].x * tr_[pt] - lm[pt].y * ti_[pt] + acc[pt][4 * k + q];
                        const float ti = lm[pt].x * ti_[pt] + lm[pt].y * tr_[pt] + acc[2 + pt][4 * k + q];
                        tr_[pt] = tr; ti_[pt] = ti;
                    }
#pragma unroll
                for (int pt = 0; pt < 2; ++pt) { sr[pt] = mine ? tr_[pt] : sr[pt]; si[pt] = mine ? ti_[pt] : si[pt]; }
#pragma unroll
                for (int pt = 0; pt < 2; ++pt) { const float orr = xor32(sr[pt], half), oii = xor32(si[pt], half); sr[pt] = mine ? sr[pt] : orr; si[pt] = mine ? si[pt] : oii; }
            }
    }
    if (half == 0) {
        float* E = (float*)(p.ws + WS_E) + ((size_t)((b * 32 + g) * 8 + sc)) * 128;
#pragma unroll
        for (int pt = 0; pt < 2; ++pt) { E[pt * 32 + li] = sr[pt]; E[64 + pt * 32 + li] = si[pt]; }
    }
}

__device__ __forceinline__ float log2_gamma(int h) { return __log2f(1.0f - exp2f(-5.0f - (float)h)); }

__device__ __forceinline__ void rot8(const u32x4& lo, const u32x4& hi, const float2* rp, float scale, float* olo, float* ohi) {
    const unsigned lw[4] = {lo.x, lo.y, lo.z, lo.w}, hw[4] = {hi.x, hi.y, hi.z, hi.w};
#pragma unroll
    for (int e = 0; e < 8; ++e) {
        const float x1 = (e & 1) ? bfhi(lw[e >> 1]) : bflo(lw[e >> 1]);
        const float x2 = (e & 1) ? bfhi(hw[e >> 1]) : bflo(hw[e >> 1]);
        const float2 cs = rp[e];
        olo[e] = (x1 * cs.x - x2 * cs.y) * scale; ohi[e] = (x1 * cs.y + x2 * cs.x) * scale;
    }
}

__device__ __forceinline__ void ret_m1_unit(const KPG& p, int l, int unit, unsigned char* lds, int wave, int lane) {
    const int tid = fresh_tid(), b = unit >> 4, h = (unit >> 2) & 3, s = unit & 3;
    const bf16_t* z = (const bf16_t*)(p.ws + WS_Z); const float2* rope = (const float2*)(p.ws + WS_ROPE);
    bf16_t* RTb = (bf16_t*)(p.ws + WS_RT);
    bf16_t* KT = (bf16_t*)lds; bf16_t* VT = KT + 128 * 136;
    const float lg2 = log2_gamma(h), cdec = exp2f(128.0f * lg2);
    const int fr = lane & 15, fq = lane >> 4;
    f32x4 R[4];
#pragma unroll
    for (int nt = 0; nt < 4; ++nt) R[nt] = (f32x4){0.f, 0.f, 0.f, 0.f};
    for (int i = 0; i < 16; ++i) {
        bf16_t* rt = RTb + ((size_t)((b * 4 + h) * 16 + i)) * 256 * 128;
#pragma unroll
        for (int nt = 0; nt < 4; ++nt) { u32x2 w; w.x = pk2(R[nt][0], R[nt][1]); w.y = pk2(R[nt][2], R[nt][3]);
            *(u32x2*)(rt + (size_t)(64 * s + 16 * nt + fr) * 128 + 16 * wave + 4 * fq) = w; }
        const int row0 = b * 2048 + i * 128;
#pragma unroll
        for (int tk = 0; tk < 2; ++tk) {
            const int task = tid + 512 * tk, j = task & 127, dg = task >> 7;
            const bf16_t* zr = z + (size_t)(row0 + j) * INC + ZK + h * 128 + dg * 8;
            const u32x4 lo = *(const u32x4*)zr, hi = *(const u32x4*)(zr + 64);
            float olo[8], ohi[8];
            rot8(lo, hi, rope + (size_t)(i * 128 + j) * 64 + dg * 8, 0.08838834764831845f * exp2f((float)(127 - j) * lg2), olo, ohi);
#pragma unroll
            for (int e = 0; e < 8; ++e) { KT[(dg * 8 + e) * 136 + j] = f2bf(olo[e]); KT[(64 + dg * 8 + e) * 136 + j] = f2bf(ohi[e]); }
        }
#pragma unroll
        for (int tk = 0; tk < 2; ++tk) {
            const int task = tid + 512 * tk, j = task & 127, vg = task >> 7;
            const u32x4 v = *(const u32x4*)(z + (size_t)(row0 + j) * INC + ZV + h * 256 + s * 64 + vg * 8);
            const unsigned vw[4] = {v.x, v.y, v.z, v.w};
#pragma unroll
            for (int e = 0; e < 8; ++e) VT[(vg * 8 + e) * 136 + j] = (bf16_t)((e & 1) ? (vw[e >> 1] >> 16) : (vw[e >> 1] & 0xffffu));
        }
        __syncthreads();
#pragma unroll
        for (int nt = 0; nt < 4; ++nt) R[nt] = R[nt] * cdec;
#pragma unroll
        for (int ks = 0; ks < 4; ++ks) {
            const bf16x8 a = *(const bf16x8*)(KT + (16 * wave + fr) * 136 + ks * 32 + 8 * fq);
#pragma unroll
            for (int nt = 0; nt < 4; ++nt) { const bf16x8 bb = *(const bf16x8*)(VT + (16 * nt + fr) * 136 + ks * 32 + 8 * fq); R[nt] = MFMA16(a, bb, R[nt]); }
        }
        MFMA_SETTLE();
        __syncthreads();
    }
    float* ro = p.out + O_RP + ((size_t)((l * 8 + b) * 4 + h)) * 128 * 256;
#pragma unroll
    for (int nt = 0; nt < 4; ++nt)
#pragma unroll
        for (int r = 0; r < 4; ++r) ro[(size_t)(16 * wave + 4 * fq + r) * 256 + 64 * s + 16 * nt + fr] = R[nt][r];
}

__device__ __forceinline__ void ret_m2_unit(const KPG& p, int l, int unit, unsigned char* lds, int wave, int lane) {
    const int tid = fresh_tid(), b = unit >> 6, h = (unit >> 4) & 3, i = unit & 15;
    const bf16_t* z = (const bf16_t*)(p.ws + WS_Z); const float2* rope = (const float2*)(p.ws + WS_ROPE);
    const bf16_t* RTb = (const bf16_t*)(p.ws + WS_RT); bf16_t* ob = (bf16_t*)(p.ws + WS_O);
    bf16_t* Qs = (bf16_t*)lds; bf16_t* Ks = Qs + 128 * 136; bf16_t* BIG = Ks + 128 * 136;
    const float lg2 = log2_gamma(h);
    const int fr = lane & 15, fq = lane >> 4, row0 = b * 2048 + i * 128;
#pragma unroll
    for (int tk = 0; tk < 2; ++tk) {
        const int task = tid + 512 * tk, dg = task & 7, j = task >> 3;
        const bf16_t* zr = z + (size_t)(row0 + j) * INC + h * 128 + dg * 8;
        const float2* rp = rope + (size_t)(i * 128 + j) * 64 + dg * 8;
        float olo[8], ohi[8];
        { const u32x4 lo = *(const u32x4*)(zr + ZQ), hi = *(const u32x4*)(zr + ZQ + 64); rot8(lo, hi, rp, 1.0f, olo, ohi);
          u32x4 w; w.x = pk2(olo[0], olo[1]); w.y = pk2(olo[2], olo[3]); w.z = pk2(olo[4], olo[5]); w.w = pk2(olo[6], olo[7]); *(u32x4*)(Qs + j * 136 + dg * 8) = w;
          w.x = pk2(ohi[0], ohi[1]); w.y = pk2(ohi[2], ohi[3]); w.z = pk2(ohi[4], ohi[5]); w.w = pk2(ohi[6], ohi[7]); *(u32x4*)(Qs + j * 136 + 64 + dg * 8) = w; }
        { const u32x4 lo = *(const u32x4*)(zr + ZK), hi = *(const u32x4*)(zr + ZK + 64); rot8(lo, hi, rp, 0.08838834764831845f, olo, ohi);
          u32x4 w; w.x = pk2(olo[0], olo[1]); w.y = pk2(olo[2], olo[3]); w.z = pk2(olo[4], olo[5]); w.w = pk2(olo[6], olo[7]); *(u32x4*)(Ks + j * 136 + dg * 8) = w;
          w.x = pk2(ohi[0], ohi[1]); w.y = pk2(ohi[2], ohi[3]); w.z = pk2(ohi[4], ohi[5]); w.w = pk2(ohi[6], ohi[7]); *(u32x4*)(Ks + j * 136 + 64 + dg * 8) = w; }
    }
    {
        const bf16_t* src = RTb + ((size_t)((b * 4 + h) * 16 + i)) * 256 * 128;
#pragma unroll
        for (int k = 0; k < 8; ++k) { const int idx = tid + 512 * k, dv = idx >> 4, c16 = idx & 15; *(u32x4*)(BIG + dv * 136 + c16 * 8) = *(const u32x4*)(src + (size_t)dv * 128 + c16 * 8); }
    }
    __syncthreads();
    bf16x8 Aq[4];
#pragma unroll
    for (int ks = 0; ks < 4; ++ks) Aq[ks] = *(const bf16x8*)(Qs + (16 * wave + fr) * 136 + ks * 32 + 8 * fq);
    f32x4 S[8];
#pragma unroll
    for (int jt = 0; jt < 8; ++jt) {
        S[jt] = (f32x4){0.f, 0.f, 0.f, 0.f};
        if (jt <= wave) {
#pragma unroll
            for (int ks = 0; ks < 4; ++ks) { const bf16x8 bb = *(const bf16x8*)(Ks + (16 * jt + fr) * 136 + ks * 32 + 8 * fq); S[jt] = MFMA16(Aq[ks], bb, S[jt]); }
        }
        __builtin_amdgcn_sched_barrier(0);
    }
    f32x4 O[16];
#pragma unroll
    for (int nt = 0; nt < 16; ++nt) {
        O[nt] = (f32x4){0.f, 0.f, 0.f, 0.f};
#pragma unroll
        for (int ks = 0; ks < 4; ++ks) { const bf16x8 bb = *(const bf16x8*)(BIG + (16 * nt + fr) * 136 + ks * 32 + 8 * fq); O[nt] = MFMA16(Aq[ks], bb, O[nt]); }
        if ((nt & 1) == 1) __builtin_amdgcn_sched_barrier(0);
    }
    MFMA_SETTLE();
    {
        float inn[4];
#pragma unroll
        for (int r = 0; r < 4; ++r) inn[r] = exp2f((float)(16 * wave + 4 * fq + r + 1) * lg2);
#pragma unroll
        for (int nt = 0; nt < 16; ++nt)
#pragma unroll
            for (int r = 0; r < 4; ++r) O[nt][r] *= inn[r];
    }
    __syncthreads();
#pragma unroll
    for (int jt = 0; jt < 8; ++jt)
#pragma unroll
        for (int r = 0; r < 4; ++r) {
            const int ii = 16 * wave + 4 * fq + r, jj = 16 * jt + fr;
            const float v = (jt <= wave && ii >= jj) ? S[jt][r] * exp2f((float)(ii - jj) * lg2) : 0.0f;
            Ks[ii * 136 + jj] = f2bf(v);
        }
#pragma unroll
    for (int k = 0; k < 8; ++k) {
        const int task = tid + 512 * k, j = task & 127, vg = task >> 7;
        const u32x4 v = *(const u32x4*)(z + (size_t)(row0 + j) * INC + ZV + h * 256 + vg * 8);
        const unsigned vw[4] = {v.x, v.y, v.z, v.w};
#pragma unroll
        for (int e = 0; e < 8; ++e) BIG[(vg * 8 + e) * 136 + j] = (bf16_t)((e & 1) ? (vw[e >> 1] >> 16) : (vw[e >> 1] & 0xffffu));
    }
    __syncthreads();
#pragma unroll
    for (int ks = 0; ks < 4; ++ks) {
        if (ks <= (wave >> 1)) {
            const bf16x8 a = *(const bf16x8*)(Ks + (16 * wave + fr) * 136 + ks * 32 + 8 * fq);
#pragma unroll
            for (int nt = 0; nt < 16; ++nt) { const bf16x8 bb = *(const bf16x8*)(BIG + (16 * nt + fr) * 136 + ks * 32 + 8 * fq); O[nt] = MFMA16(a, bb, O[nt]); if ((nt & 1) == 1) __builtin_amdgcn_sched_barrier(0); }
        }
    }
    MFMA_SETTLE();
#pragma unroll
    for (int r = 0; r < 4; ++r) {
        float ss = 0.f;
#pragma unroll
        for (int nt = 0; nt < 16; ++nt) ss += O[nt][r] * O[nt][r];
        ss = row_sum16(ss);
        const float rstd = rsqrtf(ss * (1.0f / 256.0f) + EPSF);
        const size_t tok = (size_t)(row0 + 16 * wave + 4 * fq + r);
#pragma unroll
        for (int nt = 0; nt < 16; ++nt) { const int col = h * 256 + 16 * nt + fr; const float gg = bf2f(z[tok * INC + ZGR + col]);
            ob[tok * 1024 + col] = f2bf(O[nt][r] * rstd * siluf_(gg)); }
    }
    __syncthreads();
}

__device__ __forceinline__ void ret_sample_unit(const KPG& p, int l, int unit, unsigned char* lds, int wave, int lane) {
    const int tid = fresh_tid(), b = unit >> 2, h = unit & 3;
    const bf16_t* z = (const bf16_t*)(p.ws + WS_Z); const float2* rope = (const float2*)(p.ws + WS_ROPE); bf16_t* ob = (bf16_t*)(p.ws + WS_O);
    float* qT = (float*)lds; float* kT = qT + 1024; float* ktT = kT + 1024; float* vs = ktT + 1024; float* sc = vs + 2048; float* opart = sc + 64;
    const float lg2 = log2_gamma(h);
    const int row0 = MP + b * 8;
    if (tid < 64) {
        const int i = tid >> 3, dg = tid & 7;
        const bf16_t* zr = z + (size_t)(row0 + i) * INC + h * 128 + dg * 8;
        const float2* rp = rope + (size_t)(2048 + i) * 64 + dg * 8;
        float olo[8], ohi[8];
        { const u32x4 lo = *(const u32x4*)(zr + ZQ), hi = *(const u32x4*)(zr + ZQ + 64); rot8(lo, hi, rp, 1.0f, olo, ohi);
#pragma unroll
          for (int e = 0; e < 8; ++e) { qT[(dg * 8 + e) * 8 + i] = olo[e]; qT[(64 + dg * 8 + e) * 8 + i] = ohi[e]; } }
        { const u32x4 lo = *(const u32x4*)(zr + ZK), hi = *(const u32x4*)(zr + ZK + 64); rot8(lo, hi, rp, 0.08838834764831845f, olo, ohi);
          const float tl = exp2f((float)(7 - i) * lg2);
#pragma unroll
          for (int e = 0; e < 8; ++e) { kT[(dg * 8 + e) * 8 + i] = olo[e]; kT[(64 + dg * 8 + e) * 8 + i] = ohi[e]; ktT[(dg * 8 + e) * 8 + i] = olo[e] * tl; ktT[(64 + dg * 8 + e) * 8 + i] = ohi[e] * tl; } }
    }
    if (tid < 256) {
#pragma unroll
        for (int i = 0; i < 8; ++i) vs[i * 256 + tid] = bf2f(z[(size_t)(row0 + i) * INC + ZV + h * 256 + tid]);
    }
    __syncthreads();
    if (tid < 64) {
        const int i = tid >> 3, j = tid & 7; float d = 0.f;
        for (int dd = 0; dd < 128; ++dd) d += qT[dd * 8 + i] * kT[dd * 8 + j];
        sc[tid] = (j <= i) ? d * exp2f((float)(i - j) * lg2) : 0.f;
    }
    {
        const int dv4 = (tid & 63) * 4;
        f32x4 vv[8], ao[8];
#pragma unroll
        for (int j = 0; j < 8; ++j) { vv[j] = *(const f32x4*)(vs + j * 256 + dv4); ao[j] = (f32x4){0.f, 0.f, 0.f, 0.f}; }
        const size_t so = ((size_t)((l * 128 + b) * 4 + h)) * 128 * 256;
        const float* r0 = p.in[4] + so; float* rn = p.out + O_RS + so;
        const float cdec = exp2f(8.0f * lg2);
#pragma unroll 8
        for (int dd = 0; dd < 16; ++dd) {
            const int d = wave * 16 + dd;
            const f32x4 r = *(const f32x4*)(r0 + (size_t)d * 256 + dv4);
            const f32x4 qa = *(const f32x4*)(qT + d * 8), qb = *(const f32x4*)(qT + d * 8 + 4), ka = *(const f32x4*)(ktT + d * 8), kb = *(const f32x4*)(ktT + d * 8 + 4);
            ao[0] += qa[0] * r; ao[1] += qa[1] * r; ao[2] += qa[2] * r; ao[3] += qa[3] * r; ao[4] += qb[0] * r; ao[5] += qb[1] * r; ao[6] += qb[2] * r; ao[7] += qb[3] * r;
            f32x4 nr = r * cdec;
            nr += ka[0] * vv[0]; nr += ka[1] * vv[1]; nr += ka[2] * vv[2]; nr += ka[3] * vv[3]; nr += kb[0] * vv[4]; nr += kb[1] * vv[5]; nr += kb[2] * vv[6]; nr += kb[3] * vv[7];
            *(f32x4*)(rn + (size_t)d * 256 + dv4) = nr;
        }
#pragma unroll
        for (int i = 0; i < 8; ++i) *(f32x4*)(opart + (wave * 8 + i) * 256 + dv4) = ao[i];
    }
    __syncthreads();
    {
        const int i = wave, dv4 = (tid & 63) * 4;
        f32x4 a = (f32x4){0.f, 0.f, 0.f, 0.f};
#pragma unroll
        for (int w = 0; w < 8; ++w) a += *(const f32x4*)(opart + (w * 8 + i) * 256 + dv4);
        a = a * exp2f((float)(i + 1) * lg2);
#pragma unroll
        for (int j = 0; j < 8; ++j) { if (j <= i) a += sc[i * 8 + j] * *(const f32x4*)(vs + j * 256 + dv4); }
        const float ss = wave_sum(a[0] * a[0] + a[1] * a[1] + a[2] * a[2] + a[3] * a[3]);
        const float rstd = rsqrtf(ss * (1.0f / 256.0f) + EPSF);
        const size_t tok = (size_t)(row0 + i);
        const u32x2 gw = *(const u32x2*)(z + tok * INC + ZGR + h * 256 + dv4);
        u32x2 w; w.x = pk2(a[0] * rstd * siluf_(bflo(gw.x)), a[1] * rstd * siluf_(bfhi(gw.x))); w.y = pk2(a[2] * rstd * siluf_(bflo(gw.y)), a[3] * rstd * siluf_(bfhi(gw.y)));
        *(u32x2*)(ob + tok * 1024 + h * 256 + dv4) = w;
    }
    __syncthreads();
}

__device__ __forceinline__ void phase_convact(const KPG& p, int l) {
    const bf16_t* up = (const bf16_t*)(p.ws + WS_Z); bf16_t* act = (bf16_t*)(p.ws + WS_ACT);
    const float* cw = p.in[22] + (size_t)l * 3 * INC; const float* cb = p.in[23] + (size_t)l * INC;
    const int NT = (512 + 128) * 352;
    for (int task = fresh_bid() * 512 + fresh_tid(); task < NT; task += gridDim.x * 512) {
        const int cgp = task % 352, rc = task / 352, j0 = cgp * 8;
        int row0, nrows; bool sample = rc >= 512;
        if (!sample) { row0 = rc * 32; nrows = 32; } else { row0 = MP + (rc - 512) * 8; nrows = 8; }
        float w0v[8], w1v[8], w2v[8], bv[8], w0g[8], w1g[8], w2g[8], bg[8];
#pragma unroll
        for (int e = 0; e < 8; ++e) { w0v[e] = cw[j0 + e]; w1v[e] = cw[INC + j0 + e]; w2v[e] = cw[2 * INC + j0 + e]; bv[e] = cb[j0 + e];
            w0g[e] = cw[DFF + j0 + e]; w1g[e] = cw[INC + DFF + j0 + e]; w2g[e] = cw[2 * INC + DFF + j0 + e]; bg[e] = cb[DFF + j0 + e]; }
        float p2v[8], p1v[8], p2g[8], p1g[8];
        if (sample) {
            const float* sc = p.in[5] + ((size_t)(l * 128 + (rc - 512)) * 2) * INC;
#pragma unroll
            for (int e = 0; e < 8; ++e) { p2v[e] = sc[j0 + e]; p1v[e] = sc[INC + j0 + e]; p2g[e] = sc[DFF + j0 + e]; p1g[e] = sc[INC + DFF + j0 + e]; }
        } else if ((row0 & 2047) == 0) {
#pragma unroll
            for (int e = 0; e < 8; ++e) { p2v[e] = 0.f; p1v[e] = 0.f; p2g[e] = 0.f; p1g[e] = 0.f; }
        } else {
            const u32x4 a = *(const u32x4*)(up + (size_t)(row0 - 2) * INC + j0), b = *(const u32x4*)(up + (size_t)(row0 - 1) * INC + j0);
            const u32x4 c = *(const u32x4*)(up + (size_t)(row0 - 2) * INC + DFF + j0), d = *(const u32x4*)(up + (size_t)(row0 - 1) * INC + DFF + j0);
            const unsigned aw[4] = {a.x, a.y, a.z, a.w}, bw[4] = {b.x, b.y, b.z, b.w}, cw_[4] = {c.x, c.y, c.z, c.w}, dw[4] = {d.x, d.y, d.z, d.w};
#pragma unroll
            for (int e = 0; e < 8; ++e) { p2v[e] = (e & 1) ? bfhi(aw[e >> 1]) : bflo(aw[e >> 1]); p1v[e] = (e & 1) ? bfhi(bw[e >> 1]) : bflo(bw[e >> 1]);
                p2g[e] = (e & 1) ? bfhi(cw_[e >> 1]) : bflo(cw_[e >> 1]); p1g[e] = (e & 1) ? bfhi(dw[e >> 1]) : bflo(dw[e >> 1]); }
        }
        for (int r = 0; r < nrows; ++r) {
            const u32x4 a = *(const u32x4*)(up + (size_t)(row0 + r) * INC + j0), c = *(const u32x4*)(up + (size_t)(row0 + r) * INC + DFF + j0);
            const unsigned aw[4] = {a.x, a.y, a.z, a.w}, cw_[4] = {c.x, c.y, c.z, c.w};
            float o[8];
#pragma unroll
            for (int e = 0; e < 8; ++e) {
                const float cv = (e & 1) ? bfhi(aw[e >> 1]) : bflo(aw[e >> 1]), cg_ = (e & 1) ? bfhi(cw_[e >> 1]) : bflo(cw_[e >> 1]);
                const float val = bv[e] + w0v[e] * p2v[e] + w1v[e] * p1v[e] + w2v[e] * cv;
                const float gat = bg[e] + w0g[e] * p2g[e] + w1g[e] * p1g[e] + w2g[e] * cg_;
                o[e] = siluf_(gat) * val;
                p2v[e] = p1v[e]; p1v[e] = cv; p2g[e] = p1g[e]; p1g[e] = cg_;
            }
            u32x4 w; w.x = pk2(o[0], o[1]); w.y = pk2(o[2], o[3]); w.z = pk2(o[4], o[5]); w.w = pk2(o[6], o[7]);
            *(u32x4*)(act + (size_t)(row0 + r) * DFF + j0) = w;
        }
    }
}

#endif

__global__ void __launch_bounds__(512, 2) fwd_kernel(KP p) {
#if defined(__HIP_DEVICE_COMPILE__)
    extern __shared__ __attribute__((aligned(16))) unsigned char lds[];
    cg::grid_group grid = cg::this_grid();
    volatile LAS unsigned* barw = (volatile LAS unsigned*)((LAS unsigned char*)lds + LDS_BARW);
    if (threadIdx.x < 4) barw[threadIdx.x] = 0u;
    if (threadIdx.x == 0) {
        LAS unsigned long long* t = (LAS unsigned long long*)((LAS unsigned char*)lds + LDS_TAB);
#pragma unroll
        for (int i = 0; i < 26; ++i) t[i] = (unsigned long long)p.in[i];
        t[26] = (unsigned long long)p.out; t[27] = (unsigned long long)p.ws;
    }
    __syncthreads();
    (void)xcd_barrier_post((unsigned*)(p.ws + WS_CTL), barw);
#if USE_CG
#define GSYNC() grid.sync()
#else
#define GSYNC() do { XcdBarrier b_; b_.bar = (unsigned*)((GAS unsigned char*)ld_tab(lds, 27) + WS_CTL); b_.x = xb_xcc_id(); b_.st = (volatile LAS unsigned*)((LAS unsigned char*)lds + LDS_BARW); xcd_barrier(b_); } while (0)
#endif
#define PH_BEGIN const KPG q = load_kp(lds); const int tid_ = fresh_tid(), lane = tid_ & 63, wave = __builtin_amdgcn_readfirstlane(tid_ >> 6); (void)lane; (void)wave; \
                 const int G = gridDim.x, c = fresh_bid(); (void)G; (void)c; LAS unsigned char* glds = (LAS unsigned char*)lds; (void)glds;

    for (int l = 0; l < DEPTH; ++l) {
        {
            PH_BEGIN
#ifndef NO_PRO
            phase_prologue(q, l, lds, wave, lane);
#endif
            phase_rmsnorm(q, l, wave, lane);
        }
        if (l == 0) grid.sync();
        GSYNC();
        {
            PH_BEGIN
            unsigned char* wl = q.ws + WS_WT + (size_t)l * LW_SIZE;
            pg8::Sched S{(const char*)(q.ws + WS_H), (const char*)(wl + LW_IN), nullptr, nullptr, 16, 0, 1024, MT / 256, INC / 256, G, c};
            pg8::EpiStoreBf16 E{(bf16_t*)(q.ws + WS_Z), INC};
#if !defined(NO_GEMM) && (!defined(ONLY_GEMM) || ONLY_GEMM == 0)
            pg8::gemm_phase(glds, S, E);
#endif
        }
        GSYNC();
        {
            PH_BEGIN
#ifndef NO_RM1
            for (int u = c; u < 128; u += G) ret_m1_unit(q, l, u, lds, wave, lane);
#endif
#ifndef NO_RS
            for (int u = c - 128; u >= 0 && u < 512; u += 128) ret_sample_unit(q, l, u, lds, wave, lane);
#endif
        }
        {
            PH_BEGIN
#ifndef NO_SM1
            for (int u = c; u < 256; u += G) { const int wt = u * 8 + wave; s5_m1(q, l, wt >> 8, (wt >> 3) & 31, wt & 7, lane); }
#endif
        }
        {
            PH_BEGIN
#ifndef NO_SS
            for (int u = c - 128; u >= 0 && u < 128; u += G) { const int g = (u >> 4) * 4 + (wave & 3), bq = (u & 15) * 2 + (wave >> 2);
                s5_tile<true>(q, l, g, MP + bq * 32, bq * 4, 0, (bf16_t*)(lds + wave * 8704), lane); }
#endif
        }
        GSYNC();
        {
            PH_BEGIN
#ifndef NO_RM2
            for (int u = c; u < 512; u += G) ret_m2_unit(q, l, u, lds, wave, lane);
#endif
        }
        {
            PH_BEGIN
#ifndef NO_SM2
            for (int uu = c; uu < 2048; uu += G) { const int chunk = (uu & 31) * 2 + (wave >> 2), g = ((uu >> 5) & 7) * 4 + (wave & 3), b = uu >> 8;
                s5_tile<false>(q, l, g, b * 2048 + chunk * 32, b, chunk, (bf16_t*)(lds + wave * 8704), lane); }
#endif
        }
        GSYNC();
        {
            PH_BEGIN
            unsigned char* wl = q.ws + WS_WT + (size_t)l * LW_SIZE;
            pg8::Sched S{(const char*)(q.ws + WS_YA), (const char*)(wl + LW_GLU), nullptr, nullptr, 8, 0, 512, MT / 256, 2, G, c};
            pg8::EpiGlu E{(const bf16_t*)(q.ws + WS_YA), (bf16_t*)(q.ws + WS_YA2)};
#if !defined(NO_GEMM) && (!defined(ONLY_GEMM) || ONLY_GEMM == 1)
            pg8::gemm_phase(glds, S, E);
#endif
        }
        GSYNC();
        {
            PH_BEGIN
            unsigned char* wl = q.ws + WS_WT + (size_t)l * LW_SIZE;
            pg8::Sched S{(const char*)(q.ws + WS_YA2), (const char*)(wl + LW_SSM), (const char*)(q.ws + WS_O), (const char*)(wl + LW_RET), 8, 16, 1024, MT / 256, 4, G, c};
            pg8::EpiMix E{(const bf16_t*)(q.ws + WS_Z), (bf16_t*)(q.ws + WS_MIX)};
#if !defined(NO_GEMM) && (!defined(ONLY_GEMM) || ONLY_GEMM == 2)
            pg8::gemm_phase(glds, S, E);
#endif
        }
        GSYNC();
        {
            PH_BEGIN
            unsigned char* wl = q.ws + WS_WT + (size_t)l * LW_SIZE;
            pg8::Sched S{(const char*)(q.ws + WS_MIX), (const char*)(wl + LW_O), nullptr, nullptr, 16, 0, 1024, MT / 256, 4, G, c};
            pg8::EpiRes E{l == 0 ? q.in[0] : (const float*)(q.ws + WS_X), l == 0 ? q.in[1] : (const float*)(q.ws + WS_X) + (size_t)MP * 1024, (float*)(q.ws + WS_X)};
#if !defined(NO_GEMM) && (!defined(ONLY_GEMM) || ONLY_GEMM == 3)
            pg8::gemm_phase(glds, S, E);
#endif
        }
        GSYNC();
        { PH_BEGIN phase_rmsnorm(q, 1, wave, lane); }
        GSYNC();
        {
            PH_BEGIN
            unsigned char* wl = q.ws + WS_WT + (size_t)l * LW_SIZE;
            pg8::Sched S{(const char*)(q.ws + WS_H), (const char*)(wl + LW_UP), nullptr, nullptr, 16, 0, 1024, MT / 256, INC / 256, G, c};
            pg8::EpiUp E{(bf16_t*)(q.ws + WS_Z), q.out + O_CP + (size_t)l * 8 * 2 * INC, q.out + O_CS + (size_t)l * 128 * 2 * INC};
#if !defined(NO_GEMM) && (!defined(ONLY_GEMM) || ONLY_GEMM == 4)
            pg8::gemm_phase(glds, S, E);
#endif
        }
        GSYNC();
        {
            PH_BEGIN
#ifndef NO_CONV
            phase_convact(q, l);
#endif
        }
        GSYNC();
        {
            PH_BEGIN
            unsigned char* wl = q.ws + WS_WT + (size_t)l * LW_SIZE;
            pg8::Sched S{(const char*)(q.ws + WS_ACT), (const char*)(wl + LW_DOWN), nullptr, nullptr, 44, 0, DFF, MT / 256, 4, G, c};
            pg8::EpiRes E{(const float*)(q.ws + WS_X), (const float*)(q.ws + WS_X) + (size_t)MP * 1024, (float*)(q.ws + WS_X)};
#if !defined(NO_GEMM) && (!defined(ONLY_GEMM) || ONLY_GEMM == 5)
            pg8::gemm_phase(glds, S, E);
#endif
        }
        GSYNC();
    }
    {
        PH_BEGIN
        const float* xb = (const float*)(q.ws + WS_X); const float* gf = q.in[25];
        for (int row = c * 8 + wave; row < MT; row += G * 8) {
            const f32x4* xr = (const f32x4*)(xb + (size_t)row * 1024) + lane; const f32x4* gr = (const f32x4*)gf + lane;
            f32x4 v[4]; float s = 0.f;
#pragma unroll
            for (int j = 0; j < 4; ++j) { v[j] = xr[64 * j]; s += (v[j].x * v[j].x + v[j].y * v[j].y) + (v[j].z * v[j].z + v[j].w * v[j].w); }
            const float rstd = rsqrtf(wave_sum(s) * (1.f / 1024.f) + EPSF);
            f32x4* o = (f32x4*)(q.out + O_YP + (size_t)row * 1024) + lane;
#pragma unroll
            for (int j = 0; j < 4; ++j) o[64 * j] = v[j] * rstd * gr[64 * j];
        }
    }
#endif
}

extern "C" void kernel_launch(void* const* d_in, const int* in_sizes, int n_in, void* d_out, int out_size, void* d_ws, size_t ws_size, hipStream_t stream) {
    static int grid = 0;
    if (grid == 0) {
        if (n_in != 26 || ws_size < WS_END) { fprintf(stderr, "kernel_launch: unexpected shapes (n_in %d, ws %zu < %zu)\n", n_in, ws_size, (size_t)WS_END); grid = -1; return; }
        int dev = 0, cus = 0, per_cu = 0;
        hipGetDevice(&dev);
        hipDeviceGetAttribute(&cus, hipDeviceAttributeMultiprocessorCount, dev);
        if (hipFuncSetAttribute((const void*)fwd_kernel, hipFuncAttributeMaxDynamicSharedMemorySize, LDS_BYTES) != hipSuccess) { fprintf(stderr, "kernel_launch: hipFuncSetAttribute failed\n"); grid = -1; return; }
        hipOccupancyMaxActiveBlocksPerMultiprocessor(&per_cu, (const void*)fwd_kernel, 512, LDS_BYTES);
        (void)hipGetLastError();
        if (per_cu < 1) per_cu = 1;
        grid = cus * 1;
    }
    if (grid < 0) return;
    hipMemsetAsync((char*)d_ws + WS_CTL, 0, 65536, stream);
    KP p{};
    for (int i = 0; i < 26; ++i) p.in[i] = (const float*)d_in[i];
    p.out = (float*)d_out; p.ws = (unsigned char*)d_ws;
    void* args[] = {&p};
    hipError_t e = hipLaunchCooperativeKernel((const void*)fwd_kernel, dim3(grid), dim3(512), args, LDS_BYTES, stream);
    if (e != hipSuccess) fprintf(stderr, "cooperative launch failed: %s (grid %d)\n", hipGetErrorString(e), grid);
}
```

```cpp
#include <hip/hip_runtime.h>
#include <hip/hip_cooperative_groups.h>
#include <cstdio>
#include <cstdint>
namespace cg = cooperative_groups;

#ifndef USE_CG
#define USE_CG 0
#endif

#define LAS __attribute__((address_space(3)))
typedef unsigned short bf16_t;
typedef short bf16x8 __attribute__((ext_vector_type(8)));
typedef float f32x4 __attribute__((ext_vector_type(4)));
typedef float f32x16 __attribute__((ext_vector_type(16)));
typedef unsigned u32x4 __attribute__((ext_vector_type(4)));
typedef unsigned u32x2 __attribute__((ext_vector_type(2)));

constexpr int DM = 1024, MP = 16384, MS = 1024, MT = MP + MS, DEPTH = 4;
constexpr int INC = 5632, DFF = 2816, DSSM = 512;
constexpr int ZQ = 512, ZK = 1024, ZV = 1536, ZGR = 2560, ZGA = 3584, ZGB = 4608;
constexpr float EPSF = 1e-6f;
constexpr size_t O_YP = 0, O_YS = 16777216, O_SRP = 17825792, O_SIP = 17891328, O_RP = 17956864, O_CP = 22151168,
                 O_SRS = 22511616, O_SIS = 23560192, O_RS = 24608768, O_CS = 91717632;
constexpr size_t WS_CTL = 0;
constexpr size_t WS_WT = 65536;
constexpr size_t LW_IN = 0, LW_UP = 11534336, LW_DOWN = LW_UP + 11534336, LW_O = LW_DOWN + 5767168, LW_RET = LW_O + 2097152,
                 LW_SSM = LW_RET + 2097152, LW_GLU = LW_SSM + 2097152, LW_SIZE = LW_GLU + 524288;
constexpr size_t WS_S5T = WS_WT + 4 * LW_SIZE;
constexpr size_t S5_MB = 0, S5_BMT = 4194304, S5_CMT = S5_BMT + 131072, S5_LAM = S5_CMT + 131072, S5_LAM32 = S5_LAM + 16384, S5_SIZE = S5_LAM32 + 16384;
constexpr size_t WS_ROPE = WS_S5T + 4 * S5_SIZE;
constexpr size_t WS_X = WS_ROPE + 1052672;
constexpr size_t WS_H = WS_X + (size_t)MT * 1024 * 4;
constexpr size_t WS_Z = WS_H + (size_t)MT * 1024 * 2;
constexpr size_t WS_YA = WS_Z + (size_t)MT * INC * 2;
constexpr size_t WS_YA2 = WS_YA + (size_t)MT * 512 * 2;
constexpr size_t WS_O = WS_YA2 + (size_t)MT * 1024 * 2;
constexpr size_t WS_MIX = WS_O + (size_t)MT * 1024 * 2;
constexpr size_t WS_ACT = WS_MIX + (size_t)MT * 1024 * 2;
constexpr size_t WS_SIN = WS_ACT + (size_t)MT * DFF * 2;
constexpr size_t WS_RT = WS_SIN + (size_t)8 * 32 * 64 * 128 * 4;
constexpr size_t WS_E = WS_RT + (size_t)32 * 16 * 256 * 128 * 2;
constexpr size_t WS_END = WS_E + (size_t)8 * 32 * 8 * 128 * 4;

constexpr int LDS_BYTES = 147456;
constexpr int LDS_BARW = LDS_BYTES - 16;

#define GAS __attribute__((address_space(1)))
struct KP { const float* in[26]; float* out; unsigned char* ws; };
#if defined(__HIP_DEVICE_COMPILE__)
struct KPG { const GAS float* in[26]; GAS float* out; GAS unsigned char* ws; };
constexpr int LDS_TAB = LDS_BYTES - 16 - 256;
__device__ __forceinline__ unsigned long long ld_tab(const unsigned char* lds, int i) {
    unsigned off = (unsigned)(LDS_TAB + 8 * i); asm volatile("" : "+v"(off));
    const unsigned long long v = *(const LAS unsigned long long*)((const LAS unsigned char*)lds + off);
    const unsigned lo = __builtin_amdgcn_readfirstlane((unsigned)v), hi = __builtin_amdgcn_readfirstlane((unsigned)(v >> 32));
    return ((unsigned long long)hi << 32) | lo;
}
__device__ __forceinline__ KPG load_kp(const unsigned char* lds) {
    KPG q; asm volatile("" ::: "memory");
#pragma unroll
    for (int i = 0; i < 26; ++i) q.in[i] = (const GAS float*)ld_tab(lds, i);
    q.out = (GAS float*)ld_tab(lds, 26); q.ws = (GAS unsigned char*)ld_tab(lds, 27);
    return q;
}
__device__ __forceinline__ int fresh_tid() { int t = threadIdx.x; asm volatile("" : "+v"(t)); return t; }
__device__ __forceinline__ int fresh_bid() { int b = blockIdx.x; asm volatile("" : "+s"(b)); return b; }

__device__ __forceinline__ float bf2f(bf16_t b) { return __uint_as_float(((unsigned)b) << 16); }
__device__ __forceinline__ float bflo(unsigned w) { return __uint_as_float(w << 16); }
__device__ __forceinline__ float bfhi(unsigned w) { return __uint_as_float(w & 0xffff0000u); }
__device__ __forceinline__ bf16_t f2bf(float f) { unsigned u = __float_as_uint(f); u += 0x7FFFu + ((u >> 16) & 1u); return (bf16_t)(u >> 16); }
__device__ __forceinline__ unsigned pk2(float lo, float hi) { unsigned r; asm volatile("v_cvt_pk_bf16_f32 %0, %1, %2" : "=v"(r) : "v"(lo), "v"(hi)); return r; }
template <int CTRL> __device__ __forceinline__ float dppf(float x) { return __uint_as_float((unsigned)__builtin_amdgcn_update_dpp(0, (int)__float_as_uint(x), CTRL, 0xf, 0xf, false)); }
__device__ __forceinline__ float row_sum16(float x) {
    x += dppf<0xB1>(x); x += dppf<0x4E>(x); x += dppf<0x141>(x); x += dppf<0x140>(x); return x;
}
__device__ __forceinline__ float wave_sum(float v) {
    const float r = row_sum16(v);
    return (__builtin_amdgcn_readlane(r, 0) + __builtin_amdgcn_readlane(r, 16)) + (__builtin_amdgcn_readlane(r, 32) + __builtin_amdgcn_readlane(r, 48));
}
__device__ __forceinline__ float xor32(float x, int half) { const unsigned u = __float_as_uint(x); auto r = __builtin_amdgcn_permlane32_swap(u, u, false, false); return __uint_as_float(half ? r[0] : r[1]); }
__device__ __forceinline__ float sigmoidf_(float x) { return __builtin_amdgcn_rcpf(1.0f + __expf(-x)); }
__device__ __forceinline__ float siluf_(float x) { return x * __builtin_amdgcn_rcpf(1.0f + __expf(-x)); }
__device__ __forceinline__ float gelu_tanh(float x) { const float u = 0.7978845608028654f * (x + 0.044715f * x * x * x); return x * __builtin_amdgcn_rcpf(1.0f + __expf(-2.0f * u)); }
__device__ __forceinline__ void sincos_rev(float rev, float& s, float& c) {
    const float f = rev - rintf(rev);
    s = __builtin_amdgcn_sinf(f); c = __builtin_amdgcn_cosf(f);
}
#define LDS_WAIT() asm volatile("s_waitcnt lgkmcnt(0)" ::: "memory")
#define MFMA16(a, b, c) __builtin_amdgcn_mfma_f32_16x16x32_bf16((a), (b), (c), 0, 0, 0)
#define MFMA32(a, b, c) __builtin_amdgcn_mfma_f32_32x32x16_bf16((a), (b), (c), 0, 0, 0)
#define MFMA_SETTLE() do { __builtin_amdgcn_sched_barrier(0); asm volatile("s_nop 15\n\ts_nop 15\n\ts_nop 15\n\ts_nop 15" ::: "memory"); __builtin_amdgcn_sched_barrier(0); } while (0)

#define XB_TMO      128
#define XB_XCNT(j)  (256  + 64 * (j))
#define XB_XSUB(j)  (1280 + 64 * (j))
#define XB_XGEN(j)  (2304 + 64 * (j))
#define XB_TOP      3328
#define XB_TOPGEN   3392
#define XCD_BAR_WORDS 3456
#define XB_SPIN_CAP (1u << 22)
__device__ __forceinline__ unsigned xb_ld(unsigned* p)              { return __hip_atomic_load(p, __ATOMIC_RELAXED, __HIP_MEMORY_SCOPE_AGENT); }
__device__ __forceinline__ unsigned xb_add(unsigned* p, unsigned v) { return __hip_atomic_fetch_add(p, v, __ATOMIC_RELAXED, __HIP_MEMORY_SCOPE_AGENT); }
__device__ __forceinline__ unsigned xb_xcc_id() { return (unsigned)__builtin_amdgcn_s_getreg((3 << 11) | 20) & 0xFu; }
#define XB_SPIN(cond, bar) do { unsigned _sp = 0; while (cond) { __builtin_amdgcn_s_sleep(1); \
    if ((++_sp & 255u) == 0u) { if (xb_ld(&(bar)[XB_TMO])) break; if (_sp > XB_SPIN_CAP) { atomicAdd(&(bar)[XB_TMO], 1u); break; } } } } while (0)
struct XcdBarrier { unsigned* bar; unsigned x; volatile LAS unsigned* st; };
__device__ __forceinline__ XcdBarrier xcd_barrier_post(unsigned* bar, volatile LAS unsigned* st) {
    XcdBarrier b; b.bar = bar; b.x = xb_xcc_id(); b.st = st;
    if (threadIdx.x == 0) (void)xb_add(&bar[XB_XCNT(b.x)], 1u);
    return b;
}
__device__ __forceinline__ void xcd_barrier_complete(unsigned* bar, unsigned x, unsigned& nloc, unsigned& nx) {
    const unsigned G = gridDim.x * gridDim.y * gridDim.z;
    unsigned sum, cnt, mine, sp = 0u;
    for (;;) {
        sum = 0u; cnt = 0u; mine = 0u;
#pragma unroll
        for (unsigned j = 0; j < 16; ++j) { const unsigned c = xb_ld(&bar[XB_XCNT(j)]); sum += c; cnt += (c > 0u) ? 1u : 0u; mine = (j == x) ? c : mine; }
        if (sum == G) break;
        __builtin_amdgcn_s_sleep(1);
        if ((++sp & 255u) == 0u) { if (xb_ld(&bar[XB_TMO])) break; if (sp > XB_SPIN_CAP) { atomicAdd(&bar[XB_TMO], 1u); break; } }
    }
    nloc = mine > 0u ? mine : 1u; nx = cnt > 0u ? cnt : 1u;
}
__device__ __forceinline__ void xcd_barrier(const XcdBarrier& b) {
    asm volatile("s_waitcnt vmcnt(0)" ::: "memory");
    __syncthreads();
    if (threadIdx.x == 0) {
        unsigned* bar = b.bar;
        __builtin_amdgcn_s_waitcnt(0);
        unsigned nloc = b.st[0], nx = b.st[1];
        if (nloc == 0u) { xcd_barrier_complete(bar, b.x, nloc, nx); b.st[0] = nloc; b.st[1] = nx; }
        const unsigned old = xb_add(&bar[XB_XSUB(b.x)], 1u);
        const unsigned gen = old / nloc;
        if (old + 1u == (gen + 1u) * nloc) {
            __builtin_amdgcn_fence(__ATOMIC_RELEASE, "agent");
            asm volatile("s_waitcnt vmcnt(0)" ::: "memory");
            const unsigned og = xb_add(&bar[XB_TOP], 1u);
            const unsigned tg = og / nx;
            if (og + 1u == (tg + 1u) * nx) xb_add(&bar[XB_TOPGEN], 1u);
            else XB_SPIN(xb_ld(&bar[XB_TOPGEN]) == tg, bar);
            __builtin_amdgcn_fence(__ATOMIC_ACQUIRE, "agent");
            xb_add(&bar[XB_XGEN(b.x)], 1u);
            asm volatile("s_waitcnt vmcnt(0)" ::: "memory");
        } else {
            XB_SPIN(xb_ld(&bar[XB_XGEN(b.x)]) == gen, bar);
            __builtin_amdgcn_fence(__ATOMIC_ACQUIRE, "agent");
            asm volatile("s_waitcnt vmcnt(0)" ::: "memory");
        }
    }
    __syncthreads();
}

namespace pg8 {
constexpr int BM = 256, BK = 64, HALF = 128, HTB = HALF * BK * 2, STAGE_BYTES = 8 * HTB, NXCD = 8, WGM = 8;
__device__ __forceinline__ int lds_byte(int r, int c) { const int st = (r >> 4) * 2 + (c >> 5), rr = r & 15, cc = c & 31, ob = rr * 64 + cc * 2; return st * 1024 + (ob ^ (((ob >> 9) & 1) << 5)); }
__device__ __forceinline__ void stage_rc(int b, int& R, int& C) { const int st = b / 1024, sb = b % 1024, swz = sb ^ (((sb >> 9) & 1) << 5); R = (st >> 1) * 16 + swz / 64; C = (st & 1) * 32 + (swz % 64) / 2; }
__device__ __forceinline__ int perm32(int rho) { const int n = rho >> 4, i = rho & 15; return 8 * (i >> 2) + 4 * n + (i & 3); }

struct Unit { const char* A; const char* B; int nt, mode, pm, pn; };
struct Sched {
    const char *A0, *B0, *A1, *B1; int nt0, nt1, ld, nM, nN, G, c;
    __device__ __forceinline__ bool next(int i, Unit& u) const {
        const int dual = (A1 != nullptr) ? 1 : 0; const int ti = dual ? (i >> 1) : i, sub = dual ? (i & 1) : 0;
        const int nwg = nM * nN; const long L = (long)ti * G + c; if (L >= nwg) return false;
        int wgid = (int)L; { const int q = nwg / NXCD, r = nwg % NXCD, xcd = wgid % NXCD, off = wgid / NXCD; wgid = (xcd < r ? xcd * (q + 1) : r * (q + 1) + (xcd - r) * q) + off; }
        const int nig = WGM * nN, gid = wgid / nig, fm = gid * WGM, gsz = (nM - fm) < WGM ? (nM - fm) : WGM;
        u.pm = fm + ((wgid % nig) % gsz); u.pn = (wgid % nig) / gsz;
        const size_t tstep = (size_t)BM * ld * 2;
        u.A = (sub ? A1 : A0) + (size_t)u.pm * tstep; u.B = (sub ? B1 : B0) + (size_t)u.pn * tstep; u.nt = sub ? nt1 : nt0; u.mode = dual ? (sub ? 2 : 1) : 0;
        return true;
    }
};
typedef f32x4 Acc[2][2][4][2];

template <class Epi>
__device__ __forceinline__ void gemm_phase(LAS unsigned char* lds, const Sched& S, const Epi& E) {
    const int tid = fresh_tid(), wid = __builtin_amdgcn_readfirstlane(tid >> 6), lane = tid & 63, wr = wid >> 2, wc = wid & 3, fr = lane & 15, fq = lane >> 4;
    const int ld = S.ld;
    unsigned voffA[2], voffB[2];
#pragma unroll
    for (int i = 0; i < 2; ++i) { int R, C; stage_rc(tid * 16 + i * 8192, R, C); const int Rb = (R & ~31) + perm32(R & 31);
        voffA[i] = (unsigned)(R * ld + C) * 2u; voffB[i] = (unsigned)(Rb * ld + C) * 2u; }
    const size_t kstep = (size_t)(BK * 2);
    const size_t hstep = (size_t)HALF * ld * 2;
    const unsigned ldsw = (unsigned)wid * 1024u;
    const int aoff = lds_byte(wr * 64 + fr, fq * 8), boff = lds_byte(wc * 32 + fr, fq * 8);
#define PG8_SA(b, h) (((b) * 2 + (h)) * HTB)
#define PG8_SB(b, h) ((4 + (b) * 2 + (h)) * HTB)
#define PG8_STAGE(bufoff, gbase, voff) do { _Pragma("unroll") for (int _i = 0; _i < 2; ++_i) \
        __builtin_amdgcn_global_load_lds((const unsigned*)((const char*)(gbase) + (voff)[_i]), (LAS unsigned*)(lds + (bufoff) + ldsw + _i * 8192), 16, 0, 0); } while (0)
#define PG8_LDA(dst, b, h) do { _Pragma("unroll") for (int m = 0; m < 4; ++m) _Pragma("unroll") for (int k = 0; k < 2; ++k) dst[m][k] = *(const LAS bf16x8*)(lds + PG8_SA(b, h) + aoff + m * 2048 + k * 1024); } while (0)
#define PG8_LDB(dst, b, h) do { _Pragma("unroll") for (int n = 0; n < 2; ++n) _Pragma("unroll") for (int k = 0; k < 2; ++k) dst[n][k] = *(const LAS bf16x8*)(lds + PG8_SB(b, h) + boff + n * 2048 + k * 1024); } while (0)
#define PG8_MMA(ai, bj, At, Bt) do { __builtin_amdgcn_s_setprio(1); _Pragma("unroll") for (int m = 0; m < 4; ++m) _Pragma("unroll") for (int n = 0; n < 2; ++n) _Pragma("unroll") for (int k = 0; k < 2; ++k) \
        acc[ai][bj][m][n] = __builtin_amdgcn_mfma_f32_16x16x32_bf16(Bt[n][k], At[m][k], acc[ai][bj][m][n], 0, 0, 0); __builtin_amdgcn_s_setprio(0); } while (0)
#define PG8_WAIT_V(n) asm volatile("s_waitcnt vmcnt(" #n ")" ::: "memory")
#define PG8_WAIT_L(n) asm volatile("s_waitcnt lgkmcnt(" #n ")" ::: "memory")
#define PG8_BAR __builtin_amdgcn_s_barrier()
#define PG8_SCHED __builtin_amdgcn_sched_barrier(0)
    Unit cur, nxt; int ui = 0;
    if (!S.next(0, cur)) return;
    Acc acc;
#pragma unroll
    for (int a = 0; a < 2; ++a)
#pragma unroll
        for (int b = 0; b < 2; ++b)
#pragma unroll
            for (int m = 0; m < 4; ++m)
#pragma unroll
                for (int n = 0; n < 2; ++n) acc[a][b][m][n] = (f32x4){0.f, 0.f, 0.f, 0.f};
    bf16x8 At[4][2], B0[2][2], B1[2][2];
    const char* cA = cur.A; const char* cB = cur.B;
    PG8_STAGE(PG8_SB(0, 0), cB, voffB); PG8_STAGE(PG8_SA(0, 0), cA, voffA); PG8_STAGE(PG8_SB(0, 1), cB + hstep, voffB); PG8_STAGE(PG8_SA(0, 1), cA + hstep, voffA);
    if (wr == 1) PG8_BAR;
    PG8_WAIT_V(4); PG8_BAR;
    PG8_STAGE(PG8_SB(1, 0), cB + kstep, voffB); PG8_STAGE(PG8_SA(1, 0), cA + kstep, voffA); PG8_STAGE(PG8_SB(1, 1), cB + hstep + kstep, voffB);
    PG8_WAIT_V(6); PG8_BAR;
    for (;;) {
        const bool has_next = S.next(ui + 1, nxt);
        const char* nA = has_next ? nxt.A : cA; const char* nB = has_next ? nxt.B : cB;
        const int nt = cur.nt;
        for (int t = 0; t < nt; t += 2) {
            const bool last = (t == nt - 2);
            const char* a1 = cA + (size_t)(t + 1) * kstep;
            const char* a2 = last ? nA : cA + (size_t)(t + 2) * kstep; const char* b2 = last ? nB : cB + (size_t)(t + 2) * kstep;
            const char* a3 = a2 + kstep; const char* b3 = b2 + kstep;
            PG8_LDB(B0, 0, 0); PG8_SCHED; PG8_LDA(At, 0, 0); PG8_STAGE(PG8_SA(1, 1), a1 + hstep, voffA);
            PG8_WAIT_L(8); PG8_BAR; PG8_WAIT_L(0); PG8_MMA(0, 0, At, B0); PG8_BAR; PG8_SCHED;
            PG8_LDB(B1, 0, 1); PG8_STAGE(PG8_SB(0, 0), b2, voffB);
            PG8_BAR; PG8_WAIT_L(0); PG8_MMA(0, 1, At, B1); PG8_BAR;
            PG8_LDA(At, 0, 1); PG8_STAGE(PG8_SA(0, 0), a2, voffA);
            PG8_BAR; PG8_WAIT_L(0); PG8_MMA(1, 0, At, B0); PG8_BAR; PG8_SCHED;
            PG8_STAGE(PG8_SB(0, 1), b2 + hstep, voffB);
            PG8_WAIT_V(6); PG8_BAR; PG8_MMA(1, 1, At, B1); PG8_BAR;
            PG8_LDB(B0, 1, 0); PG8_SCHED; PG8_LDA(At, 1, 0); PG8_STAGE(PG8_SA(0, 1), a2 + hstep, voffA);
            PG8_WAIT_L(8); PG8_BAR; PG8_WAIT_L(0); PG8_MMA(0, 0, At, B0); PG8_BAR; PG8_SCHED;
            PG8_LDB(B1, 1, 1); PG8_STAGE(PG8_SB(1, 0), b3, voffB);
            PG8_BAR; PG8_WAIT_L(0); PG8_MMA(0, 1, At, B1); PG8_BAR;
            PG8_LDA(At, 1, 1); PG8_STAGE(PG8_SA(1, 0), a3, voffA);
            PG8_BAR; PG8_WAIT_L(0); PG8_MMA(1, 0, At, B0); PG8_BAR; PG8_SCHED;
            PG8_STAGE(PG8_SB(1, 1), b3 + hstep, voffB);
            PG8_WAIT_V(6); PG8_BAR; PG8_MMA(1, 1, At, B1); PG8_BAR;
        }
        MFMA_SETTLE();
        E(acc, cur, wr, wc, fr, fq);
        if (!has_next) break;
        if (cur.mode != 1) {
#pragma unroll
            for (int a = 0; a < 2; ++a)
#pragma unroll
                for (int b = 0; b < 2; ++b)
#pragma unroll
                    for (int m = 0; m < 4; ++m)
#pragma unroll
                        for (int n = 0; n < 2; ++n) acc[a][b][m][n] = (f32x4){0.f, 0.f, 0.f, 0.f};
        }
        cur = nxt; cA = nA; cB = nB; ++ui;
    }
    PG8_WAIT_V(0);
    if (wr == 0) PG8_BAR;
    PG8_BAR;
#undef PG8_SA
#undef PG8_SB
#undef PG8_STAGE
#undef PG8_LDA
#undef PG8_LDB
#undef PG8_MMA
#undef PG8_WAIT_V
#undef PG8_WAIT_L
#undef PG8_BAR
#undef PG8_SCHED
}

#define EPI_ROWS_BEGIN \
    _Pragma("unroll") for (int ai = 0; ai < 2; ++ai) _Pragma("unroll") for (int m = 0; m < 4; ++m) { const int row = u.pm * 256 + ai * 128 + wr * 64 + m * 16 + fr; \
    _Pragma("unroll") for (int bj = 0; bj < 2; ++bj) { const int col = u.pn * 256 + bj * 128 + wc * 32 + 8 * fq; f32x4& v0 = acc[ai][bj][m][0]; f32x4& v1 = acc[ai][bj][m][1];
#define EPI_ROWS_END } __builtin_amdgcn_sched_barrier(0); }

struct EpiStoreBf16 {
    bf16_t* O; int ldc;
    __device__ __forceinline__ void operator()(Acc& acc, const Unit& u, int wr, int wc, int fr, int fq) const {
        EPI_ROWS_BEGIN
            u32x4 w; w.x = pk2(v0[0], v0[1]); w.y = pk2(v0[2], v0[3]); w.z = pk2(v1[0], v1[1]); w.w = pk2(v1[2], v1[3]);
            *(u32x4*)(O + (size_t)row * ldc + col) = w;
        EPI_ROWS_END
    }
};
struct EpiGlu {
    const bf16_t* ya; bf16_t* ya2;
    __device__ __forceinline__ void operator()(Acc& acc, const Unit& u, int wr, int wc, int fr, int fq) const {
        EPI_ROWS_BEGIN
            const u32x4 y = *(const u32x4*)(ya + (size_t)row * 512 + col);
            u32x4 w;
            w.x = pk2(bflo(y.x) * sigmoidf_(v0[0]), bfhi(y.x) * sigmoidf_(v0[1]));
            w.y = pk2(bflo(y.y) * sigmoidf_(v0[2]), bfhi(y.y) * sigmoidf_(v0[3]));
            w.z = pk2(bflo(y.z) * sigmoidf_(v1[0]), bfhi(y.z) * sigmoidf_(v1[1]));
            w.w = pk2(bflo(y.w) * sigmoidf_(v1[2]), bfhi(y.w) * sigmoidf_(v1[3]));
            *(u32x4*)(ya2 + (size_t)row * 1024 + col) = w;
        EPI_ROWS_END
    }
};
struct EpiMix {
    const bf16_t* z; bf16_t* mix;
    __device__ __forceinline__ void operator()(Acc& acc, const Unit& u, int wr, int wc, int fr, int fq) const {
        if (u.mode == 1) {
            EPI_ROWS_BEGIN
                const u32x4 ga = *(const u32x4*)(z + (size_t)row * INC + ZGA + col);
                const u32x4 gb = *(const u32x4*)(z + (size_t)row * INC + ZGB + col);
#define RATIO(a, b) ((1.0f + __expf(-(b))) * __builtin_amdgcn_rcpf(1.0f + __expf(-(a))))
                v0[0] *= RATIO(bflo(ga.x), bflo(gb.x)); v0[1] *= RATIO(bfhi(ga.x), bfhi(gb.x));
                v0[2] *= RATIO(bflo(ga.y), bflo(gb.y)); v0[3] *= RATIO(bfhi(ga.y), bfhi(gb.y));
                v1[0] *= RATIO(bflo(ga.z), bflo(gb.z)); v1[1] *= RATIO(bfhi(ga.z), bfhi(gb.z));
                v1[2] *= RATIO(bflo(ga.w), bflo(gb.w)); v1[3] *= RATIO(bfhi(ga.w), bfhi(gb.w));
#undef RATIO
            EPI_ROWS_END
        } else {
            EPI_ROWS_BEGIN
                const u32x4 gb = *(const u32x4*)(z + (size_t)row * INC + ZGB + col);
                u32x4 w;
                w.x = pk2(v0[0] * sigmoidf_(bflo(gb.x)), v0[1] * sigmoidf_(bfhi(gb.x)));
                w.y = pk2(v0[2] * sigmoidf_(bflo(gb.y)), v0[3] * sigmoidf_(bfhi(gb.y)));
                w.z = pk2(v1[0] * sigmoidf_(bflo(gb.z)), v1[1] * sigmoidf_(bfhi(gb.z)));
                w.w = pk2(v1[2] * sigmoidf_(bflo(gb.w)), v1[3] * sigmoidf_(bfhi(gb.w)));
                *(u32x4*)(mix + (size_t)row * 1024 + col) = w;
            EPI_ROWS_END
        }
    }
};
struct EpiRes {
    const float* xinP; const float* xinS; float* xout;
    __device__ __forceinline__ void operator()(Acc& acc, const Unit& u, int wr, int wc, int fr, int fq) const {
        EPI_ROWS_BEGIN
            const float* xi = (row < MP ? xinP + (size_t)row * 1024 : xinS + (size_t)(row - MP) * 1024) + col;
            const f32x4 a = *(const f32x4*)xi, b = *(const f32x4*)(xi + 4);
            float* xo = xout + (size_t)row * 1024 + col;
            *(f32x4*)xo = a + v0; *(f32x4*)(xo + 4) = b + v1;
        EPI_ROWS_END
    }
};
struct EpiUp {
    bf16_t* up; float* convP; float* convS;
    __device__ __forceinline__ void operator()(Acc& acc, const Unit& u, int wr, int wc, int fr, int fq) const {
        EPI_ROWS_BEGIN
            u32x4 w; w.x = pk2(v0[0], v0[1]); w.y = pk2(v0[2], v0[3]); w.z = pk2(v1[0], v1[1]); w.w = pk2(v1[2], v1[3]);
            *(u32x4*)(up + (size_t)row * INC + col) = w;
            float* cp = nullptr;
            if (row < MP) { const int t = row & 2047; if (t >= 2046) cp = convP + ((size_t)((row >> 11) * 2 + (t - 2046))) * INC + col; }
            else { const int r2 = row - MP, t = r2 & 7; if (t >= 6) cp = convS + ((size_t)((r2 >> 3) * 2 + (t - 6))) * INC + col; }
            if (cp) { *(f32x4*)cp = v0; *(f32x4*)(cp + 4) = v1; }
        EPI_ROWS_END
    }
};
}

__device__ __forceinline__ void transpose_item(const float* W, int K, int N, bf16_t* WT, int ldd, const float* gk, float* scr, int item, int lane) {
    const int nblk = N / 32, kb = item / nblk, nb = item % nblk, k0 = 64 * kb, n0 = 32 * nb;
#pragma unroll 8
    for (int i = 0; i < 32; ++i) { const int kk = 2 * i + (lane >> 5); float v = W[(size_t)(k0 + kk) * N + n0 + (lane & 31)]; if (gk) v *= gk[k0 + kk]; scr[kk * 33 + (lane & 31)] = v; }
    LDS_WAIT();
    const int c = lane & 7;
#pragma unroll
    for (int j = 0; j < 4; ++j) { const int n = (lane >> 3) + 8 * j; const float* s = scr + (8 * c) * 33 + n;
        u32x4 o; o.x = pk2(s[0 * 33], s[1 * 33]); o.y = pk2(s[2 * 33], s[3 * 33]); o.z = pk2(s[4 * 33], s[5 * 33]); o.w = pk2(s[6 * 33], s[7 * 33]);
        *(u32x4*)(WT + (size_t)(n0 + n) * ldd + k0 + 8 * c) = o; }
    LDS_WAIT();
}

__device__ __forceinline__ void rms_row_to_bf16(const float* xrow, bf16_t* orow, int lane) {
    const f32x4* xr = (const f32x4*)xrow + lane;
    f32x4 v[4]; float s = 0.f;
#pragma unroll
    for (int j = 0; j < 4; ++j) { v[j] = xr[64 * j]; s += (v[j].x * v[j].x + v[j].y * v[j].y) + (v[j].z * v[j].z + v[j].w * v[j].w); }
    const float rstd = rsqrtf(wave_sum(s) * (1.f / 1024.f) + EPSF);
    u32x2* o8 = (u32x2*)orow + lane;
#pragma unroll
    for (int j = 0; j < 4; ++j) { u32x2 w; w.x = pk2(v[j].x * rstd, v[j].y * rstd); w.y = pk2(v[j].z * rstd, v[j].w * rstd); o8[64 * j] = w; }
}

__device__ __forceinline__ void phase_rmsnorm(const KPG& p, int l, int wave, int lane) {
    const float* xb = (const float*)(p.ws + WS_X); bf16_t* h = (bf16_t*)(p.ws + WS_H);
    for (int row = fresh_bid() * 8 + wave; row < MT; row += gridDim.x * 8) {
        const float* xr = (l == 0) ? (row < MP ? p.in[0] + (size_t)row * 1024 : p.in[1] + (size_t)(row - MP) * 1024) : xb + (size_t)row * 1024;
        rms_row_to_bf16(xr, h + (size_t)row * 1024, lane);
    }
}

__device__ __forceinline__ void phase_prologue(const KPG& p, int l, unsigned char* lds, int wave, int lane) {
    float* scr = (float*)(lds + wave * 8448);
    const int gw = fresh_bid() * 8 + wave, NGW = gridDim.x * 8;
    constexpr int I_IN = 16 * 176, I_UP = 16 * 176, I_DN = 44 * 32, I_O = 16 * 32, I_RET = 16 * 32, I_SSM = 8 * 32, I_GLU = 8 * 16;
    constexpr int I_L = I_IN + I_UP + I_DN + I_O + I_RET + I_SSM + I_GLU;
    for (int it = gw; it < I_L; it += NGW) {
        int r = it;
        unsigned char* wl = p.ws + WS_WT + (size_t)l * LW_SIZE;
        if (r < I_IN) { transpose_item(p.in[7] + (size_t)l * 1024 * INC, 1024, INC, (bf16_t*)(wl + LW_IN), 1024, p.in[6] + l * 1024, scr, r, lane); continue; } r -= I_IN;
        if (r < I_UP) { transpose_item(p.in[21] + (size_t)l * 1024 * INC, 1024, INC, (bf16_t*)(wl + LW_UP), 1024, p.in[20] + l * 1024, scr, r, lane); continue; } r -= I_UP;
        if (r < I_DN) { transpose_item(p.in[24] + (size_t)l * DFF * 1024, DFF, 1024, (bf16_t*)(wl + LW_DOWN), DFF, nullptr, scr, r, lane); continue; } r -= I_DN;
        if (r < I_O) { transpose_item(p.in[19] + (size_t)l * 1024 * 1024, 1024, 1024, (bf16_t*)(wl + LW_O), 1024, nullptr, scr, r, lane); continue; } r -= I_O;
        if (r < I_RET) { transpose_item(p.in[18] + (size_t)l * 1024 * 1024, 1024, 1024, (bf16_t*)(wl + LW_RET), 1024, nullptr, scr, r, lane); continue; } r -= I_RET;
        if (r < I_SSM) { transpose_item(p.in[17] + (size_t)l * 512 * 1024, 512, 1024, (bf16_t*)(wl + LW_SSM), 1024, nullptr, scr, r, lane); continue; } r -= I_SSM;
        transpose_item(p.in[16] + (size_t)l * 512 * 512, 512, 512, (bf16_t*)(wl + LW_GLU), 512, nullptr, scr, r, lane);
    }
    const int gt = fresh_bid() * 512 + fresh_tid(), NGT = gridDim.x * 512;
    for (int it = gt; it < 32 * 64; it += NGT) {
        const int pp = it & 63, g = (it >> 6) & 31;
        const int gi = l * 32 + g, pi = gi * 64 + pp;
        const float dt = __expf(p.in[10][gi]), lr = p.in[8][pi], li = p.in[9][pi];
        float s1, c1; sincos_rev(li * dt * 0.15915494309189535f, s1, c1);
        const float m1 = __expf(lr * dt); const float lbr = m1 * c1, lbi = m1 * s1;
        const float nr = lbr - 1.0f, ni = lbi, den = 1.0f / (lr * lr + li * li);
        const float cr = (nr * lr + ni * li) * den, ci = (ni * lr - nr * li) * den;
        unsigned char* st = p.ws + WS_S5T + (size_t)l * S5_SIZE;
        const float* bre = p.in[11] + (size_t)pi * 16; const float* bim = p.in[12] + (size_t)pi * 16;
        bf16_t* bmre = (bf16_t*)(st + S5_BMT) + (size_t)(g * 128 + pp) * 16; bf16_t* bmim = (bf16_t*)(st + S5_BMT) + (size_t)(g * 128 + 64 + pp) * 16;
#pragma unroll
        for (int c = 0; c < 16; ++c) { const float br = bre[c], bi = bim[c]; bmre[c] = f2bf(cr * br - ci * bi); bmim[c] = f2bf(cr * bi + ci * br); }
        float2* lam = (float2*)(st + S5_LAM) + g * 64 + pp; *lam = make_float2(lbr, lbi);
        float s32, c32; sincos_rev(32.0f * li * dt * 0.15915494309189535f, s32, c32); const float m32 = __expf(32.0f * lr * dt);
        float2* lam32 = (float2*)(st + S5_LAM32) + g * 64 + pp; *lam32 = make_float2(m32 * c32, m32 * s32);
    }
    for (int it = gt; it < 32 * 16 * 128; it += NGT) {
        const int pq = it & 127, c = (it >> 7) & 15, g = (it >> 11) & 31;
        const size_t src = ((size_t)((l * 32 + g) * 16 + c)) * 64 + (pq & 63);
        const float v = pq < 64 ? p.in[13][src] : -p.in[14][src];
        ((bf16_t*)(p.ws + WS_S5T + (size_t)l * S5_SIZE + S5_CMT))[(g * 16 + c) * 128 + pq] = f2bf(v);
    }
    for (int it = gt; it < 2056 * 64; it += NGT) {
        const int j = it & 63, pi = it >> 6; const double pos = (double)(pi < 2048 ? pi : 16384 + pi - 2048);
        double inv = 1.0, r = 0.86596432336006535;
        int e = j;
#pragma unroll
        for (int b = 0; b < 6; ++b) { if (e & 1) inv *= r; r *= r; e >>= 1; }
        const double rev = pos * inv * 0.15915494309189535; const double fr_ = rev - __builtin_rint(rev);
        const float f = (float)fr_;
        ((float2*)(p.ws + WS_ROPE))[it] = make_float2(__builtin_amdgcn_cosf(f), __builtin_amdgcn_sinf(f));
    }
}

template <bool SAMPLE>
__device__ __forceinline__ void s5_tile(const KPG& p, int l, int g, int row0, int bseq, int chunk, bf16_t* Sl, int lane) {
    const bf16_t* z = (const bf16_t*)(p.ws + WS_Z); bf16_t* ya = (bf16_t*)(p.ws + WS_YA);
    const unsigned char* st = p.ws + WS_S5T + (size_t)l * S5_SIZE;
    const int half = lane >> 5, li = lane & 31;
    const bf16x8 uf = *(const bf16x8*)(z + (size_t)(row0 + li) * INC + g * 16 + 8 * half);
    f32x16 acc[4];
#pragma unroll
    for (int ct = 0; ct < 4; ++ct) {
        const bf16x8 bfr = *(const bf16x8*)((const bf16_t*)(st + S5_BMT) + (size_t)(g * 128 + ct * 32 + li) * 16 + 8 * half);
        f32x16 zz;
#pragma unroll
        for (int e = 0; e < 16; ++e) zz[e] = 0.f;
        acc[ct] = MFMA32(uf, bfr, zz);
    }
    MFMA_SETTLE();
    float2 lm[2]; lm[0] = ((const float2*)(st + S5_LAM))[g * 64 + li]; lm[1] = ((const float2*)(st + S5_LAM))[g * 64 + 32 + li];
    float sr[2] = {0.f, 0.f}, si[2] = {0.f, 0.f};
    const float* sin_ = (const float*)(p.ws + WS_SIN);
#pragma unroll
    for (int k = 0; k < 4; ++k) {
        if (SAMPLE || k == 0) {
#pragma unroll
            for (int pt = 0; pt < 2; ++pt) {
                if (SAMPLE) { const size_t o = ((size_t)((l * 128 + bseq + k) * 32 + g)) * 64 + pt * 32 + li; sr[pt] = p.in[2][o]; si[pt] = p.in[3][o]; }
                else {
                    const int sc = chunk >> 3, jj = chunk & 7;
                    const float2 l32 = ((const float2*)(st + S5_LAM32))[g * 64 + pt * 32 + li];
                    const float2 l64 = make_float2(l32.x * l32.x - l32.y * l32.y, 2.0f * l32.x * l32.y);
                    const float2 l128 = make_float2(l64.x * l64.x - l64.y * l64.y, 2.0f * l64.x * l64.y);
                    const float2 l256 = make_float2(l128.x * l128.x - l128.y * l128.y, 2.0f * l128.x * l128.y);
                    const float* Eb = (const float*)(p.ws + WS_E) + ((size_t)((bseq * 32 + g) * 8)) * 128 + pt * 32 + li;
                    float Sr = 0.f, Si = 0.f;
#pragma unroll
                    for (int i = 0; i < 7; ++i) { if (i < sc) { const float er = Eb[i * 128], ei = Eb[i * 128 + 64]; const float tr = l256.x * Sr - l256.y * Si + er, ti = l256.x * Si + l256.y * Sr + ei; Sr = tr; Si = ti; } }
                    float rr = 1.0f, ri = 0.0f;
                    if (jj & 1) { const float tr = rr * l32.x - ri * l32.y, ti = rr * l32.y + ri * l32.x; rr = tr; ri = ti; }
                    if (jj & 2) { const float tr = rr * l64.x - ri * l64.y, ti = rr * l64.y + ri * l64.x; rr = tr; ri = ti; }
                    if (jj & 4) { const float tr = rr * l128.x - ri * l128.y, ti = rr * l128.y + ri * l128.x; rr = tr; ri = ti; }
                    const size_t o = ((size_t)((bseq * 32 + g) * 64 + chunk)) * 128 + pt * 32 + li;
                    sr[pt] = sin_[o] + (rr * Sr - ri * Si); si[pt] = sin_[o + 64] + (rr * Si + ri * Sr);
                }
            }
        }
#pragma unroll
        for (int hh = 0; hh < 2; ++hh) {
            const bool mine = (half == hh);
            float tr_[2] = {sr[0], sr[1]}, ti_[2] = {si[0], si[1]};
#pragma unroll
            for (int q = 0; q < 4; ++q)
#pragma unroll
                for (int pt = 0; pt < 2; ++pt) {
                    const float tr = lm[pt].x * tr_[pt] - lm[pt].y * ti_[pt] + acc[pt][4 * k + q];
                    const float ti = lm[pt].x * ti_[pt] + lm[pt].y * tr_[pt] + acc[2 + pt][4 * k + q];
                    tr_[pt] = tr; ti_[pt] = ti;
                    acc[pt][4 * k + q] = mine ? tr : acc[pt][4 * k + q]; acc[2 + pt][4 * k + q] = mine ? ti : acc[2 + pt][4 * k + q];
                }
#pragma unroll
            for (int pt = 0; pt < 2; ++pt) { sr[pt] = mine ? tr_[pt] : sr[pt]; si[pt] = mine ? ti_[pt] : si[pt]; }
            if (SAMPLE && hh == 1) {
                if (mine) {
#pragma unroll
                    for (int pt = 0; pt < 2; ++pt) { const size_t o = ((size_t)((l * 128 + bseq + k) * 32 + g)) * 64 + pt * 32 + li;
                        p.out[O_SRS + o] = sr[pt]; p.out[O_SIS + o] = si[pt]; }
                }
            }
#pragma unroll
            for (int pt = 0; pt < 2; ++pt) { const float orr = xor32(sr[pt], half), oii = xor32(si[pt], half); sr[pt] = mine ? sr[pt] : orr; si[pt] = mine ? si[pt] : oii; }
        }
    }
    if (!SAMPLE && chunk == 63 && half == 0) {
#pragma unroll
        for (int pt = 0; pt < 2; ++pt) { const size_t o = ((size_t)((l * 8 + bseq) * 32 + g)) * 64 + pt * 32 + li; p.out[O_SRP + o] = sr[pt]; p.out[O_SIP + o] = si[pt]; }
    }
#pragma unroll
    for (int ct = 0; ct < 4; ++ct)
#pragma unroll
        for (int r = 0; r < 16; ++r) { const int t = (r & 3) + 8 * (r >> 2) + 4 * half; Sl[t * 136 + ct * 32 + li] = f2bf(acc[ct][r]); }
    LDS_WAIT();
    const int fr = lane & 15, fq = lane >> 4;
    bf16x8 cf[4];
#pragma unroll
    for (int ks = 0; ks < 4; ++ks) cf[ks] = *(const bf16x8*)((const bf16_t*)(st + S5_CMT) + (size_t)(g * 16 + fr) * 128 + ks * 32 + 8 * fq);
    const float dv = p.in[15][l * 512 + g * 16 + fr];
#pragma unroll
    for (int rt = 0; rt < 2; ++rt) {
        f32x4 y = {0.f, 0.f, 0.f, 0.f};
#pragma unroll
        for (int ks = 0; ks < 4; ++ks) { const bf16x8 a = *(const bf16x8*)(Sl + (rt * 16 + fr) * 136 + ks * 32 + 8 * fq); y = MFMA16(a, cf[ks], y); }
        MFMA_SETTLE();
#pragma unroll
        for (int r = 0; r < 4; ++r) { const int tok = row0 + rt * 16 + 4 * fq + r; const float uu = bf2f(z[(size_t)tok * INC + g * 16 + fr]);
            ya[(size_t)tok * 512 + g * 16 + fr] = f2bf(gelu_tanh(y[r] + dv * uu)); }
    }
    LDS_WAIT();
}

__device__ __forceinline__ void s5_m1(const KPG& p, int l, int b, int g, int sc, int lane) {
    const bf16_t* z = (const bf16_t*)(p.ws + WS_Z);
    const unsigned char* st = p.ws + WS_S5T + (size_t)l * S5_SIZE;
    const int half = lane >> 5, li = lane & 31;
    bf16x8 bfr[4];
#pragma unroll
    for (int ct = 0; ct < 4; ++ct) bfr[ct] = *(const bf16x8*)((const bf16_t*)(st + S5_BMT) + (size_t)(g * 128 + ct * 32 + li) * 16 + 8 * half);
    float2 lm[2]; lm[0] = ((const float2*)(st + S5_LAM))[g * 64 + li]; lm[1] = ((const float2*)(st + S5_LAM))[g * 64 + 32 + li];
    float sr[2] = {0.f, 0.f}, si[2] = {0.f, 0.f};
    float* sin_ = (float*)(p.ws + WS_SIN);
    for (int j = 0; j < 8; ++j) {
        const int chunk = sc * 8 + j, row0 = b * 2048 + chunk * 32;
        const bf16x8 uf = *(const bf16x8*)(z + (size_t)(row0 + li) * INC + g * 16 + 8 * half);
        if (half == 0) {
#pragma unroll
            for (int pt = 0; pt < 2; ++pt) { const size_t o = ((size_t)((b * 32 + g) * 64 + chunk)) * 128 + pt * 32 + li; sin_[o] = sr[pt]; sin_[o + 64] = si[pt]; }
        }
        f32x16 acc[4];
#pragma unroll
        for (int ct = 0; ct < 4; ++ct) {
            f32x16 zz;
#pragma unroll
            for (int e = 0; e < 16; ++e) zz[e] = 0.f;
            acc[ct] = MFMA32(uf, bfr[ct], zz);
        }
        MFMA_SETTLE();
#pragma unroll
        for (int k = 0; k < 4; ++k)
#pragma unroll
            for (int hh = 0; hh < 2; ++hh) {
                const bool mine = (half == hh);
                float tr_[2] = {sr[0], sr[1]}, ti_[2] = {si[0], si[1]};
#pragma unroll
                for (int q = 0; q < 4; ++q)
#pragma unroll
                    for (int pt = 0; pt < 2; ++pt) {
                        const float tr = lm[pt].x * tr_[pt] - lm[pt].y * ti_[pt] + acc[pt][4 * k + q];
                        const float ti = lm[pt].x * ti_[pt] + lm[pt].y * tr_[pt] + acc[2 + pt][4 * k + q];
                        tr_[pt] = tr; ti_[pt] = ti;
                    }
#pragma unroll
                for (int pt = 0; pt < 2; ++pt) { sr[pt] = mine ? tr_[pt] : sr[pt]; si[pt] = mine ? ti_[pt] : si[pt]; }
#pragma unroll
                for (int pt = 0; pt < 2; ++pt) { const float orr = xor32(sr[pt], half), oii = xor32(si[pt], half); sr[pt] = mine ? sr[pt] : orr; si[pt] = mine ? si[pt] : oii; }
            }
    }
    if (half == 0) {
        float* E = (float*)(p.ws + WS_E) + ((size_t)((b * 32 + g) * 8 + sc)) * 128;
#pragma unroll
        for (int pt = 0; pt < 2; ++pt) { E[pt * 32 + li] = sr[pt]; E[64 + pt * 32 + li] = si[pt]; }
    }
}

__device__ __forceinline__ float log2_gamma(int h) { return __log2f(1.0f - exp2f(-5.0f - (float)h)); }

__device__ __forceinline__ void rot8(const u32x4& lo, const u32x4& hi, const float2* rp, float scale, float* olo, float* ohi) {
    const unsigned lw[4] = {lo.x, lo.y, lo.z, lo.w}, hw[4] = {hi.x, hi.y, hi.z, hi.w};
#pragma unroll
    for (int e = 0; e < 8; ++e) {
        const float x1 = (e & 1) ? bfhi(lw[e >> 1]) : bflo(lw[e >> 1]);
        const float x2 = (e & 1) ? bfhi(hw[e >> 1]) : bflo(hw[e >> 1]);
        const float2 cs = rp[e];
        olo[e] = (x1 * cs.x - x2 * cs.y) * scale; ohi[e] = (x1 * cs.y + x2 * cs.x) * scale;
    }
}

__device__ __forceinline__ void ret_m1_unit(const KPG& p, int l, int unit, unsigned char* lds, int wave, int lane) {
    const int tid = fresh_tid(), b = unit >> 4, h = (unit >> 2) & 3, s = unit & 3;
    const bf16_t* z = (const bf16_t*)(p.ws + WS_Z); const float2* rope = (const float2*)(p.ws + WS_ROPE);
    bf16_t* RTb = (bf16_t*)(p.ws + WS_RT);
    bf16_t* KT = (bf16_t*)lds; bf16_t* VT = KT + 128 * 136;
    const float lg2 = log2_gamma(h), cdec = exp2f(128.0f * lg2);
    const int fr = lane & 15, fq = lane >> 4;
    f32x4 R[4];
#pragma unroll
    for (int nt = 0; nt < 4; ++nt) R[nt] = (f32x4){0.f, 0.f, 0.f, 0.f};
    for (int i = 0; i < 16; ++i) {
        bf16_t* rt = RTb + ((size_t)((b * 4 + h) * 16 + i)) * 256 * 128;
#pragma unroll
        for (int nt = 0; nt < 4; ++nt) { u32x2 w; w.x = pk2(R[nt][0], R[nt][1]); w.y = pk2(R[nt][2], R[nt][3]);
            *(u32x2*)(rt + (size_t)(64 * s + 16 * nt + fr) * 128 + 16 * wave + 4 * fq) = w; }
        const int row0 = b * 2048 + i * 128;
#pragma unroll
        for (int tk = 0; tk < 2; ++tk) {
            const int task = tid + 512 * tk, j = task & 127, dg = task >> 7;
            const bf16_t* zr = z + (size_t)(row0 + j) * INC + ZK + h * 128 + dg * 8;
            const u32x4 lo = *(const u32x4*)zr, hi = *(const u32x4*)(zr + 64);
            float olo[8], ohi[8];
            rot8(lo, hi, rope + (size_t)(i * 128 + j) * 64 + dg * 8, 0.08838834764831845f * exp2f((float)(127 - j) * lg2), olo, ohi);
#pragma unroll
            for (int e = 0; e < 8; ++e) { KT[(dg * 8 + e) * 136 + j] = f2bf(olo[e]); KT[(64 + dg * 8 + e) * 136 + j] = f2bf(ohi[e]); }
        }
#pragma unroll
        for (int tk = 0; tk < 2; ++tk) {
            const int task = tid + 512 * tk, j = task & 127, vg = task >> 7;
            const u32x4 v = *(const u32x4*)(z + (size_t)(row0 + j) * INC + ZV + h * 256 + s * 64 + vg * 8);
            const unsigned vw[4] = {v.x, v.y, v.z, v.w};
#pragma unroll
            for (int e = 0; e < 8; ++e) VT[(vg * 8 + e) * 136 + j] = (bf16_t)((e & 1) ? (vw[e >> 1] >> 16) : (vw[e >> 1] & 0xffffu));
        }
        __syncthreads();
#pragma unroll
        for (int nt = 0; nt < 4; ++nt) R[nt] = R[nt] * cdec;
#pragma unroll
        for (int ks = 0; ks < 4; ++ks) {
            const bf16x8 a = *(const bf16x8*)(KT + (16 * wave + fr) * 136 + ks * 32 + 8 * fq);
#pragma unroll
            for (int nt = 0; nt < 4; ++nt) { const bf16x8 bb = *(const bf16x8*)(VT + (16 * nt + fr) * 136 + ks * 32 + 8 * fq); R[nt] = MFMA16(a, bb, R[nt]); }
        }
        MFMA_SETTLE();
        __syncthreads();
    }
    float* ro = p.out + O_RP + ((size_t)((l * 8 + b) * 4 + h)) * 128 * 256;
#pragma unroll
    for (int nt = 0; nt < 4; ++nt)
#pragma unroll
        for (int r = 0; r < 4; ++r) ro[(size_t)(16 * wave + 4 * fq + r) * 256 + 64 * s + 16 * nt + fr] = R[nt][r];
}

__device__ __forceinline__ void ret_m2_unit(const KPG& p, int l, int unit, unsigned char* lds, int wave, int lane) {
    const int tid = fresh_tid(), b = unit >> 6, h = (unit >> 4) & 3, i = unit & 15;
    const bf16_t* z = (const bf16_t*)(p.ws + WS_Z); const float2* rope = (const float2*)(p.ws + WS_ROPE);
    const bf16_t* RTb = (const bf16_t*)(p.ws + WS_RT); bf16_t* ob = (bf16_t*)(p.ws + WS_O);
    bf16_t* Qs = (bf16_t*)lds; bf16_t* Ks = Qs + 128 * 136; bf16_t* BIG = Ks + 128 * 136;
    const float lg2 = log2_gamma(h);
    const int fr = lane & 15, fq = lane >> 4, row0 = b * 2048 + i * 128;
#pragma unroll
    for (int tk = 0; tk < 2; ++tk) {
        const int task = tid + 512 * tk, dg = task & 7, j = task >> 3;
        const bf16_t* zr = z + (size_t)(row0 + j) * INC + h * 128 + dg * 8;
        const float2* rp = rope + (size_t)(i * 128 + j) * 64 + dg * 8;
        float olo[8], ohi[8];
        { const u32x4 lo = *(const u32x4*)(zr + ZQ), hi = *(const u32x4*)(zr + ZQ + 64); rot8(lo, hi, rp, 1.0f, olo, ohi);
          u32x4 w; w.x = pk2(olo[0], olo[1]); w.y = pk2(olo[2], olo[3]); w.z = pk2(olo[4], olo[5]); w.w = pk2(olo[6], olo[7]); *(u32x4*)(Qs + j * 136 + dg * 8) = w;
          w.x = pk2(ohi[0], ohi[1]); w.y = pk2(ohi[2], ohi[3]); w.z = pk2(ohi[4], ohi[5]); w.w = pk2(ohi[6], ohi[7]); *(u32x4*)(Qs + j * 136 + 64 + dg * 8) = w; }
        { const u32x4 lo = *(const u32x4*)(zr + ZK), hi = *(const u32x4*)(zr + ZK + 64); rot8(lo, hi, rp, 0.08838834764831845f, olo, ohi);
          u32x4 w; w.x = pk2(olo[0], olo[1]); w.y = pk2(olo[2], olo[3]); w.z = pk2(olo[4], olo[5]); w.w = pk2(olo[6], olo[7]); *(u32x4*)(Ks + j * 136 + dg * 8) = w;
          w.x = pk2(ohi[0], ohi[1]); w.y = pk2(ohi[2], ohi[3]); w.z = pk2(ohi[4], ohi[5]); w.w = pk2(ohi[6], ohi[7]); *(u32x4*)(Ks + j * 136 + 64 + dg * 8) = w; }
    }
    {
        const bf16_t* src = RTb + ((size_t)((b * 4 + h) * 16 + i)) * 256 * 128;
#pragma unroll
        for (int k = 0; k < 8; ++k) { const int idx = tid + 512 * k, dv = idx >> 4, c16 = idx & 15; *(u32x4*)(BIG + dv * 136 + c16 * 8) = *(const u32x4*)(src + (size_t)dv * 128 + c16 * 8); }
    }
    __syncthreads();
    bf16x8 Aq[4];
#pragma unroll
    for (int ks = 0; ks < 4; ++ks) Aq[ks] = *(const bf16x8*)(Qs + (16 * wave + fr) * 136 + ks * 32 + 8 * fq);
    f32x4 S[8];
#pragma unroll
    for (int jt = 0; jt < 8; ++jt) {
        S[jt] = (f32x4){0.f, 0.f, 0.f, 0.f};
        if (jt <= wave) {
#pragma unroll
            for (int ks = 0; ks < 4; ++ks) { const bf16x8 bb = *(const bf16x8*)(Ks + (16 * jt + fr) * 136 + ks * 32 + 8 * fq); S[jt] = MFMA16(Aq[ks], bb, S[jt]); }
        }
        __builtin_amdgcn_sched_barrier(0);
    }
    f32x4 O[16];
#pragma unroll
    for (int nt = 0; nt < 16; ++nt) {
        O[nt] = (f32x4){0.f, 0.f, 0.f, 0.f};
#pragma unroll
        for (int ks = 0; ks < 4; ++ks) { const bf16x8 bb = *(const bf16x8*)(BIG + (16 * nt + fr) * 136 + ks * 32 + 8 * fq); O[nt] = MFMA16(Aq[ks], bb, O[nt]); }
        if ((nt & 1) == 1) __builtin_amdgcn_sched_barrier(0);
    }
    MFMA_SETTLE();
    {
        float inn[4];
#pragma unroll
        for (int r = 0; r < 4; ++r) inn[r] = exp2f((float)(16 * wave + 4 * fq + r + 1) * lg2);
#pragma unroll
        for (int nt = 0; nt < 16; ++nt)
#pragma unroll
            for (int r = 0; r < 4; ++r) O[nt][r] *= inn[r];
    }
    __syncthreads();
#pragma unroll
    for (int jt = 0; jt < 8; ++jt)
#pragma unroll
        for (int r = 0; r < 4; ++r) {
            const int ii = 16 * wave + 4 * fq + r, jj = 16 * jt + fr;
            const float v = (jt <= wave && ii >= jj) ? S[jt][r] * exp2f((float)(ii - jj) * lg2) : 0.0f;
            Ks[ii * 136 + jj] = f2bf(v);
        }
#pragma unroll
    for (int k = 0; k < 8; ++k) {
        const int task = tid + 512 * k, j = task & 127, vg = task >> 7;
        const u32x4 v = *(const u32x4*)(z + (size_t)(row0 + j) * INC + ZV + h * 256 + vg * 8);
        const unsigned vw[4] = {v.x, v.y, v.z, v.w};
#pragma unroll
        for (int e = 0; e < 8; ++e) BIG[(vg * 8 + e) * 136 + j] = (bf16_t)((e & 1) ? (vw[e >> 1] >> 16) : (vw[e >> 1] & 0xffffu));
    }
    __syncthreads();
#pragma unroll
    for (int ks = 0; ks < 4; ++ks) {
        if (ks <= (wave >> 1)) {
            const bf16x8 a = *(const bf16x8*)(Ks + (16 * wave + fr) * 136 + ks * 32 + 8 * fq);
#pragma unroll
            for (int nt = 0; nt < 16; ++nt) { const bf16x8 bb = *(const bf16x8*)(BIG + (16 * nt + fr) * 136 + ks * 32 + 8 * fq); O[nt] = MFMA16(a, bb, O[nt]); if ((nt & 1) == 1) __builtin_amdgcn_sched_barrier(0); }
        }
    }
    MFMA_SETTLE();
#pragma unroll
    for (int r = 0; r < 4; ++r) {
        float ss = 0.f;
#pragma unroll
        for (int nt = 0; nt < 16; ++nt) ss += O[nt][r] * O[nt][r];
        ss = row_sum16(ss);
        const float rstd = rsqrtf(ss * (1.0f / 256.0f) + EPSF);
        const size_t tok = (size_t)(row0 + 16 * wave + 4 * fq + r);
#pragma unroll
        for (int nt = 0; nt < 16; ++nt) { const int col = h * 256 + 16 * nt + fr; const float gg = bf2f(z[tok * INC + ZGR + col]);
            ob[tok * 1024 + col] = f2bf(O[nt][r] * rstd * siluf_(gg)); }
    }
    __syncthreads();
}

__device__ __forceinline__ void ret_sample_unit(const KPG& p, int l, int unit, unsigned char* lds, int wave, int lane) {
    const int tid = fresh_tid(), b = unit >> 2, h = unit & 3;
    const bf16_t* z = (const bf16_t*)(p.ws + WS_Z); const float2* rope = (const float2*)(p.ws + WS_ROPE); bf16_t* ob = (bf16_t*)(p.ws + WS_O);
    float* qT = (float*)lds; float* kT = qT + 1024; float* ktT = kT + 1024; float* vs = ktT + 1024; float* sc = vs + 2048; float* opart = sc + 64;
    const float lg2 = log2_gamma(h);
    const int row0 = MP + b * 8;
    if (tid < 64) {
        const int i = tid >> 3, dg = tid & 7;
        const bf16_t* zr = z + (size_t)(row0 + i) * INC + h * 128 + dg * 8;
        const float2* rp = rope + (size_t)(2048 + i) * 64 + dg * 8;
        float olo[8], ohi[8];
        { const u32x4 lo = *(const u32x4*)(zr + ZQ), hi = *(const u32x4*)(zr + ZQ + 64); rot8(lo, hi, rp, 1.0f, olo, ohi);
#pragma unroll
          for (int e = 0; e < 8; ++e) { qT[(dg * 8 + e) * 8 + i] = olo[e]; qT[(64 + dg * 8 + e) * 8 + i] = ohi[e]; } }
        { const u32x4 lo = *(const u32x4*)(zr + ZK), hi = *(const u32x4*)(zr + ZK + 64); rot8(lo, hi, rp, 0.08838834764831845f, olo, ohi);
          const float tl = exp2f((float)(7 - i) * lg2);
#pragma unroll
          for (int e = 0; e < 8; ++e) { kT[(dg * 8 + e) * 8 + i] = olo[e]; kT[(64 + dg * 8 + e) * 8 + i] = ohi[e]; ktT[(dg * 8 + e) * 8 + i] = olo[e] * tl; ktT[(64 + dg * 8 + e) * 8 + i] = ohi[e] * tl; } }
    }
    if (tid < 256) {
#pragma unroll
        for (int i = 0; i < 8; ++i) vs[i * 256 + tid] = bf2f(z[(size_t)(row0 + i) * INC + ZV + h * 256 + tid]);
    }
    __syncthreads();
    if (tid < 64) {
        const int i = tid >> 3, j = tid & 7; float d = 0.f;
        for (int dd = 0; dd < 128; ++dd) d += qT[dd * 8 + i] * kT[dd * 8 + j];
        sc[tid] = (j <= i) ? d * exp2f((float)(i - j) * lg2) : 0.f;
    }
    {
        const int dv4 = (tid & 63) * 4;
        f32x4 vv[8], ao[8];
#pragma unroll
        for (int j = 0; j < 8; ++j) { vv[j] = *(const f32x4*)(vs + j * 256 + dv4); ao[j] = (f32x4){0.f, 0.f, 0.f, 0.f}; }
        const size_t so = ((size_t)((l * 128 + b) * 4 + h)) * 128 * 256;
        const float* r0 = p.in[4] + so; float* rn = p.out + O_RS + so;
        const float cdec = exp2f(8.0f * lg2);
#pragma unroll 8
        for (int dd = 0; dd < 16; ++dd) {
            const int d = wave * 16 + dd;
            const f32x4 r = *(const f32x4*)(r0 + (size_t)d * 256 + dv4);
            const f32x4 qa = *(const f32x4*)(qT + d * 8), qb = *(const f32x4*)(qT + d * 8 + 4), ka = *(const f32x4*)(ktT + d * 8), kb = *(const f32x4*)(ktT + d * 8 + 4);
            ao[0] += qa[0] * r; ao[1] += qa[1] * r; ao[2] += qa[2] * r; ao[3] += qa[3] * r; ao[4] += qb[0] * r; ao[5] += qb[1] * r; ao[6] += qb[2] * r; ao[7] += qb[3] * r;
            f32x4 nr = r * cdec;
            nr += ka[0] * vv[0]; nr += ka[1] * vv[1]; nr += ka[2] * vv[2]; nr += ka[3] * vv[3]; nr += kb[0] * vv[4]; nr += kb[1] * vv[5]; nr += kb[2] * vv[6]; nr += kb[3] * vv[7];
            *(f32x4*)(rn + (size_t)d * 256 + dv4) = nr;
        }
#pragma unroll
        for (int i = 0; i < 8; ++i) *(f32x4*)(opart + (wave * 8 + i) * 256 + dv4) = ao[i];
    }
    __syncthreads();
    {
        const int i = wave, dv4 = (tid & 63) * 4;
        f32x4 a = (f32x4){0.f, 0.f, 0.f, 0.f};
#pragma unroll
        for (int w = 0; w < 8; ++w) a += *(const f32x4*)(opart + (w * 8 + i) * 256 + dv4);
        a = a * exp2f((float)(i + 1) * lg2);
#pragma unroll
        for (int j = 0; j < 8; ++j) { if (j <= i) a += sc[i * 8 + j] * *(const f32x4*)(vs + j * 256 + dv4); }
        const float ss = wave_sum(a[0] * a[0] + a[1] * a[1] + a[2] * a[2] + a[3] * a[3]);
        const float rstd = rsqrtf(ss * (1.0f / 256.0f) + EPSF);
        const size_t tok = (size_t)(row0 + i);
        const u32x2 gw = *(const u32x2*)(z + tok * INC + ZGR + h * 256 + dv4);
        u32x2 w; w.x = pk2(a[0] * rstd * siluf_(bflo(gw.x)), a[1] * rstd * siluf_(bfhi(gw.x))); w.y = pk2(a[2] * rstd * siluf_(bflo(gw.y)), a[3] * rstd * siluf_(bfhi(gw.y)));
        *(u32x2*)(ob + tok * 1024 + h * 256 + dv4) = w;
    }
    __syncthreads();
}

__device__ __forceinline__ void phase_convact(const KPG& p, int l) {
    const bf16_t* up = (const bf16_t*)(p.ws + WS_Z); bf16_t* act = (bf16_t*)(p.ws + WS_ACT);
    const float* cw = p.in[22] + (size_t)l * 3 * INC; const float* cb = p.in[23] + (size_t)l * INC;
    const int NT = (512 + 128) * 352;
    for (int task = fresh_bid() * 512 + fresh_tid(); task < NT; task += gridDim.x * 512) {
        const int cgp = task % 352, rc = task / 352, j0 = cgp * 8;
        int row0, nrows; bool sample = rc >= 512;
        if (!sample) { row0 = rc * 32; nrows = 32; } else { row0 = MP + (rc - 512) * 8; nrows = 8; }
        float w0v[8], w1v[8], w2v[8], bv[8], w0g[8], w1g[8], w2g[8], bg[8];
#pragma unroll
        for (int e = 0; e < 8; ++e) { w0v[e] = cw[j0 + e]; w1v[e] = cw[INC + j0 + e]; w2v[e] = cw[2 * INC + j0 + e]; bv[e] = cb[j0 + e];
            w0g[e] = cw[DFF + j0 + e]; w1g[e] = cw[INC + DFF + j0 + e]; w2g[e] = cw[2 * INC + DFF + j0 + e]; bg[e] = cb[DFF + j0 + e]; }
        float p2v[8], p1v[8], p2g[8], p1g[8];
        if (sample) {
            const float* sc = p.in[5] + ((size_t)(l * 128 + (rc - 512)) * 2) * INC;
#pragma unroll
            for (int e = 0; e < 8; ++e) { p2v[e] = sc[j0 + e]; p1v[e] = sc[INC + j0 + e]; p2g[e] = sc[DFF + j0 + e]; p1g[e] = sc[INC + DFF + j0 + e]; }
        } else if ((row0 & 2047) == 0) {
#pragma unroll
            for (int e = 0; e < 8; ++e) { p2v[e] = 0.f; p1v[e] = 0.f; p2g[e] = 0.f; p1g[e] = 0.f; }
        } else {
            const u32x4 a = *(const u32x4*)(up + (size_t)(row0 - 2) * INC + j0), b = *(const u32x4*)(up + (size_t)(row0 - 1) * INC + j0);
            const u32x4 c = *(const u32x4*)(up + (size_t)(row0 - 2) * INC + DFF + j0), d = *(const u32x4*)(up + (size_t)(row0 - 1) * INC + DFF + j0);
            const unsigned aw[4] = {a.x, a.y, a.z, a.w}, bw[4] = {b.x, b.y, b.z, b.w}, cw_[4] = {c.x, c.y, c.z, c.w}, dw[4] = {d.x, d.y, d.z, d.w};
#pragma unroll
            for (int e = 0; e < 8; ++e) { p2v[e] = (e & 1) ? bfhi(aw[e >> 1]) : bflo(aw[e >> 1]); p1v[e] = (e & 1) ? bfhi(bw[e >> 1]) : bflo(bw[e >> 1]);
                p2g[e] = (e & 1) ? bfhi(cw_[e >> 1]) : bflo(cw_[e >> 1]); p1g[e] = (e & 1) ? bfhi(dw[e >> 1]) : bflo(dw[e >> 1]); }
        }
        for (int r = 0; r < nrows; ++r) {
            const u32x4 a = *(const u32x4*)(up + (size_t)(row0 + r) * INC + j0), c = *(const u32x4*)(up + (size_t)(row0 + r) * INC + DFF + j0);
            const unsigned aw[4] = {a.x, a.y, a.z, a.w}, cw_[4] = {c.x, c.y, c.z, c.w};
            float o[8];
#pragma unroll
            for (int e = 0; e < 8; ++e) {
                const float cv = (e & 1) ? bfhi(aw[e >> 1]) : bflo(aw[e >> 1]), cg_ = (e & 1) ? bfhi(cw_[e >> 1]) : bflo(cw_[e >> 1]);
                const float val = bv[e] + w0v[e] * p2v[e] + w1v[e] * p1v[e] + w2v[e] * cv;
                const float gat = bg[e] + w0g[e] * p2g[e] + w1g[e] * p1g[e] + w2g[e] * cg_;
                o[e] = siluf_(gat) * val;
                p2v[e] = p1v[e]; p1v[e] = cv; p2g[e] = p1g[e]; p1g[e] = cg_;
            }
            u32x4 w; w.x = pk2(o[0], o[1]); w.y = pk2(o[2], o[3]); w.z = pk2(o[4], o[5]); w.w = pk2(o[6], o[7]);
            *(u32x4*)(act + (size_t)(row0 + r) * DFF + j0) = w;
        }
    }
}

#endif

__global__ void __launch_bounds__(512, 2) fwd_kernel(KP p) {
#if defined(__HIP_DEVICE_COMPILE__)
    extern __shared__ __attribute__((aligned(16))) unsigned char lds[];
    cg::grid_group grid = cg::this_grid();
    volatile LAS unsigned* barw = (volatile LAS unsigned*)((LAS unsigned char*)lds + LDS_BARW);
    if (threadIdx.x < 4) barw[threadIdx.x] = 0u;
    if (threadIdx.x == 0) {
        LAS unsigned long long* t = (LAS unsigned long long*)((LAS unsigned char*)lds + LDS_TAB);
#pragma unroll
        for (int i = 0; i < 26; ++i) t[i] = (unsigned long long)p.in[i];
        t[26] = (unsigned long long)p.out; t[27] = (unsigned long long)p.ws;
    }
    __syncthreads();
    (void)xcd_barrier_post((unsigned*)(p.ws + WS_CTL), barw);
#if USE_CG
#define GSYNC() grid.sync()
#else
#define GSYNC() do { XcdBarrier b_; b_.bar = (unsigned*)((GAS unsigned char*)ld_tab(lds, 27) + WS_CTL); b_.x = xb_xcc_id(); b_.st = (volatile LAS unsigned*)((LAS unsigned char*)lds + LDS_BARW); xcd_barrier(b_); } while (0)
#endif
#define PH_BEGIN const KPG q = load_kp(lds); const int tid_ = fresh_tid(), lane = tid_ & 63, wave = __builtin_amdgcn_readfirstlane(tid_ >> 6); (void)lane; (void)wave; \
                 const int G = gridDim.x, c = fresh_bid(); (void)G; (void)c; LAS unsigned char* glds = (LAS unsigned char*)lds; (void)glds;

    for (int l = 0; l < DEPTH; ++l) {
        {
            PH_BEGIN
#ifndef NO_PRO
            phase_prologue(q, l, lds, wave, lane);
#endif
            phase_rmsnorm(q, l, wave, lane);
        }
        if (l == 0) grid.sync();
        GSYNC();
        {
            PH_BEGIN
            unsigned char* wl = q.ws + WS_WT + (size_t)l * LW_SIZE;
            pg8::Sched S{(const char*)(q.ws + WS_H), (const char*)(wl + LW_IN), nullptr, nullptr, 16, 0, 1024, MT / 256, INC / 256, G, c};
            pg8::EpiStoreBf16 E{(bf16_t*)(q.ws + WS_Z), INC};
#if !defined(NO_GEMM) && (!defined(ONLY_GEMM) || ONLY_GEMM == 0)
            pg8::gemm_phase(glds, S, E);
#endif
        }
        GSYNC();
        {
            PH_BEGIN
#ifndef NO_RM1
            for (int u = c; u < 128; u += G) ret_m1_unit(q, l, u, lds, wave, lane);
#endif
#ifndef NO_RS
            for (int u = c - 128; u >= 0 && u < 512; u += 128) ret_sample_unit(q, l, u, lds, wave, lane);
#endif
        }
        {
            PH_BEGIN
#ifndef NO_SM1
            for (int u = c - 128; u >= 0 && u < 256; u += 128) { const int wt = u * 8 + wave; s5_m1(q, l, wt >> 8, (wt >> 3) & 31, wt & 7, lane); }
#endif
        }
        {
            PH_BEGIN
#ifndef NO_SS
            for (int u = c - 128; u >= 0 && u < 128; u += G) { const int g = (u >> 4) * 4 + (wave & 3), bq = (u & 15) * 2 + (wave >> 2);
                s5_tile<true>(q, l, g, MP + bq * 32, bq * 4, 0, (bf16_t*)(lds + wave * 8704), lane); }
#endif
        }
        GSYNC();
        {
            PH_BEGIN
#ifndef NO_RM2
            for (int u = c; u < 512; u += G) ret_m2_unit(q, l, u, lds, wave, lane);
#endif
        }
        {
            PH_BEGIN
#ifndef NO_SM2
            for (int uu = c; uu < 2048; uu += G) { const int chunk = (uu & 31) * 2 + (wave >> 2), g = ((uu >> 5) & 7) * 4 + (wave & 3), b = uu >> 8;
                s5_tile<false>(q, l, g, b * 2048 + chunk * 32, b, chunk, (bf16_t*)(lds + wave * 8704), lane); }
#endif
        }
        GSYNC();
        {
            PH_BEGIN
            unsigned char* wl = q.ws + WS_WT + (size_t)l * LW_SIZE;
            pg8::Sched S{(const char*)(q.ws + WS_YA), (const char*)(wl + LW_GLU), nullptr, nullptr, 8, 0, 512, MT / 256, 2, G, c};
            pg8::EpiGlu E{(const bf16_t*)(q.ws + WS_YA), (bf16_t*)(q.ws + WS_YA2)};
#if !defined(NO_GEMM) && (!defined(ONLY_GEMM) || ONLY_GEMM == 1)
            pg8::gemm_phase(glds, S, E);
#endif
        }
        GSYNC();
        {
            PH_BEGIN
            unsigned char* wl = q.ws + WS_WT + (size_t)l * LW_SIZE;
            pg8::Sched S{(const char*)(q.ws + WS_YA2), (const char*)(wl + LW_SSM), (const char*)(q.ws + WS_O), (const char*)(wl + LW_RET), 8, 16, 1024, MT / 256, 4, G, c};
            pg8::EpiMix E{(const bf16_t*)(q.ws + WS_Z), (bf16_t*)(q.ws + WS_MIX)};
#if !defined(NO_GEMM) && (!defined(ONLY_GEMM) || ONLY_GEMM == 2)
            pg8::gemm_phase(glds, S, E);
#endif
        }
        GSYNC();
        {
            PH_BEGIN
            unsigned char* wl = q.ws + WS_WT + (size_t)l * LW_SIZE;
            pg8::Sched S{(const char*)(q.ws + WS_MIX), (const char*)(wl + LW_O), nullptr, nullptr, 16, 0, 1024, MT / 256, 4, G, c};
            pg8::EpiRes E{l == 0 ? q.in[0] : (const float*)(q.ws + WS_X), l == 0 ? q.in[1] : (const float*)(q.ws + WS_X) + (size_t)MP * 1024, (float*)(q.ws + WS_X)};
#if !defined(NO_GEMM) && (!defined(ONLY_GEMM) || ONLY_GEMM == 3)
            pg8::gemm_phase(glds, S, E);
#endif
        }
        GSYNC();
        { PH_BEGIN phase_rmsnorm(q, 1, wave, lane); }
        GSYNC();
        {
            PH_BEGIN
            unsigned char* wl = q.ws + WS_WT + (size_t)l * LW_SIZE;
            pg8::Sched S{(const char*)(q.ws + WS_H), (const char*)(wl + LW_UP), nullptr, nullptr, 16, 0, 1024, MT / 256, INC / 256, G, c};
            pg8::EpiUp E{(bf16_t*)(q.ws + WS_Z), q.out + O_CP + (size_t)l * 8 * 2 * INC, q.out + O_CS + (size_t)l * 128 * 2 * INC};
#if !defined(NO_GEMM) && (!defined(ONLY_GEMM) || ONLY_GEMM == 4)
            pg8::gemm_phase(glds, S, E);
#endif
        }
        GSYNC();
        {
            PH_BEGIN
#ifndef NO_CONV
            phase_convact(q, l);
#endif
        }
        GSYNC();
        {
            PH_BEGIN
            unsigned char* wl = q.ws + WS_WT + (size_t)l * LW_SIZE;
            pg8::Sched S{(const char*)(q.ws + WS_ACT), (const char*)(wl + LW_DOWN), nullptr, nullptr, 44, 0, DFF, MT / 256, 4, G, c};
            pg8::EpiRes E{(const float*)(q.ws + WS_X), (const float*)(q.ws + WS_X) + (size_t)MP * 1024, (float*)(q.ws + WS_X)};
#if !defined(NO_GEMM) && (!defined(ONLY_GEMM) || ONLY_GEMM == 5)
            pg8::gemm_phase(glds, S, E);
#endif
        }
        GSYNC();
    }
    {
        PH_BEGIN
        const float* xb = (const float*)(q.ws + WS_X); const float* gf = q.in[25];
        for (int row = c * 8 + wave; row < MT; row += G * 8) {
            const f32x4* xr = (const f32x4*)(xb + (size_t)row * 1024) + lane; const f32x4* gr = (const f32x4*)gf + lane;
            f32x4 v[4]; float s = 0.f;
#pragma unroll
            for (int j = 0; j < 4; ++j) { v[j] = xr[64 * j]; s += (v[j].x * v[j].x + v[j].y * v[j].y) + (v[j].z * v[j].z + v[j].w * v[j].w); }
            const float rstd = rsqrtf(wave_sum(s) * (1.f / 1024.f) + EPSF);
            f32x4* o = (f32x4*)(q.out + O_YP + (size_t)row * 1024) + lane;
#pragma unroll
            for (int j = 0; j < 4; ++j) o[64 * j] = v[j] * rstd * gr[64 * j];
        }
    }
#endif
}

extern "C" void kernel_launch(void* const* d_in, const int* in_sizes, int n_in, void* d_out, int out_size, void* d_ws, size_t ws_size, hipStream_t stream) {
    static int grid = 0;
    if (grid == 0) {
        if (n_in != 26 || ws_size < WS_END) { fprintf(stderr, "kernel_launch: unexpected shapes (n_in %d, ws %zu < %zu)\n", n_in, ws_size, (size_t)WS_END); grid = -1; return; }
        int dev = 0, cus = 0, per_cu = 0;
        hipGetDevice(&dev);
        hipDeviceGetAttribute(&cus, hipDeviceAttributeMultiprocessorCount, dev);
        if (hipFuncSetAttribute((const void*)fwd_kernel, hipFuncAttributeMaxDynamicSharedMemorySize, LDS_BYTES) != hipSuccess) { fprintf(stderr, "kernel_launch: hipFuncSetAttribute failed\n"); grid = -1; return; }
        hipOccupancyMaxActiveBlocksPerMultiprocessor(&per_cu, (const void*)fwd_kernel, 512, LDS_BYTES);
        (void)hipGetLastError();
        if (per_cu < 1) per_cu = 1;
        grid = cus * 1;
    }
    if (grid < 0) return;
    hipMemsetAsync((char*)d_ws + WS_CTL, 0, 65536, stream);
    KP p{};
    for (int i = 0; i < 26; ++i) p.in[i] = (const float*)d_in[i];
    p.out = (float*)d_out; p.ws = (unsigned char*)d_ws;
    void* args[] = {&p};
    hipError_t e = hipLaunchCooperativeKernel((const void*)fwd_kernel, dim3(grid), dim3(512), args, LDS_BYTES, stream);
    if (e != hipSuccess) fprintf(stderr, "cooperative launch failed: %s (grid %d)\n", hipGetErrorString(e), grid);
}
```

```cpp
#include <hip/hip_runtime.h>
#include <hip/hip_cooperative_groups.h>
#include <cstdio>
#include <cstdint>
namespace cg = cooperative_groups;

#ifndef USE_CG
#define USE_CG 0
#endif

#define LAS __attribute__((address_space(3)))
typedef unsigned short bf16_t;
typedef short bf16x8 __attribute__((ext_vector_type(8)));
typedef float f32x4 __attribute__((ext_vector_type(4)));
typedef float f32x16 __attribute__((ext_vector_type(16)));
typedef unsigned u32x4 __attribute__((ext_vector_type(4)));
typedef unsigned u32x2 __attribute__((ext_vector_type(2)));

constexpr int DM = 1024, MP = 16384, MS = 1024, MT = MP + MS, DEPTH = 4;
constexpr int INC = 5632, DFF = 2816, DSSM = 512;
constexpr int ZQ = 512, ZK = 1024, ZV = 1536, ZGR = 2560, ZGA = 3584, ZGB = 4608;
constexpr float EPSF = 1e-6f;
constexpr size_t O_YP = 0, O_YS = 16777216, O_SRP = 17825792, O_SIP = 17891328, O_RP = 17956864, O_CP = 22151168,
                 O_SRS = 22511616, O_SIS = 23560192, O_RS = 24608768, O_CS = 91717632;
constexpr size_t WS_CTL = 0;
constexpr size_t WS_WT = 65536;
constexpr size_t LW_IN = 0, LW_UP = 11534336, LW_DOWN = LW_UP + 11534336, LW_O = LW_DOWN + 5767168, LW_RET = LW_O + 2097152,
                 LW_SSM = LW_RET + 2097152, LW_GLU = LW_SSM + 2097152, LW_SIZE = LW_GLU + 524288;
constexpr size_t WS_S5T = WS_WT + 4 * LW_SIZE;
constexpr size_t S5_MB = 0, S5_BMT = 4194304, S5_CMT = S5_BMT + 131072, S5_LAM = S5_CMT + 131072, S5_LAM32 = S5_LAM + 16384, S5_SIZE = S5_LAM32 + 16384;
constexpr size_t WS_ROPE = WS_S5T + 4 * S5_SIZE;
constexpr size_t WS_X = WS_ROPE + 1052672;
constexpr size_t WS_H = WS_X + (size_t)MT * 1024 * 4;
constexpr size_t WS_Z = WS_H + (size_t)MT * 1024 * 2;
constexpr size_t WS_YA = WS_Z + (size_t)MT * INC * 2;
constexpr size_t WS_YA2 = WS_YA + (size_t)MT * 512 * 2;
constexpr size_t WS_O = WS_YA2 + (size_t)MT * 1024 * 2;
constexpr size_t WS_MIX = WS_O + (size_t)MT * 1024 * 2;
constexpr size_t WS_ACT = WS_MIX + (size_t)MT * 1024 * 2;
constexpr size_t WS_SIN = WS_ACT + (size_t)MT * DFF * 2;
constexpr size_t WS_RT = WS_SIN + (size_t)8 * 32 * 64 * 128 * 4;
constexpr size_t WS_E = WS_RT + (size_t)32 * 16 * 256 * 128 * 2;
constexpr size_t WS_END = WS_E + (size_t)8 * 32 * 8 * 128 * 4;

constexpr int LDS_BYTES = 147456;
constexpr int LDS_BARW = LDS_BYTES - 16;

#define GAS __attribute__((address_space(1)))
struct KP { const float* in[26]; float* out; unsigned char* ws; };
#if defined(__HIP_DEVICE_COMPILE__)
struct KPG { const GAS float* in[26]; GAS float* out; GAS unsigned char* ws; };
constexpr int LDS_TAB = LDS_BYTES - 16 - 256;
__device__ __forceinline__ unsigned long long ld_tab(const unsigned char* lds, int i) {
    unsigned off = (unsigned)(LDS_TAB + 8 * i); asm volatile("" : "+v"(off));
    const unsigned long long v = *(const LAS unsigned long long*)((const LAS unsigned char*)lds + off);
    const unsigned lo = __builtin_amdgcn_readfirstlane((unsigned)v), hi = __builtin_amdgcn_readfirstlane((unsigned)(v >> 32));
    return ((unsigned long long)hi << 32) | lo;
}
__device__ __forceinline__ KPG load_kp(const unsigned char* lds) {
    KPG q; asm volatile("" ::: "memory");
#pragma unroll
    for (int i = 0; i < 26; ++i) q.in[i] = (const GAS float*)ld_tab(lds, i);
    q.out = (GAS float*)ld_tab(lds, 26); q.ws = (GAS unsigned char*)ld_tab(lds, 27);
    return q;
}
__device__ __forceinline__ int fresh_tid() { int t = threadIdx.x; asm volatile("" : "+v"(t)); return t; }
__device__ __forceinline__ int fresh_bid() { int b = blockIdx.x; asm volatile("" : "+s"(b)); return b; }

__device__ __forceinline__ float bf2f(bf16_t b) { return __uint_as_float(((unsigned)b) << 16); }
__device__ __forceinline__ float bflo(unsigned w) { return __uint_as_float(w << 16); }
__device__ __forceinline__ float bfhi(unsigned w) { return __uint_as_float(w & 0xffff0000u); }
__device__ __forceinline__ bf16_t f2bf(float f) { unsigned u = __float_as_uint(f); u += 0x7FFFu + ((u >> 16) & 1u); return (bf16_t)(u >> 16); }
__device__ __forceinline__ unsigned pk2(float lo, float hi) { unsigned r; asm volatile("v_cvt_pk_bf16_f32 %0, %1, %2" : "=v"(r) : "v"(lo), "v"(hi)); return r; }
template <int CTRL> __device__ __forceinline__ float dppf(float x) { return __uint_as_float((unsigned)__builtin_amdgcn_update_dpp(0, (int)__float_as_uint(x), CTRL, 0xf, 0xf, false)); }
__device__ __forceinline__ float row_sum16(float x) {
    x += dppf<0xB1>(x); x += dppf<0x4E>(x); x += dppf<0x141>(x); x += dppf<0x140>(x); return x;
}
__device__ __forceinline__ float wave_sum(float v) {
    const float r = row_sum16(v);
    return (__builtin_amdgcn_readlane(r, 0) + __builtin_amdgcn_readlane(r, 16)) + (__builtin_amdgcn_readlane(r, 32) + __builtin_amdgcn_readlane(r, 48));
}
__device__ __forceinline__ float xor32(float x, int half) { const unsigned u = __float_as_uint(x); auto r = __builtin_amdgcn_permlane32_swap(u, u, false, false); return __uint_as_float(half ? r[0] : r[1]); }
__device__ __forceinline__ float sigmoidf_(float x) { return __builtin_amdgcn_rcpf(1.0f + __expf(-x)); }
__device__ __forceinline__ float siluf_(float x) { return x * __builtin_amdgcn_rcpf(1.0f + __expf(-x)); }
__device__ __forceinline__ float gelu_tanh(float x) { const float u = 0.7978845608028654f * (x + 0.044715f * x * x * x); return x * __builtin_amdgcn_rcpf(1.0f + __expf(-2.0f * u)); }
__device__ __forceinline__ void sincos_rev(float rev, float& s, float& c) {
    const float f = rev - rintf(rev);
    s = __builtin_amdgcn_sinf(f); c = __builtin_amdgcn_cosf(f);
}
#define LDS_WAIT() asm volatile("s_waitcnt lgkmcnt(0)" ::: "memory")
#define MFMA16(a, b, c) __builtin_amdgcn_mfma_f32_16x16x32_bf16((a), (b), (c), 0, 0, 0)
#define MFMA32(a, b, c) __builtin_amdgcn_mfma_f32_32x32x16_bf16((a), (b), (c), 0, 0, 0)
#define MFMA_SETTLE() do { __builtin_amdgcn_sched_barrier(0); asm volatile("s_nop 15\n\ts_nop 15\n\ts_nop 15\n\ts_nop 15" ::: "memory"); __builtin_amdgcn_sched_barrier(0); } while (0)

#define XB_TMO      128
#define XB_XCNT(j)  (256  + 64 * (j))
#define XB_XSUB(j)  (1280 + 64 * (j))
#define XB_XGEN(j)  (2304 + 64 * (j))
#define XB_TOP      3328
#define XB_TOPGEN   3392
#define XCD_BAR_WORDS 3456
#define XB_SPIN_CAP (1u << 22)
__device__ __forceinline__ unsigned xb_ld(unsigned* p)              { return __hip_atomic_load(p, __ATOMIC_RELAXED, __HIP_MEMORY_SCOPE_AGENT); }
__device__ __forceinline__ unsigned xb_add(unsigned* p, unsigned v) { return __hip_atomic_fetch_add(p, v, __ATOMIC_RELAXED, __HIP_MEMORY_SCOPE_AGENT); }
__device__ __forceinline__ unsigned xb_xcc_id() { return (unsigned)__builtin_amdgcn_s_getreg((3 << 11) | 20) & 0xFu; }
#define XB_SPIN(cond, bar) do { unsigned _sp = 0; while (cond) { __builtin_amdgcn_s_sleep(1); \
    if ((++_sp & 255u) == 0u) { if (xb_ld(&(bar)[XB_TMO])) break; if (_sp > XB_SPIN_CAP) { atomicAdd(&(bar)[XB_TMO], 1u); break; } } } } while (0)
struct XcdBarrier { unsigned* bar; unsigned x; volatile LAS unsigned* st; };
__device__ __forceinline__ XcdBarrier xcd_barrier_post(unsigned* bar, volatile LAS unsigned* st) {
    XcdBarrier b; b.bar = bar; b.x = xb_xcc_id(); b.st = st;
    if (threadIdx.x == 0) (void)xb_add(&bar[XB_XCNT(b.x)], 1u);
    return b;
}
__device__ __forceinline__ void xcd_barrier_complete(unsigned* bar, unsigned x, unsigned& nloc, unsigned& nx) {
    const unsigned G = gridDim.x * gridDim.y * gridDim.z;
    unsigned sum, cnt, mine, sp = 0u;
    for (;;) {
        sum = 0u; cnt = 0u; mine = 0u;
#pragma unroll
        for (unsigned j = 0; j < 16; ++j) { const unsigned c = xb_ld(&bar[XB_XCNT(j)]); sum += c; cnt += (c > 0u) ? 1u : 0u; mine = (j == x) ? c : mine; }
        if (sum == G) break;
        __builtin_amdgcn_s_sleep(1);
        if ((++sp & 255u) == 0u) { if (xb_ld(&bar[XB_TMO])) break; if (sp > XB_SPIN_CAP) { atomicAdd(&bar[XB_TMO], 1u); break; } }
    }
    nloc = mine > 0u ? mine : 1u; nx = cnt > 0u ? cnt : 1u;
}
__device__ __forceinline__ void xcd_barrier(const XcdBarrier& b) {
    asm volatile("s_waitcnt vmcnt(0)" ::: "memory");
    __syncthreads();
    if (threadIdx.x == 0) {
        unsigned* bar = b.bar;
        __builtin_amdgcn_s_waitcnt(0);
        unsigned nloc = b.st[0], nx = b.st[1];
        if (nloc == 0u) { xcd_barrier_complete(bar, b.x, nloc, nx); b.st[0] = nloc; b.st[1] = nx; }
        const unsigned old = xb_add(&bar[XB_XSUB(b.x)], 1u);
        const unsigned gen = old / nloc;
        if (old + 1u == (gen + 1u) * nloc) {
            __builtin_amdgcn_fence(__ATOMIC_RELEASE, "agent");
            asm volatile("s_waitcnt vmcnt(0)" ::: "memory");
            const unsigned og = xb_add(&bar[XB_TOP], 1u);
            const unsigned tg = og / nx;
            if (og + 1u == (tg + 1u) * nx) xb_add(&bar[XB_TOPGEN], 1u);
            else XB_SPIN(xb_ld(&bar[XB_TOPGEN]) == tg, bar);
            __builtin_amdgcn_fence(__ATOMIC_ACQUIRE, "agent");
            xb_add(&bar[XB_XGEN(b.x)], 1u);
            asm volatile("s_waitcnt vmcnt(0)" ::: "memory");
        } else {
            XB_SPIN(xb_ld(&bar[XB_XGEN(b.x)]) == gen, bar);
            __builtin_amdgcn_fence(__ATOMIC_ACQUIRE, "agent");
            asm volatile("s_waitcnt vmcnt(0)" ::: "memory");
        }
    }
    __syncthreads();
}

namespace pg8 {
constexpr int BM = 256, BK = 64, HALF = 128, HTB = HALF * BK * 2, STAGE_BYTES = 8 * HTB, NXCD = 8, WGM = 8;
__device__ __forceinline__ int lds_byte(int r, int c) { const int st = (r >> 4) * 2 + (c >> 5), rr = r & 15, cc = c & 31, ob = rr * 64 + cc * 2; return st * 1024 + (ob ^ (((ob >> 9) & 1) << 5)); }
__device__ __forceinline__ void stage_rc(int b, int& R, int& C) { const int st = b / 1024, sb = b % 1024, swz = sb ^ (((sb >> 9) & 1) << 5); R = (st >> 1) * 16 + swz / 64; C = (st & 1) * 32 + (swz % 64) / 2; }
__device__ __forceinline__ int perm32(int rho) { const int n = rho >> 4, i = rho & 15; return 8 * (i >> 2) + 4 * n + (i & 3); }

struct Unit { const char* A; const char* B; int nt, mode, pm, pn; };
struct Sched {
    const char *A0, *B0, *A1, *B1; int nt0, nt1, ld, nM, nN, G, c;
    __device__ __forceinline__ bool next(int i, Unit& u) const {
        const int dual = (A1 != nullptr) ? 1 : 0; const int ti = dual ? (i >> 1) : i, sub = dual ? (i & 1) : 0;
        const int nwg = nM * nN; const long L = (long)ti * G + c; if (L >= nwg) return false;
        int wgid = (int)L; { const int q = nwg / NXCD, r = nwg % NXCD, xcd = wgid % NXCD, off = wgid / NXCD; wgid = (xcd < r ? xcd * (q + 1) : r * (q + 1) + (xcd - r) * q) + off; }
        const int nig = WGM * nN, gid = wgid / nig, fm = gid * WGM, gsz = (nM - fm) < WGM ? (nM - fm) : WGM;
        u.pm = fm + ((wgid % nig) % gsz); u.pn = (wgid % nig) / gsz;
        const size_t tstep = (size_t)BM * ld * 2;
        u.A = (sub ? A1 : A0) + (size_t)u.pm * tstep; u.B = (sub ? B1 : B0) + (size_t)u.pn * tstep; u.nt = sub ? nt1 : nt0; u.mode = dual ? (sub ? 2 : 1) : 0;
        return true;
    }
};
typedef f32x4 Acc[2][2][4][2];

template <class Epi>
__device__ __forceinline__ void gemm_phase(LAS unsigned char* lds, const Sched& S, const Epi& E) {
    const int tid = fresh_tid(), wid = __builtin_amdgcn_readfirstlane(tid >> 6), lane = tid & 63, wr = wid >> 2, wc = wid & 3, fr = lane & 15, fq = lane >> 4;
    const int ld = S.ld;
    unsigned voffA[2], voffB[2];
#pragma unroll
    for (int i = 0; i < 2; ++i) { int R, C; stage_rc(tid * 16 + i * 8192, R, C); const int Rb = (R & ~31) + perm32(R & 31);
        voffA[i] = (unsigned)(R * ld + C) * 2u; voffB[i] = (unsigned)(Rb * ld + C) * 2u; }
    const size_t kstep = (size_t)(BK * 2);
    const size_t hstep = (size_t)HALF * ld * 2;
    const unsigned ldsw = (unsigned)wid * 1024u;
    const int aoff = lds_byte(wr * 64 + fr, fq * 8), boff = lds_byte(wc * 32 + fr, fq * 8);
#define PG8_SA(b, h) (((b) * 2 + (h)) * HTB)
#define PG8_SB(b, h) ((4 + (b) * 2 + (h)) * HTB)
#define PG8_STAGE(bufoff, gbase, voff) do { _Pragma("unroll") for (int _i = 0; _i < 2; ++_i) \
        __builtin_amdgcn_global_load_lds((const unsigned*)((const char*)(gbase) + (voff)[_i]), (LAS unsigned*)(lds + (bufoff) + ldsw + _i * 8192), 16, 0, 0); } while (0)
#define PG8_LDA(dst, b, h) do { _Pragma("unroll") for (int m = 0; m < 4; ++m) _Pragma("unroll") for (int k = 0; k < 2; ++k) dst[m][k] = *(const LAS bf16x8*)(lds + PG8_SA(b, h) + aoff + m * 2048 + k * 1024); } while (0)
#define PG8_LDB(dst, b, h) do { _Pragma("unroll") for (int n = 0; n < 2; ++n) _Pragma("unroll") for (int k = 0; k < 2; ++k) dst[n][k] = *(const LAS bf16x8*)(lds + PG8_SB(b, h) + boff + n * 2048 + k * 1024); } while (0)
#define PG8_MMA(ai, bj, At, Bt) do { __builtin_amdgcn_s_setprio(1); _Pragma("unroll") for (int m = 0; m < 4; ++m) _Pragma("unroll") for (int n = 0; n < 2; ++n) _Pragma("unroll") for (int k = 0; k < 2; ++k) \
        acc[ai][bj][m][n] = __builtin_amdgcn_mfma_f32_16x16x32_bf16(Bt[n][k], At[m][k], acc[ai][bj][m][n], 0, 0, 0); __builtin_amdgcn_s_setprio(0); } while (0)
#define PG8_WAIT_V(n) asm volatile("s_waitcnt vmcnt(" #n ")" ::: "memory")
#define PG8_WAIT_L(n) asm volatile("s_waitcnt lgkmcnt(" #n ")" ::: "memory")
#define PG8_BAR __builtin_amdgcn_s_barrier()
#define PG8_SCHED __builtin_amdgcn_sched_barrier(0)
    Unit cur, nxt; int ui = 0;
    if (!S.next(0, cur)) return;
    Acc acc;
#pragma unroll
    for (int a = 0; a < 2; ++a)
#pragma unroll
        for (int b = 0; b < 2; ++b)
#pragma unroll
            for (int m = 0; m < 4; ++m)
#pragma unroll
                for (int n = 0; n < 2; ++n) acc[a][b][m][n] = (f32x4){0.f, 0.f, 0.f, 0.f};
    bf16x8 At[4][2], B0[2][2], B1[2][2];
    const char* cA = cur.A; const char* cB = cur.B;
    PG8_STAGE(PG8_SB(0, 0), cB, voffB); PG8_STAGE(PG8_SA(0, 0), cA, voffA); PG8_STAGE(PG8_SB(0, 1), cB + hstep, voffB); PG8_STAGE(PG8_SA(0, 1), cA + hstep, voffA);
    if (wr == 1) PG8_BAR;
    PG8_WAIT_V(4); PG8_BAR;
    PG8_STAGE(PG8_SB(1, 0), cB + kstep, voffB); PG8_STAGE(PG8_SA(1, 0), cA + kstep, voffA); PG8_STAGE(PG8_SB(1, 1), cB + hstep + kstep, voffB);
    PG8_WAIT_V(6); PG8_BAR;
    for (;;) {
        const bool has_next = S.next(ui + 1, nxt);
        const char* nA = has_next ? nxt.A : cA; const char* nB = has_next ? nxt.B : cB;
        const int nt = cur.nt;
        for (int t = 0; t < nt; t += 2) {
            const bool last = (t == nt - 2);
            const char* a1 = cA + (size_t)(t + 1) * kstep;
            const char* a2 = last ? nA : cA + (size_t)(t + 2) * kstep; const char* b2 = last ? nB : cB + (size_t)(t + 2) * kstep;
            const char* a3 = a2 + kstep; const char* b3 = b2 + kstep;
            PG8_LDB(B0, 0, 0); PG8_SCHED; PG8_LDA(At, 0, 0); PG8_STAGE(PG8_SA(1, 1), a1 + hstep, voffA);
            PG8_WAIT_L(8); PG8_BAR; PG8_WAIT_L(0); PG8_MMA(0, 0, At, B0); PG8_BAR; PG8_SCHED;
            PG8_LDB(B1, 0, 1); PG8_STAGE(PG8_SB(0, 0), b2, voffB);
            PG8_BAR; PG8_WAIT_L(0); PG8_MMA(0, 1, At, B1); PG8_BAR;
            PG8_LDA(At, 0, 1); PG8_STAGE(PG8_SA(0, 0), a2, voffA);
            PG8_BAR; PG8_WAIT_L(0); PG8_MMA(1, 0, At, B0); PG8_BAR; PG8_SCHED;
            PG8_STAGE(PG8_SB(0, 1), b2 + hstep, voffB);
            PG8_WAIT_V(6); PG8_BAR; PG8_MMA(1, 1, At, B1); PG8_BAR;
            PG8_LDB(B0, 1, 0); PG8_SCHED; PG8_LDA(At, 1, 0); PG8_STAGE(PG8_SA(0, 1), a2 + hstep, voffA);
            PG8_WAIT_L(8); PG8_BAR; PG8_WAIT_L(0); PG8_MMA(0, 0, At, B0); PG8_BAR; PG8_SCHED;
            PG8_LDB(B1, 1, 1); PG8_STAGE(PG8_SB(1, 0), b3, voffB);
            PG8_BAR; PG8_WAIT_L(0); PG8_MMA(0, 1, At, B1); PG8_BAR;
            PG8_LDA(At, 1, 1); PG8_STAGE(PG8_SA(1, 0), a3, voffA);
            PG8_BAR; PG8_WAIT_L(0); PG8_MMA(1, 0, At, B0); PG8_BAR; PG8_SCHED;
            PG8_STAGE(PG8_SB(1, 1), b3 + hstep, voffB);
            PG8_WAIT_V(6); PG8_BAR; PG8_MMA(1, 1, At, B1); PG8_BAR;
        }
        MFMA_SETTLE();
        E(acc, cur, wr, wc, fr, fq);
        if (!has_next) break;
        if (cur.mode != 1) {
#pragma unroll
            for (int a = 0; a < 2; ++a)
#pragma unroll
                for (int b = 0; b < 2; ++b)
#pragma unroll
                    for (int m = 0; m < 4; ++m)
#pragma unroll
                        for (int n = 0; n < 2; ++n) acc[a][b][m][n] = (f32x4){0.f, 0.f, 0.f, 0.f};
        }
        cur = nxt; cA = nA; cB = nB; ++ui;
    }
    PG8_WAIT_V(0);
    if (wr == 0) PG8_BAR;
    PG8_BAR;
#undef PG8_SA
#undef PG8_SB
#undef PG8_STAGE
#undef PG8_LDA
#undef PG8_LDB
#undef PG8_MMA
#undef PG8_WAIT_V
#undef PG8_WAIT_L
#undef PG8_BAR
#undef PG8_SCHED
}

#define EPI_ROWS_BEGIN \
    _Pragma("unroll") for (int ai = 0; ai < 2; ++ai) _Pragma("unroll") for (int m = 0; m < 4; ++m) { const int row = u.pm * 256 + ai * 128 + wr * 64 + m * 16 + fr; \
    _Pragma("unroll") for (int bj = 0; bj < 2; ++bj) { const int col = u.pn * 256 + bj * 128 + wc * 32 + 8 * fq; f32x4& v0 = acc[ai][bj][m][0]; f32x4& v1 = acc[ai][bj][m][1];
#define EPI_ROWS_END } __builtin_amdgcn_sched_barrier(0); }

struct EpiStoreBf16 {
    bf16_t* O; int ldc;
    __device__ __forceinline__ void operator()(Acc& acc, const Unit& u, int wr, int wc, int fr, int fq) const {
        EPI_ROWS_BEGIN
            u32x4 w; w.x = pk2(v0[0], v0[1]); w.y = pk2(v0[2], v0[3]); w.z = pk2(v1[0], v1[1]); w.w = pk2(v1[2], v1[3]);
            *(u32x4*)(O + (size_t)row * ldc + col) = w;
        EPI_ROWS_END
    }
};
struct EpiGlu {
    const bf16_t* ya; bf16_t* ya2;
    __device__ __forceinline__ void operator()(Acc& acc, const Unit& u, int wr, int wc, int fr, int fq) const {
        EPI_ROWS_BEGIN
            const u32x4 y = *(const u32x4*)(ya + (size_t)row * 512 + col);
            u32x4 w;
            w.x = pk2(bflo(y.x) * sigmoidf_(v0[0]), bfhi(y.x) * sigmoidf_(v0[1]));
            w.y = pk2(bflo(y.y) * sigmoidf_(v0[2]), bfhi(y.y) * sigmoidf_(v0[3]));
            w.z = pk2(bflo(y.z) * sigmoidf_(v1[0]), bfhi(y.z) * sigmoidf_(v1[1]));
            w.w = pk2(bflo(y.w) * sigmoidf_(v1[2]), bfhi(y.w) * sigmoidf_(v1[3]));
            *(u32x4*)(ya2 + (size_t)row * 1024 + col) = w;
        EPI_ROWS_END
    }
};
struct EpiMix {
    const bf16_t* z; bf16_t* mix;
    __device__ __forceinline__ void operator()(Acc& acc, const Unit& u, int wr, int wc, int fr, int fq) const {
        if (u.mode == 1) {
            EPI_ROWS_BEGIN
                const u32x4 ga = *(const u32x4*)(z + (size_t)row * INC + ZGA + col);
                const u32x4 gb = *(const u32x4*)(z + (size_t)row * INC + ZGB + col);
#define RATIO(a, b) ((1.0f + __expf(-(b))) * __builtin_amdgcn_rcpf(1.0f + __expf(-(a))))
                v0[0] *= RATIO(bflo(ga.x), bflo(gb.x)); v0[1] *= RATIO(bfhi(ga.x), bfhi(gb.x));
                v0[2] *= RATIO(bflo(ga.y), bflo(gb.y)); v0[3] *= RATIO(bfhi(ga.y), bfhi(gb.y));
                v1[0] *= RATIO(bflo(ga.z), bflo(gb.z)); v1[1] *= RATIO(bfhi(ga.z), bfhi(gb.z));
                v1[2] *= RATIO(bflo(ga.w), bflo(gb.w)); v1[3] *= RATIO(bfhi(ga.w), bfhi(gb.w));
#undef RATIO
            EPI_ROWS_END
        } else {
            EPI_ROWS_BEGIN
                const u32x4 gb = *(const u32x4*)(z + (size_t)row * INC + ZGB + col);
                u32x4 w;
                w.x = pk2(v0[0] * sigmoidf_(bflo(gb.x)), v0[1] * sigmoidf_(bfhi(gb.x)));
                w.y = pk2(v0[2] * sigmoidf_(bflo(gb.y)), v0[3] * sigmoidf_(bfhi(gb.y)));
                w.z = pk2(v1[0] * sigmoidf_(bflo(gb.z)), v1[1] * sigmoidf_(bfhi(gb.z)));
                w.w = pk2(v1[2] * sigmoidf_(bflo(gb.w)), v1[3] * sigmoidf_(bfhi(gb.w)));
                *(u32x4*)(mix + (size_t)row * 1024 + col) = w;
            EPI_ROWS_END
        }
    }
};
struct EpiRes {
    const float* xinP; const float* xinS; float* xout;
    __device__ __forceinline__ void operator()(Acc& acc, const Unit& u, int wr, int wc, int fr, int fq) const {
        EPI_ROWS_BEGIN
            const float* xi = (row < MP ? xinP + (size_t)row * 1024 : xinS + (size_t)(row - MP) * 1024) + col;
            const f32x4 a = *(const f32x4*)xi, b = *(const f32x4*)(xi + 4);
            float* xo = xout + (size_t)row * 1024 + col;
            *(f32x4*)xo = a + v0; *(f32x4*)(xo + 4) = b + v1;
        EPI_ROWS_END
    }
};
struct EpiUp {
    bf16_t* up; float* convP; float* convS;
    __device__ __forceinline__ void operator()(Acc& acc, const Unit& u, int wr, int wc, int fr, int fq) const {
        EPI_ROWS_BEGIN
            u32x4 w; w.x = pk2(v0[0], v0[1]); w.y = pk2(v0[2], v0[3]); w.z = pk2(v1[0], v1[1]); w.w = pk2(v1[2], v1[3]);
            *(u32x4*)(up + (size_t)row * INC + col) = w;
            float* cp = nullptr;
            if (row < MP) { const int t = row & 2047; if (t >= 2046) cp = convP + ((size_t)((row >> 11) * 2 + (t - 2046))) * INC + col; }
            else { const int r2 = row - MP, t = r2 & 7; if (t >= 6) cp = convS + ((size_t)((r2 >> 3) * 2 + (t - 6))) * INC + col; }
            if (cp) { *(f32x4*)cp = v0; *(f32x4*)(cp + 4) = v1; }
        EPI_ROWS_END
    }
};
}

__device__ __forceinline__ void transpose_item(const float* W, int K, int N, bf16_t* WT, int ldd, const float* gk, float* scr, int item, int lane) {
    const int nblk = N / 32, kb = item / nblk, nb = item % nblk, k0 = 64 * kb, n0 = 32 * nb;
#pragma unroll 8
    for (int i = 0; i < 32; ++i) { const int kk = 2 * i + (lane >> 5); float v = W[(size_t)(k0 + kk) * N + n0 + (lane & 31)]; if (gk) v *= gk[k0 + kk]; scr[kk * 33 + (lane & 31)] = v; }
    LDS_WAIT();
    const int c = lane & 7;
#pragma unroll
    for (int j = 0; j < 4; ++j) { const int n = (lane >> 3) + 8 * j; const float* s = scr + (8 * c) * 33 + n;
        u32x4 o; o.x = pk2(s[0 * 33], s[1 * 33]); o.y = pk2(s[2 * 33], s[3 * 33]); o.z = pk2(s[4 * 33], s[5 * 33]); o.w = pk2(s[6 * 33], s[7 * 33]);
        *(u32x4*)(WT + (size_t)(n0 + n) * ldd + k0 + 8 * c) = o; }
    LDS_WAIT();
}

__device__ __forceinline__ void rms_row_to_bf16(const float* xrow, bf16_t* orow, int lane) {
    const f32x4* xr = (const f32x4*)xrow + lane;
    f32x4 v[4]; float s = 0.f;
#pragma unroll
    for (int j = 0; j < 4; ++j) { v[j] = xr[64 * j]; s += (v[j].x * v[j].x + v[j].y * v[j].y) + (v[j].z * v[j].z + v[j].w * v[j].w); }
    const float rstd = rsqrtf(wave_sum(s) * (1.f / 1024.f) + EPSF);
    u32x2* o8 = (u32x2*)orow + lane;
#pragma unroll
    for (int j = 0; j < 4; ++j) { u32x2 w; w.x = pk2(v[j].x * rstd, v[j].y * rstd); w.y = pk2(v[j].z * rstd, v[j].w * rstd); o8[64 * j] = w; }
}

__device__ __forceinline__ void phase_rmsnorm(const KPG& p, int l, int wave, int lane) {
    const float* xb = (const float*)(p.ws + WS_X); bf16_t* h = (bf16_t*)(p.ws + WS_H);
    for (int row = fresh_bid() * 8 + wave; row < MT; row += gridDim.x * 8) {
        const float* xr = (l == 0) ? (row < MP ? p.in[0] + (size_t)row * 1024 : p.in[1] + (size_t)(row - MP) * 1024) : xb + (size_t)row * 1024;
        rms_row_to_bf16(xr, h + (size_t)row * 1024, lane);
    }
}

__device__ __forceinline__ void phase_prologue(const KPG& p, int l, unsigned char* lds, int wave, int lane) {
    float* scr = (float*)(lds + wave * 8448);
    const int gw = fresh_bid() * 8 + wave, NGW = gridDim.x * 8;
    constexpr int I_IN = 16 * 176, I_UP = 16 * 176, I_DN = 44 * 32, I_O = 16 * 32, I_RET = 16 * 32, I_SSM = 8 * 32, I_GLU = 8 * 16;
    constexpr int I_L = I_IN + I_UP + I_DN + I_O + I_RET + I_SSM + I_GLU;
    for (int it = gw; it < I_L; it += NGW) {
        int r = it;
        unsigned char* wl = p.ws + WS_WT + (size_t)l * LW_SIZE;
        if (r < I_IN) { transpose_item(p.in[7] + (size_t)l * 1024 * INC, 1024, INC, (bf16_t*)(wl + LW_IN), 1024, p.in[6] + l * 1024, scr, r, lane); continue; } r -= I_IN;
        if (r < I_UP) { transpose_item(p.in[21] + (size_t)l * 1024 * INC, 1024, INC, (bf16_t*)(wl + LW_UP), 1024, p.in[20] + l * 1024, scr, r, lane); continue; } r -= I_UP;
        if (r < I_DN) { transpose_item(p.in[24] + (size_t)l * DFF * 1024, DFF, 1024, (bf16_t*)(wl + LW_DOWN), DFF, nullptr, scr, r, lane); continue; } r -= I_DN;
        if (r < I_O) { transpose_item(p.in[19] + (size_t)l * 1024 * 1024, 1024, 1024, (bf16_t*)(wl + LW_O), 1024, nullptr, scr, r, lane); continue; } r -= I_O;
        if (r < I_RET) { transpose_item(p.in[18] + (size_t)l * 1024 * 1024, 1024, 1024, (bf16_t*)(wl + LW_RET), 1024, nullptr, scr, r, lane); continue; } r -= I_RET;
        if (r < I_SSM) { transpose_item(p.in[17] + (size_t)l * 512 * 1024, 512, 1024, (bf16_t*)(wl + LW_SSM), 1024, nullptr, scr, r, lane); continue; } r -= I_SSM;
        transpose_item(p.in[16] + (size_t)l * 512 * 512, 512, 512, (bf16_t*)(wl + LW_GLU), 512, nullptr, scr, r, lane);
    }
    const int gt = fresh_bid() * 512 + fresh_tid(), NGT = gridDim.x * 512;
    for (int it = gt; it < 32 * 64; it += NGT) {
        const int pp = it & 63, g = (it >> 6) & 31;
        const int gi = l * 32 + g, pi = gi * 64 + pp;
        const float dt = __expf(p.in[10][gi]), lr = p.in[8][pi], li = p.in[9][pi];
        float s1, c1; sincos_rev(li * dt * 0.15915494309189535f, s1, c1);
        const float m1 = __expf(lr * dt); const float lbr = m1 * c1, lbi = m1 * s1;
        const float nr = lbr - 1.0f, ni = lbi, den = 1.0f / (lr * lr + li * li);
        const float cr = (nr * lr + ni * li) * den, ci = (ni * lr - nr * li) * den;
        unsigned char* st = p.ws + WS_S5T + (size_t)l * S5_SIZE;
        const float* bre = p.in[11] + (size_t)pi * 16; const float* bim = p.in[12] + (size_t)pi * 16;
        bf16_t* bmre = (bf16_t*)(st + S5_BMT) + (size_t)(g * 128 + pp) * 16; bf16_t* bmim = (bf16_t*)(st + S5_BMT) + (size_t)(g * 128 + 64 + pp) * 16;
#pragma unroll
        for (int c = 0; c < 16; ++c) { const float br = bre[c], bi = bim[c]; bmre[c] = f2bf(cr * br - ci * bi); bmim[c] = f2bf(cr * bi + ci * br); }
        float2* lam = (float2*)(st + S5_LAM) + g * 64 + pp; *lam = make_float2(lbr, lbi);
        float s32, c32; sincos_rev(32.0f * li * dt * 0.15915494309189535f, s32, c32); const float m32 = __expf(32.0f * lr * dt);
        float2* lam32 = (float2*)(st + S5_LAM32) + g * 64 + pp; *lam32 = make_float2(m32 * c32, m32 * s32);
    }
    for (int it = gt; it < 32 * 16 * 128; it += NGT) {
        const int pq = it & 127, c = (it >> 7) & 15, g = (it >> 11) & 31;
        const size_t src = ((size_t)((l * 32 + g) * 16 + c)) * 64 + (pq & 63);
        const float v = pq < 64 ? p.in[13][src] : -p.in[14][src];
        ((bf16_t*)(p.ws + WS_S5T + (size_t)l * S5_SIZE + S5_CMT))[(g * 16 + c) * 128 + pq] = f2bf(v);
    }
    for (int it = gt; it < 2056 * 64; it += NGT) {
        const int j = it & 63, pi = it >> 6; const double pos = (double)(pi < 2048 ? pi : 16384 + pi - 2048);
        double inv = 1.0, r = 0.86596432336006535;
        int e = j;
#pragma unroll
        for (int b = 0; b < 6; ++b) { if (e & 1) inv *= r; r *= r; e >>= 1; }
        const double rev = pos * inv * 0.15915494309189535; const double fr_ = rev - __builtin_rint(rev);
        const float f = (float)fr_;
        ((float2*)(p.ws + WS_ROPE))[it] = make_float2(__builtin_amdgcn_cosf(f), __builtin_amdgcn_sinf(f));
    }
}

template <bool SAMPLE>
__device__ __forceinline__ void s5_tile(const KPG& p, int l, int g, int row0, int bseq, int chunk, bf16_t* Sl, int lane) {
    const bf16_t* z = (const bf16_t*)(p.ws + WS_Z); bf16_t* ya = (bf16_t*)(p.ws + WS_YA);
    const unsigned char* st = p.ws + WS_S5T + (size_t)l * S5_SIZE;
    const int half = lane >> 5, li = lane & 31;
    const bf16x8 uf = *(const bf16x8*)(z + (size_t)(row0 + li) * INC + g * 16 + 8 * half);
    f32x16 acc[4];
#pragma unroll
    for (int ct = 0; ct < 4; ++ct) {
        const bf16x8 bfr = *(const bf16x8*)((const bf16_t*)(st + S5_BMT) + (size_t)(g * 128 + ct * 32 + li) * 16 + 8 * half);
        f32x16 zz;
#pragma unroll
        for (int e = 0; e < 16; ++e) zz[e] = 0.f;
        acc[ct] = MFMA32(uf, bfr, zz);
    }
    MFMA_SETTLE();
    float2 lm[2]; lm[0] = ((const float2*)(st + S5_LAM))[g * 64 + li]; lm[1] = ((const float2*)(st + S5_LAM))[g * 64 + 32 + li];
    float sr[2] = {0.f, 0.f}, si[2] = {0.f, 0.f};
    const float* sin_ = (const float*)(p.ws + WS_SIN);
#pragma unroll
    for (int k = 0; k < 4; ++k) {
        if (SAMPLE || k == 0) {
#pragma unroll
            for (int pt = 0; pt < 2; ++pt) {
                if (SAMPLE) { const size_t o = ((size_t)((l * 128 + bseq + k) * 32 + g)) * 64 + pt * 32 + li; sr[pt] = p.in[2][o]; si[pt] = p.in[3][o]; }
                else {
                    const int sc = chunk >> 3, jj = chunk & 7;
                    const float2 l32 = ((const float2*)(st + S5_LAM32))[g * 64 + pt * 32 + li];
                    const float2 l64 = make_float2(l32.x * l32.x - l32.y * l32.y, 2.0f * l32.x * l32.y);
                    const float2 l128 = make_float2(l64.x * l64.x - l64.y * l64.y, 2.0f * l64.x * l64.y);
                    const float2 l256 = make_float2(l128.x * l128.x - l128.y * l128.y, 2.0f * l128.x * l128.y);
                    const float* Eb = (const float*)(p.ws + WS_E) + ((size_t)((bseq * 32 + g) * 8)) * 128 + pt * 32 + li;
                    float Sr = 0.f, Si = 0.f;
#pragma unroll
                    for (int i = 0; i < 7; ++i) { if (i < sc) { const float er = Eb[i * 128], ei = Eb[i * 128 + 64]; const float tr = l256.x * Sr - l256.y * Si + er, ti = l256.x * Si + l256.y * Sr + ei; Sr = tr; Si = ti; } }
                    float rr = 1.0f, ri = 0.0f;
                    if (jj & 1) { const float tr = rr * l32.x - ri * l32.y, ti = rr * l32.y + ri * l32.x; rr = tr; ri = ti; }
                    if (jj & 2) { const float tr = rr * l64.x - ri * l64.y, ti = rr * l64.y + ri * l64.x; rr = tr; ri = ti; }
                    if (jj & 4) { const float tr = rr * l128.x - ri * l128.y, ti = rr * l128.y + ri * l128.x; rr = tr; ri = ti; }
                    const size_t o = ((size_t)((bseq * 32 + g) * 64 + chunk)) * 128 + pt * 32 + li;
                    sr[pt] = sin_[o] + (rr * Sr - ri * Si); si[pt] = sin_[o + 64] + (rr * Si + ri * Sr);
                }
            }
        }
#pragma unroll
        for (int hh = 0; hh < 2; ++hh) {
            const bool mine = (half == hh);
            float tr_[2] = {sr[0], sr[1]}, ti_[2] = {si[0], si[1]};
#pragma unroll
            for (int q = 0; q < 4; ++q)
#pragma unroll
                for (int pt = 0; pt < 2; ++pt) {
                    const float tr = lm[pt].x * tr_[pt] - lm[pt].y * ti_[pt] + acc[pt][4 * k + q];
                    const float ti = lm[pt].x * ti_[pt] + lm[pt].y * tr_[pt] + acc[2 + pt][4 * k + q];
                    tr_[pt] = tr; ti_[pt] = ti;
                    acc[pt][4 * k + q] = mine ? tr : acc[pt][4 * k + q]; acc[2 + pt][4 * k + q] = mine ? ti : acc[2 + pt][4 * k + q];
                }
#pragma unroll
            for (int pt = 0; pt < 2; ++pt) { sr[pt] = mine ? tr_[pt] : sr[pt]; si[pt] = mine ? ti_[pt] : si[pt]; }
            if (SAMPLE && hh == 1) {
                if (mine) {
#pragma unroll
                    for (int pt = 0; pt < 2; ++pt) { const size_t o = ((size_t)((l * 128 + bseq + k) * 32 + g)) * 64 + pt * 32 + li;
                        p.out[O_SRS + o] = sr[pt]; p.out[O_SIS + o] = si[pt]; }
                }
            }
#pragma unroll
            for (int pt = 0; pt < 2; ++pt) { const float orr = xor32(sr[pt], half), oii = xor32(si[pt], half); sr[pt] = mine ? sr[pt] : orr; si[pt] = mine ? si[pt] : oii; }
        }
    }
    if (!SAMPLE && chunk == 63 && half == 0) {
#pragma unroll
        for (int pt = 0; pt < 2; ++pt) { const size_t o = ((size_t)((l * 8 + bseq) * 32 + g)) * 64 + pt * 32 + li; p.out[O_SRP + o] = sr[pt]; p.out[O_SIP + o] = si[pt]; }
    }
#pragma unroll
    for (int ct = 0; ct < 4; ++ct)
#pragma unroll
        for (int r = 0; r < 16; ++r) { const int t = (r & 3) + 8 * (r >> 2) + 4 * half; Sl[t * 136 + ct * 32 + li] = f2bf(acc[ct][r]); }
    LDS_WAIT();
    const int fr = lane & 15, fq = lane >> 4;
    bf16x8 cf[4];
#pragma unroll
    for (int ks = 0; ks < 4; ++ks) cf[ks] = *(const bf16x8*)((const bf16_t*)(st + S5_CMT) + (size_t)(g * 16 + fr) * 128 + ks * 32 + 8 * fq);
    const float dv = p.in[15][l * 512 + g * 16 + fr];
#pragma unroll
    for (int rt = 0; rt < 2; ++rt) {
        f32x4 y = {0.f, 0.f, 0.f, 0.f};
#pragma unroll
        for (int ks = 0; ks < 4; ++ks) { const bf16x8 a = *(const bf16x8*)(Sl + (rt * 16 + fr) * 136 + ks * 32 + 8 * fq); y = MFMA16(a, cf[ks], y); }
        MFMA_SETTLE();
#pragma unroll
        for (int r = 0; r < 4; ++r) { const int tok = row0 + rt * 16 + 4 * fq + r; const float uu = bf2f(z[(size_t)tok * INC + g * 16 + fr]);
            ya[(size_t)tok * 512 + g * 16 + fr] = f2bf(gelu_tanh(y[r] + dv * uu)); }
    }
    LDS_WAIT();
}

__device__ __forceinline__ void s5_m1(const KPG& p, int l, int b, int g, int sc, int lane) {
    const bf16_t* z = (const bf16_t*)(p.ws + WS_Z);
    const unsigned char* st = p.ws + WS_S5T + (size_t)l * S5_SIZE;
    const int half = lane >> 5, li = lane & 31;
    bf16x8 bfr[4];
#pragma unroll
    for (int ct = 0; ct < 4; ++ct) bfr[ct] = *(const bf16x8*)((const bf16_t*)(st + S5_BMT) + (size_t)(g * 128 + ct * 32 + li) * 16 + 8 * half);
    float2 lm[2]; lm[0] = ((const float2*)(st + S5_LAM))[g * 64 + li]; lm[1] = ((const float2*)(st + S5_LAM))[g * 64 + 32 + li];
    float sr[2] = {0.f, 0.f}, si[2] = {0.f, 0.f};
    float* sin_ = (float*)(p.ws + WS_SIN);
    for (int j = 0; j < 8; ++j) {
        const int chunk = sc * 8 + j, row0 = b * 2048 + chunk * 32;
        const bf16x8 uf = *(const bf16x8*)(z + (size_t)(row0 + li) * INC + g * 16 + 8 * half);
        if (half == 0) {
#pragma unroll
            for (int pt = 0; pt < 2; ++pt) { const size_t o = ((size_t)((b * 32 + g) * 64 + chunk)) * 128 + pt * 32 + li; sin_[o] = sr[pt]; sin_[o + 64] = si[pt]; }
        }
        f32x16 acc[4];
#pragma unroll
        for (int ct = 0; ct < 4; ++ct) {
            f32x16 zz;
#pragma unroll
            for (int e = 0; e < 16; ++e) zz[e] = 0.f;
            acc[ct] = MFMA32(uf, bfr[ct], zz);
        }
        MFMA_SETTLE();
#pragma unroll
        for (int k = 0; k < 4; ++k)
#pragma unroll
            for (int hh = 0; hh < 2; ++hh) {
                const bool mine = (half == hh);
                float tr_[2] = {sr[0], sr[1]}, ti_[2] = {si[0], si[1]};
#pragma unroll
                for (int q = 0; q < 4; ++q)
#pragma unroll
                    for (int pt = 0; pt < 2; ++pt) {
                        const float tr = lm[pt].x * tr_[pt] - lm[pt].y * ti_[pt] + acc[pt][4 * k + q];
                        const float ti = lm[pt].x * ti_[pt] + lm[pt].y * tr_[pt] + acc[2 + pt][4 * k + q];
                        tr_[pt] = tr; ti_[pt] = ti;
                    }
#pragma unroll
                for (int pt = 0; pt < 2; ++pt) { sr[pt] = mine ? tr_[pt] : sr[pt]; si[pt] = mine ? ti_[pt] : si[pt]; }
#pragma unroll
                for (int pt = 0; pt < 2; ++pt) { const float orr = xor32(sr[pt], half), oii = xor32(si[pt], half); sr[pt] = mine ? sr[pt] : orr; si[pt] = mine ? si[pt] : oii; }
            }
    }
    if (half == 0) {
        float* E = (float*)(p.ws + WS_E) + ((size_t)((b * 32 + g) * 8 + sc)) * 128;
#pragma unroll
        for (int pt = 0; pt < 2; ++pt) { E[pt * 32 + li] = sr[pt]; E[64 + pt * 32 + li] = si[pt]; }
    }
}

__device__ __forceinline__ float log2_gamma(int h) { return __log2f(1.0f - exp2f(-5.0f - (float)h)); }

__device__ __forceinline__ void rot8(const u32x4& lo, const u32x4& hi, const float2* rp, float scale, float* olo, float* ohi) {
    const unsigned lw[4] = {lo.x, lo.y, lo.z, lo.w}, hw[4] = {hi.x, hi.y, hi.z, hi.w};
#pragma unroll
    for (int e = 0; e < 8; ++e) {
        const float x1 = (e & 1) ? bfhi(lw[e >> 1]) : bflo(lw[e >> 1]);
        const float x2 = (e & 1) ? bfhi(hw[e >> 1]) : bflo(hw[e >> 1]);
        const float2 cs = rp[e];
        olo[e] = (x1 * cs.x - x2 * cs.y) * scale; ohi[e] = (x1 * cs.y + x2 * cs.x) * scale;
    }
}

__device__ __forceinline__ void ret_m1_unit(const KPG& p, int l, int unit, unsigned char* lds, int wave, int lane) {
    const int tid = fresh_tid(), b = unit >> 4, h = (unit >> 2) & 3, s = unit & 3;
    const bf16_t* z = (const bf16_t*)(p.ws + WS_Z); const float2* rope = (const float2*)(p.ws + WS_ROPE);
    bf16_t* RTb = (bf16_t*)(p.ws + WS_RT);
    bf16_t* KT = (bf16_t*)lds; bf16_t* VT = KT + 128 * 136;
    const float lg2 = log2_gamma(h), cdec = exp2f(128.0f * lg2);
    const int fr = lane & 15, fq = lane >> 4;
    f32x4 R[4];
#pragma unroll
    for (int nt = 0; nt < 4; ++nt) R[nt] = (f32x4){0.f, 0.f, 0.f, 0.f};
    u32x4 kl[2], kh[2], vv[2]; f32x4 rq[2][4];
#define RM1_PREFETCH(ii) _Pragma("unroll") for (int tk = 0; tk < 2; ++tk) { const int task_ = tid + 512 * tk, j_ = task_ & 127, dg_ = task_ >> 7; const size_t zrow_ = (size_t)(b * 2048 + (ii) * 128 + j_) * INC; \
        const bf16_t* zr_ = z + zrow_ + ZK + h * 128 + dg_ * 8; kl[tk] = *(const u32x4*)zr_; kh[tk] = *(const u32x4*)(zr_ + 64); \
        const f32x4* rs_ = (const f32x4*)(rope + (size_t)((ii) * 128 + j_) * 64 + dg_ * 8); rq[tk][0] = rs_[0]; rq[tk][1] = rs_[1]; rq[tk][2] = rs_[2]; rq[tk][3] = rs_[3]; \
        vv[tk] = *(const u32x4*)(z + zrow_ + ZV + h * 256 + s * 64 + dg_ * 8); }
    RM1_PREFETCH(0)
    for (int i = 0; i < 16; ++i) {
        bf16_t* rt = RTb + ((size_t)((b * 4 + h) * 16 + i)) * 256 * 128;
#pragma unroll
        for (int nt = 0; nt < 4; ++nt) { u32x2 w; w.x = pk2(R[nt][0], R[nt][1]); w.y = pk2(R[nt][2], R[nt][3]);
            *(u32x2*)(rt + (size_t)(64 * s + 16 * nt + fr) * 128 + 16 * wave + 4 * fq) = w; }
#pragma unroll
        for (int tk = 0; tk < 2; ++tk) {
            const int task = tid + 512 * tk, j = task & 127, dg = task >> 7;
            const float sc_ = 0.08838834764831845f * exp2f((float)(127 - j) * lg2);
            const unsigned lw[4] = {kl[tk].x, kl[tk].y, kl[tk].z, kl[tk].w}, hw[4] = {kh[tk].x, kh[tk].y, kh[tk].z, kh[tk].w}, vw[4] = {vv[tk].x, vv[tk].y, vv[tk].z, vv[tk].w};
#pragma unroll
            for (int e = 0; e < 8; ++e) {
                const float x1 = (e & 1) ? bfhi(lw[e >> 1]) : bflo(lw[e >> 1]), x2 = (e & 1) ? bfhi(hw[e >> 1]) : bflo(hw[e >> 1]);
                const float cs_ = rq[tk][e >> 1][(e & 1) * 2], sn_ = rq[tk][e >> 1][(e & 1) * 2 + 1];
                KT[(dg * 8 + e) * 136 + j] = f2bf((x1 * cs_ - x2 * sn_) * sc_); KT[(64 + dg * 8 + e) * 136 + j] = f2bf((x1 * sn_ + x2 * cs_) * sc_);
                VT[(dg * 8 + e) * 136 + j] = (bf16_t)((e & 1) ? (vw[e >> 1] >> 16) : (vw[e >> 1] & 0xffffu));
            }
        }
        if (i + 1 < 16) { RM1_PREFETCH(i + 1) }
        __syncthreads();
#pragma unroll
        for (int nt = 0; nt < 4; ++nt) R[nt] = R[nt] * cdec;
#pragma unroll
        for (int ks = 0; ks < 4; ++ks) {
            const bf16x8 a = *(const bf16x8*)(KT + (16 * wave + fr) * 136 + ks * 32 + 8 * fq);
#pragma unroll
            for (int nt = 0; nt < 4; ++nt) { const bf16x8 bb = *(const bf16x8*)(VT + (16 * nt + fr) * 136 + ks * 32 + 8 * fq); R[nt] = MFMA16(a, bb, R[nt]); }
        }
        MFMA_SETTLE();
        __syncthreads();
    }
#undef RM1_PREFETCH
    float* ro = p.out + O_RP + ((size_t)((l * 8 + b) * 4 + h)) * 128 * 256;
#pragma unroll
    for (int nt = 0; nt < 4; ++nt)
#pragma unroll
        for (int r = 0; r < 4; ++r) ro[(size_t)(16 * wave + 4 * fq + r) * 256 + 64 * s + 16 * nt + fr] = R[nt][r];
}

__device__ __forceinline__ void ret_m2_unit(const KPG& p, int l, int unit, unsigned char* lds, int wave, int lane) {
    const int tid = fresh_tid(), b = unit >> 6, h = (unit >> 4) & 3, i = unit & 15;
    const bf16_t* z = (const bf16_t*)(p.ws + WS_Z); const float2* rope = (const float2*)(p.ws + WS_ROPE);
    const bf16_t* RTb = (const bf16_t*)(p.ws + WS_RT); bf16_t* ob = (bf16_t*)(p.ws + WS_O);
    bf16_t* Qs = (bf16_t*)lds; bf16_t* Ks = Qs + 128 * 136; bf16_t* BIG = Ks + 128 * 136;
    const float lg2 = log2_gamma(h);
    const int fr = lane & 15, fq = lane >> 4, row0 = b * 2048 + i * 128;
#pragma unroll
    for (int tk = 0; tk < 2; ++tk) {
        const int task = tid + 512 * tk, dg = task & 7, j = task >> 3;
        const bf16_t* zr = z + (size_t)(row0 + j) * INC + h * 128 + dg * 8;
        const float2* rp = rope + (size_t)(i * 128 + j) * 64 + dg * 8;
        float olo[8], ohi[8];
        { const u32x4 lo = *(const u32x4*)(zr + ZQ), hi = *(const u32x4*)(zr + ZQ + 64); rot8(lo, hi, rp, 1.0f, olo, ohi);
          u32x4 w; w.x = pk2(olo[0], olo[1]); w.y = pk2(olo[2], olo[3]); w.z = pk2(olo[4], olo[5]); w.w = pk2(olo[6], olo[7]); *(u32x4*)(Qs + j * 136 + dg * 8) = w;
          w.x = pk2(ohi[0], ohi[1]); w.y = pk2(ohi[2], ohi[3]); w.z = pk2(ohi[4], ohi[5]); w.w = pk2(ohi[6], ohi[7]); *(u32x4*)(Qs + j * 136 + 64 + dg * 8) = w; }
        { const u32x4 lo = *(const u32x4*)(zr + ZK), hi = *(const u32x4*)(zr + ZK + 64); rot8(lo, hi, rp, 0.08838834764831845f, olo, ohi);
          u32x4 w; w.x = pk2(olo[0], olo[1]); w.y = pk2(olo[2], olo[3]); w.z = pk2(olo[4], olo[5]); w.w = pk2(olo[6], olo[7]); *(u32x4*)(Ks + j * 136 + dg * 8) = w;
          w.x = pk2(ohi[0], ohi[1]); w.y = pk2(ohi[2], ohi[3]); w.z = pk2(ohi[4], ohi[5]); w.w = pk2(ohi[6], ohi[7]); *(u32x4*)(Ks + j * 136 + 64 + dg * 8) = w; }
    }
    {
        const bf16_t* src = RTb + ((size_t)((b * 4 + h) * 16 + i)) * 256 * 128;
#pragma unroll
        for (int k = 0; k < 8; ++k) { const int idx = tid + 512 * k, dv = idx >> 4, c16 = idx & 15; *(u32x4*)(BIG + dv * 136 + c16 * 8) = *(const u32x4*)(src + (size_t)dv * 128 + c16 * 8); }
    }
    __syncthreads();
    bf16x8 Aq[4];
#pragma unroll
    for (int ks = 0; ks < 4; ++ks) Aq[ks] = *(const bf16x8*)(Qs + (16 * wave + fr) * 136 + ks * 32 + 8 * fq);
    f32x4 S[8];
#pragma unroll
    for (int jt = 0; jt < 8; ++jt) {
        S[jt] = (f32x4){0.f, 0.f, 0.f, 0.f};
        if (jt <= wave) {
#pragma unroll
            for (int ks = 0; ks < 4; ++ks) { const bf16x8 bb = *(const bf16x8*)(Ks + (16 * jt + fr) * 136 + ks * 32 + 8 * fq); S[jt] = MFMA16(Aq[ks], bb, S[jt]); }
        }
        __builtin_amdgcn_sched_barrier(0);
    }
    f32x4 O[16];
#pragma unroll
    for (int nt = 0; nt < 16; ++nt) {
        O[nt] = (f32x4){0.f, 0.f, 0.f, 0.f};
#pragma unroll
        for (int ks = 0; ks < 4; ++ks) { const bf16x8 bb = *(const bf16x8*)(BIG + (16 * nt + fr) * 136 + ks * 32 + 8 * fq); O[nt] = MFMA16(Aq[ks], bb, O[nt]); }
        if ((nt & 1) == 1) __builtin_amdgcn_sched_barrier(0);
    }
    MFMA_SETTLE();
    {
        float inn[4];
#pragma unroll
        for (int r = 0; r < 4; ++r) inn[r] = exp2f((float)(16 * wave + 4 * fq + r + 1) * lg2);
#pragma unroll
        for (int nt = 0; nt < 16; ++nt)
#pragma unroll
            for (int r = 0; r < 4; ++r) O[nt][r] *= inn[r];
    }
    __syncthreads();
#pragma unroll
    for (int jt = 0; jt < 8; ++jt)
#pragma unroll
        for (int r = 0; r < 4; ++r) {
            const int ii = 16 * wave + 4 * fq + r, jj = 16 * jt + fr;
            const float v = (jt <= wave && ii >= jj) ? S[jt][r] * exp2f((float)(ii - jj) * lg2) : 0.0f;
            Ks[ii * 136 + jj] = f2bf(v);
        }
#pragma unroll
    for (int k = 0; k < 8; ++k) {
        const int task = tid + 512 * k, j = task & 127, vg = task >> 7;
        const u32x4 v = *(const u32x4*)(z + (size_t)(row0 + j) * INC + ZV + h * 256 + vg * 8);
        const unsigned vw[4] = {v.x, v.y, v.z, v.w};
#pragma unroll
        for (int e = 0; e < 8; ++e) BIG[(vg * 8 + e) * 136 + j] = (bf16_t)((e & 1) ? (vw[e >> 1] >> 16) : (vw[e >> 1] & 0xffffu));
    }
    __syncthreads();
#pragma unroll
    for (int ks = 0; ks < 4; ++ks) {
        if (ks <= (wave >> 1)) {
            const bf16x8 a = *(const bf16x8*)(Ks + (16 * wave + fr) * 136 + ks * 32 + 8 * fq);
#pragma unroll
            for (int nt = 0; nt < 16; ++nt) { const bf16x8 bb = *(const bf16x8*)(BIG + (16 * nt + fr) * 136 + ks * 32 + 8 * fq); O[nt] = MFMA16(a, bb, O[nt]); if ((nt & 1) == 1) __builtin_amdgcn_sched_barrier(0); }
        }
    }
    MFMA_SETTLE();
#pragma unroll
    for (int r = 0; r < 4; ++r) {
        float ss = 0.f;
#pragma unroll
        for (int nt = 0; nt < 16; ++nt) ss += O[nt][r] * O[nt][r];
        ss = row_sum16(ss);
        const float rstd = rsqrtf(ss * (1.0f / 256.0f) + EPSF);
        const size_t tok = (size_t)(row0 + 16 * wave + 4 * fq + r);
#pragma unroll
        for (int nt = 0; nt < 16; ++nt) { const int col = h * 256 + 16 * nt + fr; const float gg = bf2f(z[tok * INC + ZGR + col]);
            ob[tok * 1024 + col] = f2bf(O[nt][r] * rstd * siluf_(gg)); }
    }
    __syncthreads();
}

__device__ __forceinline__ void ret_sample_unit(const KPG& p, int l, int unit, unsigned char* lds, int wave, int lane) {
    const int tid = fresh_tid(), b = unit >> 2, h = unit & 3;
    const bf16_t* z = (const bf16_t*)(p.ws + WS_Z); const float2* rope = (const float2*)(p.ws + WS_ROPE); bf16_t* ob = (bf16_t*)(p.ws + WS_O);
    float* qT = (float*)lds; float* kT = qT + 1024; float* ktT = kT + 1024; float* vs = ktT + 1024; float* sc = vs + 2048; float* opart = sc + 64;
    const float lg2 = log2_gamma(h);
    const int row0 = MP + b * 8;
    if (tid < 64) {
        const int i = tid >> 3, dg = tid & 7;
        const bf16_t* zr = z + (size_t)(row0 + i) * INC + h * 128 + dg * 8;
        const float2* rp = rope + (size_t)(2048 + i) * 64 + dg * 8;
        float olo[8], ohi[8];
        { const u32x4 lo = *(const u32x4*)(zr + ZQ), hi = *(const u32x4*)(zr + ZQ + 64); rot8(lo, hi, rp, 1.0f, olo, ohi);
#pragma unroll
          for (int e = 0; e < 8; ++e) { qT[(dg * 8 + e) * 8 + i] = olo[e]; qT[(64 + dg * 8 + e) * 8 + i] = ohi[e]; } }
        { const u32x4 lo = *(const u32x4*)(zr + ZK), hi = *(const u32x4*)(zr + ZK + 64); rot8(lo, hi, rp, 0.08838834764831845f, olo, ohi);
          const float tl = exp2f((float)(7 - i) * lg2);
#pragma unroll
          for (int e = 0; e < 8; ++e) { kT[(dg * 8 + e) * 8 + i] = olo[e]; kT[(64 + dg * 8 + e) * 8 + i] = ohi[e]; ktT[(dg * 8 + e) * 8 + i] = olo[e] * tl; ktT[(64 + dg * 8 + e) * 8 + i] = ohi[e] * tl; } }
    }
    if (tid < 256) {
#pragma unroll
        for (int i = 0; i < 8; ++i) vs[i * 256 + tid] = bf2f(z[(size_t)(row0 + i) * INC + ZV + h * 256 + tid]);
    }
    __syncthreads();
    if (tid < 64) {
        const int i = tid >> 3, j = tid & 7; float d = 0.f;
        for (int dd = 0; dd < 128; ++dd) d += qT[dd * 8 + i] * kT[dd * 8 + j];
        sc[tid] = (j <= i) ? d * exp2f((float)(i - j) * lg2) : 0.f;
    }
    {
        const int dv4 = (tid & 63) * 4;
        f32x4 vv[8], ao[8];
#pragma unroll
        for (int j = 0; j < 8; ++j) { vv[j] = *(const f32x4*)(vs + j * 256 + dv4); ao[j] = (f32x4){0.f, 0.f, 0.f, 0.f}; }
        const size_t so = ((size_t)((l * 128 + b) * 4 + h)) * 128 * 256;
        const float* r0 = p.in[4] + so; float* rn = p.out + O_RS + so;
        const float cdec = exp2f(8.0f * lg2);
#pragma unroll 8
        for (int dd = 0; dd < 16; ++dd) {
            const int d = wave * 16 + dd;
            const f32x4 r = *(const f32x4*)(r0 + (size_t)d * 256 + dv4);
            const f32x4 qa = *(const f32x4*)(qT + d * 8), qb = *(const f32x4*)(qT + d * 8 + 4), ka = *(const f32x4*)(ktT + d * 8), kb = *(const f32x4*)(ktT + d * 8 + 4);
            ao[0] += qa[0] * r; ao[1] += qa[1] * r; ao[2] += qa[2] * r; ao[3] += qa[3] * r; ao[4] += qb[0] * r; ao[5] += qb[1] * r; ao[6] += qb[2] * r; ao[7] += qb[3] * r;
            f32x4 nr = r * cdec;
            nr += ka[0] * vv[0]; nr += ka[1] * vv[1]; nr += ka[2] * vv[2]; nr += ka[3] * vv[3]; nr += kb[0] * vv[4]; nr += kb[1] * vv[5]; nr += kb[2] * vv[6]; nr += kb[3] * vv[7];
            *(f32x4*)(rn + (size_t)d * 256 + dv4) = nr;
        }
#pragma unroll
        for (int i = 0; i < 8; ++i) *(f32x4*)(opart + (wave * 8 + i) * 256 + dv4) = ao[i];
    }
    __syncthreads();
    {
        const int i = wave, dv4 = (tid & 63) * 4;
        f32x4 a = (f32x4){0.f, 0.f, 0.f, 0.f};
#pragma unroll
        for (int w = 0; w < 8; ++w) a += *(const f32x4*)(opart + (w * 8 + i) * 256 + dv4);
        a = a * exp2f((float)(i + 1) * lg2);
#pragma unroll
        for (int j = 0; j < 8; ++j) { if (j <= i) a += sc[i * 8 + j] * *(const f32x4*)(vs + j * 256 + dv4); }
        const float ss = wave_sum(a[0] * a[0] + a[1] * a[1] + a[2] * a[2] + a[3] * a[3]);
        const float rstd = rsqrtf(ss * (1.0f / 256.0f) + EPSF);
        const size_t tok = (size_t)(row0 + i);
        const u32x2 gw = *(const u32x2*)(z + tok * INC + ZGR + h * 256 + dv4);
        u32x2 w; w.x = pk2(a[0] * rstd * siluf_(bflo(gw.x)), a[1] * rstd * siluf_(bfhi(gw.x))); w.y = pk2(a[2] * rstd * siluf_(bflo(gw.y)), a[3] * rstd * siluf_(bfhi(gw.y)));
        *(u32x2*)(ob + tok * 1024 + h * 256 + dv4) = w;
    }
    __syncthreads();
}

__device__ __forceinline__ void phase_convact(const KPG& p, int l) {
    const bf16_t* up = (const bf16_t*)(p.ws + WS_Z); bf16_t* act = (bf16_t*)(p.ws + WS_ACT);
    const float* cw = p.in[22] + (size_t)l * 3 * INC; const float* cb = p.in[23] + (size_t)l * INC;
    const int NT = (512 + 128) * 352;
    for (int task = fresh_bid() * 512 + fresh_tid(); task < NT; task += gridDim.x * 512) {
        const int cgp = task % 352, rc = task / 352, j0 = cgp * 8;
        int row0, nrows; bool sample = rc >= 512;
        if (!sample) { row0 = rc * 32; nrows = 32; } else { row0 = MP + (rc - 512) * 8; nrows = 8; }
        float w0v[8], w1v[8], w2v[8], bv[8], w0g[8], w1g[8], w2g[8], bg[8];
#pragma unroll
        for (int e = 0; e < 8; ++e) { w0v[e] = cw[j0 + e]; w1v[e] = cw[INC + j0 + e]; w2v[e] = cw[2 * INC + j0 + e]; bv[e] = cb[j0 + e];
            w0g[e] = cw[DFF + j0 + e]; w1g[e] = cw[INC + DFF + j0 + e]; w2g[e] = cw[2 * INC + DFF + j0 + e]; bg[e] = cb[DFF + j0 + e]; }
        float p2v[8], p1v[8], p2g[8], p1g[8];
        if (sample) {
            const float* sc = p.in[5] + ((size_t)(l * 128 + (rc - 512)) * 2) * INC;
#pragma unroll
            for (int e = 0; e < 8; ++e) { p2v[e] = sc[j0 + e]; p1v[e] = sc[INC + j0 + e]; p2g[e] = sc[DFF + j0 + e]; p1g[e] = sc[INC + DFF + j0 + e]; }
        } else if ((row0 & 2047) == 0) {
#pragma unroll
            for (int e = 0; e < 8; ++e) { p2v[e] = 0.f; p1v[e] = 0.f; p2g[e] = 0.f; p1g[e] = 0.f; }
        } else {
            const u32x4 a = *(const u32x4*)(up + (size_t)(row0 - 2) * INC + j0), b = *(const u32x4*)(up + (size_t)(row0 - 1) * INC + j0);
            const u32x4 c = *(const u32x4*)(up + (size_t)(row0 - 2) * INC + DFF + j0), d = *(const u32x4*)(up + (size_t)(row0 - 1) * INC + DFF + j0);
            const unsigned aw[4] = {a.x, a.y, a.z, a.w}, bw[4] = {b.x, b.y, b.z, b.w}, cw_[4] = {c.x, c.y, c.z, c.w}, dw[4] = {d.x, d.y, d.z, d.w};
#pragma unroll
            for (int e = 0; e < 8; ++e) { p2v[e] = (e & 1) ? bfhi(aw[e >> 1]) : bflo(aw[e >> 1]); p1v[e] = (e & 1) ? bfhi(bw[e >> 1]) : bflo(bw[e >> 1]);
                p2g[e] = (e & 1) ? bfhi(cw_[e >> 1]) : bflo(cw_[e >> 1]); p1g[e] = (e & 1) ? bfhi(dw[e >> 1]) : bflo(dw[e >> 1]); }
        }
        for (int r = 0; r < nrows; ++r) {
            const u32x4 a = *(const u32x4*)(up + (size_t)(row0 + r) * INC + j0), c = *(const u32x4*)(up + (size_t)(row0 + r) * INC + DFF + j0);
            const unsigned aw[4] = {a.x, a.y, a.z, a.w}, cw_[4] = {c.x, c.y, c.z, c.w};
            float o[8];
#pragma unroll
            for (int e = 0; e < 8; ++e) {
                const float cv = (e & 1) ? bfhi(aw[e >> 1]) : bflo(aw[e >> 1]), cg_ = (e & 1) ? bfhi(cw_[e >> 1]) : bflo(cw_[e >> 1]);
                const float val = bv[e] + w0v[e] * p2v[e] + w1v[e] * p1v[e] + w2v[e] * cv;
                const float gat = bg[e] + w0g[e] * p2g[e] + w1g[e] * p1g[e] + w2g[e] * cg_;
                o[e] = siluf_(gat) * val;
                p2v[e] = p1v[e]; p1v[e] = cv; p2g[e] = p1g[e]; p1g[e] = cg_;
            }
            u32x4 w; w.x = pk2(o[0], o[1]); w.y = pk2(o[2], o[3]); w.z = pk2(o[4], o[5]); w.w = pk2(o[6], o[7]);
            *(u32x4*)(act + (size_t)(row0 + r) * DFF + j0) = w;
        }
    }
}

#endif

__global__ void __launch_bounds__(512, 2) fwd_kernel(KP p) {
#if defined(__HIP_DEVICE_COMPILE__)
    extern __shared__ __attribute__((aligned(16))) unsigned char lds[];
    cg::grid_group grid = cg::this_grid();
    volatile LAS unsigned* barw = (volatile LAS unsigned*)((LAS unsigned char*)lds + LDS_BARW);
    if (threadIdx.x < 4) barw[threadIdx.x] = 0u;
    if (threadIdx.x == 0) {
        LAS unsigned long long* t = (LAS unsigned long long*)((LAS unsigned char*)lds + LDS_TAB);
#pragma unroll
        for (int i = 0; i < 26; ++i) t[i] = (unsigned long long)p.in[i];
        t[26] = (unsigned long long)p.out; t[27] = (unsigned long long)p.ws;
    }
    __syncthreads();
    (void)xcd_barrier_post((unsigned*)(p.ws + WS_CTL), barw);
#if USE_CG
#define GSYNC() grid.sync()
#else
#define GSYNC() do { XcdBarrier b_; b_.bar = (unsigned*)((GAS unsigned char*)ld_tab(lds, 27) + WS_CTL); b_.x = xb_xcc_id(); b_.st = (volatile LAS unsigned*)((LAS unsigned char*)lds + LDS_BARW); xcd_barrier(b_); } while (0)
#endif
#define PH_BEGIN const KPG q = load_kp(lds); const int tid_ = fresh_tid(), lane = tid_ & 63, wave = __builtin_amdgcn_readfirstlane(tid_ >> 6); (void)lane; (void)wave; \
                 const int G = gridDim.x, c = fresh_bid(); (void)G; (void)c; LAS unsigned char* glds = (LAS unsigned char*)lds; (void)glds;

    for (int l = 0; l < DEPTH; ++l) {
        {
            PH_BEGIN
#ifndef NO_PRO
            phase_prologue(q, l, lds, wave, lane);
#endif
            phase_rmsnorm(q, l, wave, lane);
        }
        if (l == 0) grid.sync();
        GSYNC();
        {
            PH_BEGIN
            unsigned char* wl = q.ws + WS_WT + (size_t)l * LW_SIZE;
            pg8::Sched S{(const char*)(q.ws + WS_H), (const char*)(wl + LW_IN), nullptr, nullptr, 16, 0, 1024, MT / 256, INC / 256, G, c};
            pg8::EpiStoreBf16 E{(bf16_t*)(q.ws + WS_Z), INC};
#if !defined(NO_GEMM) && (!defined(ONLY_GEMM) || ONLY_GEMM == 0)
            pg8::gemm_phase(glds, S, E);
#endif
        }
        GSYNC();
        {
            PH_BEGIN
#ifndef NO_RM1
            for (int u = c; u < 128; u += G) ret_m1_unit(q, l, u, lds, wave, lane);
#endif
#ifndef NO_RS
            for (int u = c - 128; u >= 0 && u < 512; u += 128) ret_sample_unit(q, l, u, lds, wave, lane);
#endif
        }
        {
            PH_BEGIN
#ifndef NO_SM1
            for (int u = c - 128; u >= 0 && u < 256; u += 128) { const int wt = u * 8 + wave; s5_m1(q, l, wt >> 8, (wt >> 3) & 31, wt & 7, lane); }
#endif
        }
        {
            PH_BEGIN
#ifndef NO_SS
            for (int u = c - 128; u >= 0 && u < 128; u += G) { const int g = (u >> 4) * 4 + (wave & 3), bq = (u & 15) * 2 + (wave >> 2);
                s5_tile<true>(q, l, g, MP + bq * 32, bq * 4, 0, (bf16_t*)(lds + wave * 8704), lane); }
#endif
        }
        GSYNC();
        {
            PH_BEGIN
#ifndef NO_RM2
            for (int u = c; u < 512; u += G) ret_m2_unit(q, l, u, lds, wave, lane);
#endif
        }
        {
            PH_BEGIN
#ifndef NO_SM2
            for (int uu = c; uu < 2048; uu += G) { const int chunk = (uu & 31) * 2 + (wave >> 2), g = ((uu >> 5) & 7) * 4 + (wave & 3), b = uu >> 8;
                s5_tile<false>(q, l, g, b * 2048 + chunk * 32, b, chunk, (bf16_t*)(lds + wave * 8704), lane); }
#endif
        }
        GSYNC();
        {
            PH_BEGIN
            unsigned char* wl = q.ws + WS_WT + (size_t)l * LW_SIZE;
            pg8::Sched S{(const char*)(q.ws + WS_YA), (const char*)(wl + LW_GLU), nullptr, nullptr, 8, 0, 512, MT / 256, 2, G, c};
            pg8::EpiGlu E{(const bf16_t*)(q.ws + WS_YA), (bf16_t*)(q.ws + WS_YA2)};
#if !defined(NO_GEMM) && (!defined(ONLY_GEMM) || ONLY_GEMM == 1)
            pg8::gemm_phase(glds, S, E);
#endif
        }
        GSYNC();
        {
            PH_BEGIN
            unsigned char* wl = q.ws + WS_WT + (size_t)l * LW_SIZE;
            pg8::Sched S{(const char*)(q.ws + WS_YA2), (const char*)(wl + LW_SSM), (const char*)(q.ws + WS_O), (const char*)(wl + LW_RET), 8, 16, 1024, MT / 256, 4, G, c};
            pg8::EpiMix E{(const bf16_t*)(q.ws + WS_Z), (bf16_t*)(q.ws + WS_MIX)};
#if !defined(NO_GEMM) && (!defined(ONLY_GEMM) || ONLY_GEMM == 2)
            pg8::gemm_phase(glds, S, E);
#endif
        }
        GSYNC();
        {
            PH_BEGIN
            unsigned char* wl = q.ws + WS_WT + (size_t)l * LW_SIZE;
            pg8::Sched S{(const char*)(q.ws + WS_MIX), (const char*)(wl + LW_O), nullptr, nullptr, 16, 0, 1024, MT / 256, 4, G, c};
            pg8::EpiRes E{l == 0 ? q.in[0] : (const float*)(q.ws + WS_X), l == 0 ? q.in[1] : (const float*)(q.ws + WS_X) + (size_t)MP * 1024, (float*)(q.ws + WS_X)};
#if !defined(NO_GEMM) && (!defined(ONLY_GEMM) || ONLY_GEMM == 3)
            pg8::gemm_phase(glds, S, E);
#endif
        }
        GSYNC();
        { PH_BEGIN phase_rmsnorm(q, 1, wave, lane); }
        GSYNC();
        {
            PH_BEGIN
            unsigned char* wl = q.ws + WS_WT + (size_t)l * LW_SIZE;
            pg8::Sched S{(const char*)(q.ws + WS_H), (const char*)(wl + LW_UP), nullptr, nullptr, 16, 0, 1024, MT / 256, INC / 256, G, c};
            pg8::EpiUp E{(bf16_t*)(q.ws + WS_Z), q.out + O_CP + (size_t)l * 8 * 2 * INC, q.out + O_CS + (size_t)l * 128 * 2 * INC};
#if !defined(NO_GEMM) && (!defined(ONLY_GEMM) || ONLY_GEMM == 4)
            pg8::gemm_phase(glds, S, E);
#endif
        }
        GSYNC();
        {
            PH_BEGIN
#ifndef NO_CONV
            phase_convact(q, l);
#endif
        }
        GSYNC();
        {
            PH_BEGIN
            unsigned char* wl = q.ws + WS_WT + (size_t)l * LW_SIZE;
            pg8::Sched S{(const char*)(q.ws + WS_ACT), (const char*)(wl + LW_DOWN), nullptr, nullptr, 44, 0, DFF, MT / 256, 4, G, c};
            pg8::EpiRes E{(const float*)(q.ws + WS_X), (const float*)(q.ws + WS_X) + (size_t)MP * 1024, (float*)(q.ws + WS_X)};
#if !defined(NO_GEMM) && (!defined(ONLY_GEMM) || ONLY_GEMM == 5)
            pg8::gemm_phase(glds, S, E);
#endif
        }
        GSYNC();
    }
    {
        PH_BEGIN
        const float* xb = (const float*)(q.ws + WS_X); const float* gf = q.in[25];
        for (int row = c * 8 + wave; row < MT; row += G * 8) {
            const f32x4* xr = (const f32x4*)(xb + (size_t)row * 1024) + lane; const f32x4* gr = (const f32x4*)gf + lane;
            f32x4 v[4]; float s = 0.f;
#pragma unroll
            for (int j = 0; j < 4; ++j) { v[j] = xr[64 * j]; s += (v[j].x * v[j].x + v[j].y * v[j].y) + (v[j].z * v[j].z + v[j].w * v[j].w); }
            const float rstd = rsqrtf(wave_sum(s) * (1.f / 1024.f) + EPSF);
            f32x4* o = (f32x4*)(q.out + O_YP + (size_t)row * 1024) + lane;
#pragma unroll
            for (int j = 0; j < 4; ++j) o[64 * j] = v[j] * rstd * gr[64 * j];
        }
    }
#endif
}

extern "C" void kernel_launch(void* const* d_in, const int* in_sizes, int n_in, void* d_out, int out_size, void* d_ws, size_t ws_size, hipStream_t stream) {
    static int grid = 0;
    if (grid == 0) {
        if (n_in != 26 || ws_size < WS_END) { fprintf(stderr, "kernel_launch: unexpected shapes (n_in %d, ws %zu < %zu)\n", n_in, ws_size, (size_t)WS_END); grid = -1; return; }
        int dev = 0, cus = 0, per_cu = 0;
        hipGetDevice(&dev);
        hipDeviceGetAttribute(&cus, hipDeviceAttributeMultiprocessorCount, dev);
        if (hipFuncSetAttribute((const void*)fwd_kernel, hipFuncAttributeMaxDynamicSharedMemorySize, LDS_BYTES) != hipSuccess) { fprintf(stderr, "kernel_launch: hipFuncSetAttribute failed\n"); grid = -1; return; }
        hipOccupancyMaxActiveBlocksPerMultiprocessor(&per_cu, (const void*)fwd_kernel, 512, LDS_BYTES);
        (void)hipGetLastError();
        if (per_cu < 1) per_cu = 1;
        grid = cus * 1;
    }
    if (grid < 0) return;
    hipMemsetAsync((char*)d_ws + WS_CTL, 0, 65536, stream);
    KP p{};
    for (int i = 0; i < 26; ++i) p.in[i] = (const float*)d_in[i];
    p.out = (float*)d_out; p.ws = (unsigned char*)d_ws;
    void* args[] = {&p};
    hipError_t e = hipLaunchCooperativeKernel((const void*)fwd_kernel, dim3(grid), dim3(512), args, LDS_BYTES, stream);
    if (e != hipSuccess) fprintf(stderr, "cooperative launch failed: %s (grid %d)\n", hipGetErrorString(e), grid);
}
```

```cpp
#include <hip/hip_runtime.h>
#include <hip/hip_cooperative_groups.h>
#include <cstdio>
#include <cstdint>
namespace cg = cooperative_groups;

#ifndef USE_CG
#define USE_CG 0
#endif

#define LAS __attribute__((address_space(3)))
typedef unsigned short bf16_t;
typedef short bf16x8 __attribute__((ext_vector_type(8)));
typedef float f32x4 __attribute__((ext_vector_type(4)));
typedef float f32x16 __attribute__((ext_vector_type(16)));
typedef unsigned u32x4 __attribute__((ext_vector_type(4)));
typedef unsigned u32x2 __attribute__((ext_vector_type(2)));

constexpr int DM = 1024, MP = 16384, MS = 1024, MT = MP + MS, DEPTH = 4;
constexpr int INC = 5632, DFF = 2816, DSSM = 512;
constexpr int ZQ = 512, ZK = 1024, ZV = 1536, ZGR = 2560, ZGA = 3584, ZGB = 4608;
constexpr float EPSF = 1e-6f;
constexpr size_t O_YP = 0, O_YS = 16777216, O_SRP = 17825792, O_SIP = 17891328, O_RP = 17956864, O_CP = 22151168,
                 O_SRS = 22511616, O_SIS = 23560192, O_RS = 24608768, O_CS = 91717632;
constexpr size_t WS_CTL = 0;
constexpr size_t WS_WT = 65536;
constexpr size_t LW_IN = 0, LW_UP = 11534336, LW_DOWN = LW_UP + 11534336, LW_O = LW_DOWN + 5767168, LW_RET = LW_O + 2097152,
                 LW_SSM = LW_RET + 2097152, LW_GLU = LW_SSM + 2097152, LW_SIZE = LW_GLU + 524288;
constexpr size_t WS_S5T = WS_WT + 4 * LW_SIZE;
constexpr size_t S5_MB = 0, S5_BMT = 4194304, S5_CMT = S5_BMT + 131072, S5_LAM = S5_CMT + 131072, S5_LAM32 = S5_LAM + 16384, S5_SIZE = S5_LAM32 + 16384;
constexpr size_t WS_ROPE = WS_S5T + 4 * S5_SIZE;
constexpr size_t WS_X = WS_ROPE + 1052672;
constexpr size_t WS_H = WS_X + (size_t)MT * 1024 * 4;
constexpr size_t WS_Z = WS_H + (size_t)MT * 1024 * 2;
constexpr size_t WS_YA = WS_Z + (size_t)MT * INC * 2;
constexpr size_t WS_YA2 = WS_YA + (size_t)MT * 512 * 2;
constexpr size_t WS_O = WS_YA2 + (size_t)MT * 1024 * 2;
constexpr size_t WS_MIX = WS_O + (size_t)MT * 1024 * 2;
constexpr size_t WS_ACT = WS_MIX + (size_t)MT * 1024 * 2;
constexpr size_t WS_SIN = WS_ACT + (size_t)MT * DFF * 2;
constexpr size_t WS_RT = WS_SIN + (size_t)8 * 32 * 64 * 128 * 4;
constexpr size_t WS_E = WS_RT + (size_t)32 * 16 * 256 * 128 * 2;
constexpr size_t WS_END = WS_E + (size_t)8 * 32 * 8 * 128 * 4;

constexpr int LDS_BYTES = 147456;
constexpr int LDS_BARW = LDS_BYTES - 16;

#define GAS __attribute__((address_space(1)))
struct KP { const float* in[26]; float* out; unsigned char* ws; };
#if defined(__HIP_DEVICE_COMPILE__)
struct KPG { const GAS float* in[26]; GAS float* out; GAS unsigned char* ws; };
constexpr int LDS_TAB = LDS_BYTES - 16 - 256;
__device__ __forceinline__ unsigned long long ld_tab(const unsigned char* lds, int i) {
    unsigned off = (unsigned)(LDS_TAB + 8 * i); asm volatile("" : "+v"(off));
    const unsigned long long v = *(const LAS unsigned long long*)((const LAS unsigned char*)lds + off);
    const unsigned lo = __builtin_amdgcn_readfirstlane((unsigned)v), hi = __builtin_amdgcn_readfirstlane((unsigned)(v >> 32));
    return ((unsigned long long)hi << 32) | lo;
}
__device__ __forceinline__ KPG load_kp(const unsigned char* lds) {
    KPG q; asm volatile("" ::: "memory");
#pragma unroll
    for (int i = 0; i < 26; ++i) q.in[i] = (const GAS float*)ld_tab(lds, i);
    q.out = (GAS float*)ld_tab(lds, 26); q.ws = (GAS unsigned char*)ld_tab(lds, 27);
    return q;
}
__device__ __forceinline__ int fresh_tid() { int t = threadIdx.x; asm volatile("" : "+v"(t)); return t; }
__device__ __forceinline__ int fresh_bid() { int b = blockIdx.x; asm volatile("" : "+s"(b)); return b; }

__device__ __forceinline__ float bf2f(bf16_t b) { return __uint_as_float(((unsigned)b) << 16); }
__device__ __forceinline__ float bflo(unsigned w) { return __uint_as_float(w << 16); }
__device__ __forceinline__ float bfhi(unsigned w) { return __uint_as_float(w & 0xffff0000u); }
__device__ __forceinline__ bf16_t f2bf(float f) { unsigned u = __float_as_uint(f); u += 0x7FFFu + ((u >> 16) & 1u); return (bf16_t)(u >> 16); }
__device__ __forceinline__ unsigned pk2(float lo, float hi) { unsigned r; asm volatile("v_cvt_pk_bf16_f32 %0, %1, %2" : "=v"(r) : "v"(lo), "v"(hi)); return r; }
template <int CTRL> __device__ __forceinline__ float dppf(float x) { return __uint_as_float((unsigned)__builtin_amdgcn_update_dpp(0, (int)__float_as_uint(x), CTRL, 0xf, 0xf, false)); }
__device__ __forceinline__ float row_sum16(float x) {
    x += dppf<0xB1>(x); x += dppf<0x4E>(x); x += dppf<0x141>(x); x += dppf<0x140>(x); return x;
}
__device__ __forceinline__ float wave_sum(float v) {
    const float r = row_sum16(v);
    return (__builtin_amdgcn_readlane(r, 0) + __builtin_amdgcn_readlane(r, 16)) + (__builtin_amdgcn_readlane(r, 32) + __builtin_amdgcn_readlane(r, 48));
}
__device__ __forceinline__ float xor32(float x, int half) { const unsigned u = __float_as_uint(x); auto r = __builtin_amdgcn_permlane32_swap(u, u, false, false); return __uint_as_float(half ? r[0] : r[1]); }
__device__ __forceinline__ float sigmoidf_(float x) { return __builtin_amdgcn_rcpf(1.0f + __expf(-x)); }
__device__ __forceinline__ float siluf_(float x) { return x * __builtin_amdgcn_rcpf(1.0f + __expf(-x)); }
__device__ __forceinline__ float gelu_tanh(float x) { const float u = 0.7978845608028654f * (x + 0.044715f * x * x * x); return x * __builtin_amdgcn_rcpf(1.0f + __expf(-2.0f * u)); }
__device__ __forceinline__ void sincos_rev(float rev, float& s, float& c) {
    const float f = rev - rintf(rev);
    s = __builtin_amdgcn_sinf(f); c = __builtin_amdgcn_cosf(f);
}
#define LDS_WAIT() asm volatile("s_waitcnt lgkmcnt(0)" ::: "memory")
#define MFMA16(a, b, c) __builtin_amdgcn_mfma_f32_16x16x32_bf16((a), (b), (c), 0, 0, 0)
#define MFMA32(a, b, c) __builtin_amdgcn_mfma_f32_32x32x16_bf16((a), (b), (c), 0, 0, 0)
#define MFMA_SETTLE() do { __builtin_amdgcn_sched_barrier(0); asm volatile("s_nop 15\n\ts_nop 15\n\ts_nop 15\n\ts_nop 15" ::: "memory"); __builtin_amdgcn_sched_barrier(0); } while (0)

#define XB_TMO      128
#define XB_XCNT(j)  (256  + 64 * (j))
#define XB_XSUB(j)  (1280 + 64 * (j))
#define XB_XGEN(j)  (2304 + 64 * (j))
#define XB_TOP      3328
#define XB_TOPGEN   3392
#define XCD_BAR_WORDS 3456
#define XB_SPIN_CAP (1u << 22)
__device__ __forceinline__ unsigned xb_ld(unsigned* p)              { return __hip_atomic_load(p, __ATOMIC_RELAXED, __HIP_MEMORY_SCOPE_AGENT); }
__device__ __forceinline__ unsigned xb_add(unsigned* p, unsigned v) { return __hip_atomic_fetch_add(p, v, __ATOMIC_RELAXED, __HIP_MEMORY_SCOPE_AGENT); }
__device__ __forceinline__ unsigned xb_xcc_id() { return (unsigned)__builtin_amdgcn_s_getreg((3 << 11) | 20) & 0xFu; }
#define XB_SPIN(cond, bar) do { unsigned _sp = 0; while (cond) { __builtin_amdgcn_s_sleep(1); \
    if ((++_sp & 255u) == 0u) { if (xb_ld(&(bar)[XB_TMO])) break; if (_sp > XB_SPIN_CAP) { atomicAdd(&(bar)[XB_TMO], 1u); break; } } } } while (0)
struct XcdBarrier { unsigned* bar; unsigned x; volatile LAS unsigned* st; };
__device__ __forceinline__ XcdBarrier xcd_barrier_post(unsigned* bar, volatile LAS unsigned* st) {
    XcdBarrier b; b.bar = bar; b.x = xb_xcc_id(); b.st = st;
    if (threadIdx.x == 0) (void)xb_add(&bar[XB_XCNT(b.x)], 1u);
    return b;
}
__device__ __forceinline__ void xcd_barrier_complete(unsigned* bar, unsigned x, unsigned& nloc, unsigned& nx) {
    const unsigned G = gridDim.x * gridDim.y * gridDim.z;
    unsigned sum, cnt, mine, sp = 0u;
    for (;;) {
        sum = 0u; cnt = 0u; mine = 0u;
#pragma unroll
        for (unsigned j = 0; j < 16; ++j) { const unsigned c = xb_ld(&bar[XB_XCNT(j)]); sum += c; cnt += (c > 0u) ? 1u : 0u; mine = (j == x) ? c : mine; }
        if (sum == G) break;
        __builtin_amdgcn_s_sleep(1);
        if ((++sp & 255u) == 0u) { if (xb_ld(&bar[XB_TMO])) break; if (sp > XB_SPIN_CAP) { atomicAdd(&bar[XB_TMO], 1u); break; } }
    }
    nloc = mine > 0u ? mine : 1u; nx = cnt > 0u ? cnt : 1u;
}
__device__ __forceinline__ void xcd_barrier(const XcdBarrier& b) {
    asm volatile("s_waitcnt vmcnt(0)" ::: "memory");
    __syncthreads();
    if (threadIdx.x == 0) {
        unsigned* bar = b.bar;
        __builtin_amdgcn_s_waitcnt(0);
        unsigned nloc = b.st[0], nx = b.st[1];
        if (nloc == 0u) { xcd_barrier_complete(bar, b.x, nloc, nx); b.st[0] = nloc; b.st[1] = nx; }
        const unsigned old = xb_add(&bar[XB_XSUB(b.x)], 1u);
        const unsigned gen = old / nloc;
        if (old + 1u == (gen + 1u) * nloc) {
            __builtin_amdgcn_fence(__ATOMIC_RELEASE, "agent");
            asm volatile("s_waitcnt vmcnt(0)" ::: "memory");
            const unsigned og = xb_add(&bar[XB_TOP], 1u);
            const unsigned tg = og / nx;
            if (og + 1u == (tg + 1u) * nx) xb_add(&bar[XB_TOPGEN], 1u);
            else XB_SPIN(xb_ld(&bar[XB_TOPGEN]) == tg, bar);
            __builtin_amdgcn_fence(__ATOMIC_ACQUIRE, "agent");
            xb_add(&bar[XB_XGEN(b.x)], 1u);
            asm volatile("s_waitcnt vmcnt(0)" ::: "memory");
        } else {
            XB_SPIN(xb_ld(&bar[XB_XGEN(b.x)]) == gen, bar);
            __builtin_amdgcn_fence(__ATOMIC_ACQUIRE, "agent");
            asm volatile("s_waitcnt vmcnt(0)" ::: "memory");
        }
    }
    __syncthreads();
}

namespace pg8 {
constexpr int BM = 256, BK = 64, HALF = 128, HTB = HALF * BK * 2, STAGE_BYTES = 8 * HTB, NXCD = 8, WGM = 8;
__device__ __forceinline__ int lds_byte(int r, int c) { const int st = (r >> 4) * 2 + (c >> 5), rr = r & 15, cc = c & 31, ob = rr * 64 + cc * 2; return st * 1024 + (ob ^ (((ob >> 9) & 1) << 5)); }
__device__ __forceinline__ void stage_rc(int b, int& R, int& C) { const int st = b / 1024, sb = b % 1024, swz = sb ^ (((sb >> 9) & 1) << 5); R = (st >> 1) * 16 + swz / 64; C = (st & 1) * 32 + (swz % 64) / 2; }
__device__ __forceinline__ int perm32(int rho) { const int n = rho >> 4, i = rho & 15; return 8 * (i >> 2) + 4 * n + (i & 3); }

struct Unit { const char* A; const char* B; int nt, mode, pm, pn; };
struct Sched {
    const char *A0, *B0, *A1, *B1; int nt0, nt1, ld, nM, nN, G, c;
    __device__ __forceinline__ bool next(int i, Unit& u) const {
        const int dual = (A1 != nullptr) ? 1 : 0; const int ti = dual ? (i >> 1) : i, sub = dual ? (i & 1) : 0;
        const int nwg = nM * nN; const long L = (long)ti * G + c; if (L >= nwg) return false;
        int wgid = (int)L; { const int q = nwg / NXCD, r = nwg % NXCD, xcd = wgid % NXCD, off = wgid / NXCD; wgid = (xcd < r ? xcd * (q + 1) : r * (q + 1) + (xcd - r) * q) + off; }
        const int nig = WGM * nN, gid = wgid / nig, fm = gid * WGM, gsz = (nM - fm) < WGM ? (nM - fm) : WGM;
        u.pm = fm + ((wgid % nig) % gsz); u.pn = (wgid % nig) / gsz;
        const size_t tstep = (size_t)BM * ld * 2;
        u.A = (sub ? A1 : A0) + (size_t)u.pm * tstep; u.B = (sub ? B1 : B0) + (size_t)u.pn * tstep; u.nt = sub ? nt1 : nt0; u.mode = dual ? (sub ? 2 : 1) : 0;
        return true;
    }
};
typedef f32x4 Acc[2][2][4][2];

template <class Epi>
__device__ __forceinline__ void gemm_phase(LAS unsigned char* lds, const Sched& S, const Epi& E) {
    const int tid = fresh_tid(), wid = __builtin_amdgcn_readfirstlane(tid >> 6), lane = tid & 63, wr = wid >> 2, wc = wid & 3, fr = lane & 15, fq = lane >> 4;
    const int ld = S.ld;
    unsigned voffA[2], voffB[2];
#pragma unroll
    for (int i = 0; i < 2; ++i) { int R, C; stage_rc(tid * 16 + i * 8192, R, C); const int Rb = (R & ~31) + perm32(R & 31);
        voffA[i] = (unsigned)(R * ld + C) * 2u; voffB[i] = (unsigned)(Rb * ld + C) * 2u; }
    const size_t kstep = (size_t)(BK * 2);
    const size_t hstep = (size_t)HALF * ld * 2;
    const unsigned ldsw = (unsigned)wid * 1024u;
    const int aoff = lds_byte(wr * 64 + fr, fq * 8), boff = lds_byte(wc * 32 + fr, fq * 8);
#define PG8_SA(b, h) (((b) * 2 + (h)) * HTB)
#define PG8_SB(b, h) ((4 + (b) * 2 + (h)) * HTB)
#define PG8_STAGE(bufoff, gbase, voff) do { _Pragma("unroll") for (int _i = 0; _i < 2; ++_i) \
        __builtin_amdgcn_global_load_lds((const unsigned*)((const char*)(gbase) + (voff)[_i]), (LAS unsigned*)(lds + (bufoff) + ldsw + _i * 8192), 16, 0, 0); } while (0)
#define PG8_LDA(dst, b, h) do { _Pragma("unroll") for (int m = 0; m < 4; ++m) _Pragma("unroll") for (int k = 0; k < 2; ++k) dst[m][k] = *(const LAS bf16x8*)(lds + PG8_SA(b, h) + aoff + m * 2048 + k * 1024); } while (0)
#define PG8_LDB(dst, b, h) do { _Pragma("unroll") for (int n = 0; n < 2; ++n) _Pragma("unroll") for (int k = 0; k < 2; ++k) dst[n][k] = *(const LAS bf16x8*)(lds + PG8_SB(b, h) + boff + n * 2048 + k * 1024); } while (0)
#define PG8_MMA(ai, bj, At, Bt) do { __builtin_amdgcn_s_setprio(1); _Pragma("unroll") for (int m = 0; m < 4; ++m) _Pragma("unroll") for (int n = 0; n < 2; ++n) _Pragma("unroll") for (int k = 0; k < 2; ++k) \
        acc[ai][bj][m][n] = __builtin_amdgcn_mfma_f32_16x16x32_bf16(Bt[n][k], At[m][k], acc[ai][bj][m][n], 0, 0, 0); __builtin_amdgcn_s_setprio(0); } while (0)
#define PG8_WAIT_V(n) asm volatile("s_waitcnt vmcnt(" #n ")" ::: "memory")
#define PG8_WAIT_L(n) asm volatile("s_waitcnt lgkmcnt(" #n ")" ::: "memory")
#define PG8_BAR __builtin_amdgcn_s_barrier()
#define PG8_SCHED __builtin_amdgcn_sched_barrier(0)
    Unit cur, nxt; int ui = 0;
    if (!S.next(0, cur)) return;
    Acc acc;
#pragma unroll
    for (int a = 0; a < 2; ++a)
#pragma unroll
        for (int b = 0; b < 2; ++b)
#pragma unroll
            for (int m = 0; m < 4; ++m)
#pragma unroll
                for (int n = 0; n < 2; ++n) acc[a][b][m][n] = (f32x4){0.f, 0.f, 0.f, 0.f};
    bf16x8 At[4][2], B0[2][2], B1[2][2];
    const char* cA = cur.A; const char* cB = cur.B;
    PG8_STAGE(PG8_SB(0, 0), cB, voffB); PG8_STAGE(PG8_SA(0, 0), cA, voffA); PG8_STAGE(PG8_SB(0, 1), cB + hstep, voffB); PG8_STAGE(PG8_SA(0, 1), cA + hstep, voffA);
    if (wr == 1) PG8_BAR;
    PG8_WAIT_V(4); PG8_BAR;
    PG8_STAGE(PG8_SB(1, 0), cB + kstep, voffB); PG8_STAGE(PG8_SA(1, 0), cA + kstep, voffA); PG8_STAGE(PG8_SB(1, 1), cB + hstep + kstep, voffB);
    PG8_WAIT_V(6); PG8_BAR;
    for (;;) {
        const bool has_next = S.next(ui + 1, nxt);
        const char* nA = has_next ? nxt.A : cA; const char* nB = has_next ? nxt.B : cB;
        const int nt = cur.nt;
        for (int t = 0; t < nt; t += 2) {
            const bool last = (t == nt - 2);
            const char* a1 = cA + (size_t)(t + 1) * kstep;
            const char* a2 = last ? nA : cA + (size_t)(t + 2) * kstep; const char* b2 = last ? nB : cB + (size_t)(t + 2) * kstep;
            const char* a3 = a2 + kstep; const char* b3 = b2 + kstep;
            PG8_LDB(B0, 0, 0); PG8_SCHED; PG8_LDA(At, 0, 0); PG8_STAGE(PG8_SA(1, 1), a1 + hstep, voffA);
            PG8_WAIT_L(8); PG8_BAR; PG8_WAIT_L(0); PG8_MMA(0, 0, At, B0); PG8_BAR; PG8_SCHED;
            PG8_LDB(B1, 0, 1); PG8_STAGE(PG8_SB(0, 0), b2, voffB);
            PG8_BAR; PG8_WAIT_L(0); PG8_MMA(0, 1, At, B1); PG8_BAR;
            PG8_LDA(At, 0, 1); PG8_STAGE(PG8_SA(0, 0), a2, voffA);
            PG8_BAR; PG8_WAIT_L(0); PG8_MMA(1, 0, At, B0); PG8_BAR; PG8_SCHED;
            PG8_STAGE(PG8_SB(0, 1), b2 + hstep, voffB);
            PG8_WAIT_V(6); PG8_BAR; PG8_MMA(1, 1, At, B1); PG8_BAR;
            PG8_LDB(B0, 1, 0); PG8_SCHED; PG8_LDA(At, 1, 0); PG8_STAGE(PG8_SA(0, 1), a2 + hstep, voffA);
            PG8_WAIT_L(8); PG8_BAR; PG8_WAIT_L(0); PG8_MMA(0, 0, At, B0); PG8_BAR; PG8_SCHED;
            PG8_LDB(B1, 1, 1); PG8_STAGE(PG8_SB(1, 0), b3, voffB);
            PG8_BAR; PG8_WAIT_L(0); PG8_MMA(0, 1, At, B1); PG8_BAR;
            PG8_LDA(At, 1, 1); PG8_STAGE(PG8_SA(1, 0), a3, voffA);
            PG8_BAR; PG8_WAIT_L(0); PG8_MMA(1, 0, At, B0); PG8_BAR; PG8_SCHED;
            PG8_STAGE(PG8_SB(1, 1), b3 + hstep, voffB);
            PG8_WAIT_V(6); PG8_BAR; PG8_MMA(1, 1, At, B1); PG8_BAR;
        }
        MFMA_SETTLE();
        E(acc, cur, wr, wc, fr, fq);
        if (!has_next) break;
        if (cur.mode != 1) {
#pragma unroll
            for (int a = 0; a < 2; ++a)
#pragma unroll
                for (int b = 0; b < 2; ++b)
#pragma unroll
                    for (int m = 0; m < 4; ++m)
#pragma unroll
                        for (int n = 0; n < 2; ++n) acc[a][b][m][n] = (f32x4){0.f, 0.f, 0.f, 0.f};
        }
        cur = nxt; cA = nA; cB = nB; ++ui;
    }
    PG8_WAIT_V(0);
    if (wr == 0) PG8_BAR;
    PG8_BAR;
#undef PG8_SA
#undef PG8_SB
#undef PG8_STAGE
#undef PG8_LDA
#undef PG8_LDB
#undef PG8_MMA
#undef PG8_WAIT_V
#undef PG8_WAIT_L
#undef PG8_BAR
#undef PG8_SCHED
}

#define EPI_ROWS_BEGIN \
    _Pragma("unroll") for (int ai = 0; ai < 2; ++ai) _Pragma("unroll") for (int m = 0; m < 4; ++m) { const int row = u.pm * 256 + ai * 128 + wr * 64 + m * 16 + fr; \
    _Pragma("unroll") for (int bj = 0; bj < 2; ++bj) { const int col = u.pn * 256 + bj * 128 + wc * 32 + 8 * fq; f32x4& v0 = acc[ai][bj][m][0]; f32x4& v1 = acc[ai][bj][m][1];
#define EPI_ROWS_END } __builtin_amdgcn_sched_barrier(0); }

struct EpiStoreBf16 {
    bf16_t* O; int ldc;
    __device__ __forceinline__ void operator()(Acc& acc, const Unit& u, int wr, int wc, int fr, int fq) const {
        EPI_ROWS_BEGIN
            u32x4 w; w.x = pk2(v0[0], v0[1]); w.y = pk2(v0[2], v0[3]); w.z = pk2(v1[0], v1[1]); w.w = pk2(v1[2], v1[3]);
            *(u32x4*)(O + (size_t)row * ldc + col) = w;
        EPI_ROWS_END
    }
};
struct EpiGlu {
    const bf16_t* ya; bf16_t* ya2;
    __device__ __forceinline__ void operator()(Acc& acc, const Unit& u, int wr, int wc, int fr, int fq) const {
        EPI_ROWS_BEGIN
            const u32x4 y = *(const u32x4*)(ya + (size_t)row * 512 + col);
            u32x4 w;
            w.x = pk2(bflo(y.x) * sigmoidf_(v0[0]), bfhi(y.x) * sigmoidf_(v0[1]));
            w.y = pk2(bflo(y.y) * sigmoidf_(v0[2]), bfhi(y.y) * sigmoidf_(v0[3]));
            w.z = pk2(bflo(y.z) * sigmoidf_(v1[0]), bfhi(y.z) * sigmoidf_(v1[1]));
            w.w = pk2(bflo(y.w) * sigmoidf_(v1[2]), bfhi(y.w) * sigmoidf_(v1[3]));
            *(u32x4*)(ya2 + (size_t)row * 1024 + col) = w;
        EPI_ROWS_END
    }
};
struct EpiMix {
    const bf16_t* z; bf16_t* mix;
    __device__ __forceinline__ void operator()(Acc& acc, const Unit& u, int wr, int wc, int fr, int fq) const {
        if (u.mode == 1) {
            EPI_ROWS_BEGIN
                const u32x4 ga = *(const u32x4*)(z + (size_t)row * INC + ZGA + col);
                const u32x4 gb = *(const u32x4*)(z + (size_t)row * INC + ZGB + col);
#define RATIO(a, b) ((1.0f + __expf(-(b))) * __builtin_amdgcn_rcpf(1.0f + __expf(-(a))))
                v0[0] *= RATIO(bflo(ga.x), bflo(gb.x)); v0[1] *= RATIO(bfhi(ga.x), bfhi(gb.x));
                v0[2] *= RATIO(bflo(ga.y), bflo(gb.y)); v0[3] *= RATIO(bfhi(ga.y), bfhi(gb.y));
                v1[0] *= RATIO(bflo(ga.z), bflo(gb.z)); v1[1] *= RATIO(bfhi(ga.z), bfhi(gb.z));
                v1[2] *= RATIO(bflo(ga.w), bflo(gb.w)); v1[3] *= RATIO(bfhi(ga.w), bfhi(gb.w));
#undef RATIO
            EPI_ROWS_END
        } else {
            EPI_ROWS_BEGIN
                const u32x4 gb = *(const u32x4*)(z + (size_t)row * INC + ZGB + col);
                u32x4 w;
                w.x = pk2(v0[0] * sigmoidf_(bflo(gb.x)), v0[1] * sigmoidf_(bfhi(gb.x)));
                w.y = pk2(v0[2] * sigmoidf_(bflo(gb.y)), v0[3] * sigmoidf_(bfhi(gb.y)));
                w.z = pk2(v1[0] * sigmoidf_(bflo(gb.z)), v1[1] * sigmoidf_(bfhi(gb.z)));
                w.w = pk2(v1[2] * sigmoidf_(bflo(gb.w)), v1[3] * sigmoidf_(bfhi(gb.w)));
                *(u32x4*)(mix + (size_t)row * 1024 + col) = w;
            EPI_ROWS_END
        }
    }
};
struct EpiRes {
    const float* xinP; const float* xinS; float* xout;
    __device__ __forceinline__ void operator()(Acc& acc, const Unit& u, int wr, int wc, int fr, int fq) const {
        EPI_ROWS_BEGIN
            const float* xi = (row < MP ? xinP + (size_t)row * 1024 : xinS + (size_t)(row - MP) * 1024) + col;
            const f32x4 a = *(const f32x4*)xi, b = *(const f32x4*)(xi + 4);
            float* xo = xout + (size_t)row * 1024 + col;
            *(f32x4*)xo = a + v0; *(f32x4*)(xo + 4) = b + v1;
        EPI_ROWS_END
    }
};
struct EpiUp {
    bf16_t* up; float* convP; float* convS;
    __device__ __forceinline__ void operator()(Acc& acc, const Unit& u, int wr, int wc, int fr, int fq) const {
        EPI_ROWS_BEGIN
            u32x4 w; w.x = pk2(v0[0], v0[1]); w.y = pk2(v0[2], v0[3]); w.z = pk2(v1[0], v1[1]); w.w = pk2(v1[2], v1[3]);
            *(u32x4*)(up + (size_t)row * INC + col) = w;
            float* cp = nullptr;
            if (row < MP) { const int t = row & 2047; if (t >= 2046) cp = convP + ((size_t)((row >> 11) * 2 + (t - 2046))) * INC + col; }
            else { const int r2 = row - MP, t = r2 & 7; if (t >= 6) cp = convS + ((size_t)((r2 >> 3) * 2 + (t - 6))) * INC + col; }
            if (cp) { *(f32x4*)cp = v0; *(f32x4*)(cp + 4) = v1; }
        EPI_ROWS_END
    }
};
}

__device__ __forceinline__ void transpose_item(const float* W, int K, int N, bf16_t* WT, int ldd, const float* gk, float* scr, int item, int lane) {
    const int nblk = N / 32, kb = item / nblk, nb = item % nblk, k0 = 64 * kb, n0 = 32 * nb;
#pragma unroll 8
    for (int i = 0; i < 32; ++i) { const int kk = 2 * i + (lane >> 5); float v = W[(size_t)(k0 + kk) * N + n0 + (lane & 31)]; if (gk) v *= gk[k0 + kk]; scr[kk * 33 + (lane & 31)] = v; }
    LDS_WAIT();
    const int c = lane & 7;
#pragma unroll
    for (int j = 0; j < 4; ++j) { const int n = (lane >> 3) + 8 * j; const float* s = scr + (8 * c) * 33 + n;
        u32x4 o; o.x = pk2(s[0 * 33], s[1 * 33]); o.y = pk2(s[2 * 33], s[3 * 33]); o.z = pk2(s[4 * 33], s[5 * 33]); o.w = pk2(s[6 * 33], s[7 * 33]);
        *(u32x4*)(WT + (size_t)(n0 + n) * ldd + k0 + 8 * c) = o; }
    LDS_WAIT();
}

__device__ __forceinline__ void rms_row_to_bf16(const float* xrow, bf16_t* orow, int lane) {
    const f32x4* xr = (const f32x4*)xrow + lane;
    f32x4 v[4]; float s = 0.f;
#pragma unroll
    for (int j = 0; j < 4; ++j) { v[j] = xr[64 * j]; s += (v[j].x * v[j].x + v[j].y * v[j].y) + (v[j].z * v[j].z + v[j].w * v[j].w); }
    const float rstd = rsqrtf(wave_sum(s) * (1.f / 1024.f) + EPSF);
    u32x2* o8 = (u32x2*)orow + lane;
#pragma unroll
    for (int j = 0; j < 4; ++j) { u32x2 w; w.x = pk2(v[j].x * rstd, v[j].y * rstd); w.y = pk2(v[j].z * rstd, v[j].w * rstd); o8[64 * j] = w; }
}

__device__ __forceinline__ void phase_rmsnorm(const KPG& p, int l, int wave, int lane) {
    const float* xb = (const float*)(p.ws + WS_X); bf16_t* h = (bf16_t*)(p.ws + WS_H);
    for (int row = fresh_bid() * 8 + wave; row < MT; row += gridDim.x * 8) {
        const float* xr = (l == 0) ? (row < MP ? p.in[0] + (size_t)row * 1024 : p.in[1] + (size_t)(row - MP) * 1024) : xb + (size_t)row * 1024;
        rms_row_to_bf16(xr, h + (size_t)row * 1024, lane);
    }
}

__device__ __forceinline__ void phase_prologue(const KPG& p, int l, unsigned char* lds, int wave, int lane) {
    float* scr = (float*)(lds + wave * 8448);
    const int gw = fresh_bid() * 8 + wave, NGW = gridDim.x * 8;
    constexpr int I_IN = 16 * 176, I_UP = 16 * 176, I_DN = 44 * 32, I_O = 16 * 32, I_RET = 16 * 32, I_SSM = 8 * 32, I_GLU = 8 * 16;
    constexpr int I_L = I_IN + I_UP + I_DN + I_O + I_RET + I_SSM + I_GLU;
    for (int it = gw; it < I_L; it += NGW) {
        int r = it;
        unsigned char* wl = p.ws + WS_WT + (size_t)l * LW_SIZE;
        if (r < I_IN) { transpose_item(p.in[7] + (size_t)l * 1024 * INC, 1024, INC, (bf16_t*)(wl + LW_IN), 1024, p.in[6] + l * 1024, scr, r, lane); continue; } r -= I_IN;
        if (r < I_UP) { transpose_item(p.in[21] + (size_t)l * 1024 * INC, 1024, INC, (bf16_t*)(wl + LW_UP), 1024, p.in[20] + l * 1024, scr, r, lane); continue; } r -= I_UP;
        if (r < I_DN) { transpose_item(p.in[24] + (size_t)l * DFF * 1024, DFF, 1024, (bf16_t*)(wl + LW_DOWN), DFF, nullptr, scr, r, lane); continue; } r -= I_DN;
        if (r < I_O) { transpose_item(p.in[19] + (size_t)l * 1024 * 1024, 1024, 1024, (bf16_t*)(wl + LW_O), 1024, nullptr, scr, r, lane); continue; } r -= I_O;
        if (r < I_RET) { transpose_item(p.in[18] + (size_t)l * 1024 * 1024, 1024, 1024, (bf16_t*)(wl + LW_RET), 1024, nullptr, scr, r, lane); continue; } r -= I_RET;
        if (r < I_SSM) { transpose_item(p.in[17] + (size_t)l * 512 * 1024, 512, 1024, (bf16_t*)(wl + LW_SSM), 1024, nullptr, scr, r, lane); continue; } r -= I_SSM;
        transpose_item(p.in[16] + (size_t)l * 512 * 512, 512, 512, (bf16_t*)(wl + LW_GLU), 512, nullptr, scr, r, lane);
    }
    const int gt = fresh_bid() * 512 + fresh_tid(), NGT = gridDim.x * 512;
    for (int it = gt; it < 32 * 64; it += NGT) {
        const int pp = it & 63, g = (it >> 6) & 31;
        const int gi = l * 32 + g, pi = gi * 64 + pp;
        const float dt = __expf(p.in[10][gi]), lr = p.in[8][pi], li = p.in[9][pi];
        float s1, c1; sincos_rev(li * dt * 0.15915494309189535f, s1, c1);
        const float m1 = __expf(lr * dt); const float lbr = m1 * c1, lbi = m1 * s1;
        const float nr = lbr - 1.0f, ni = lbi, den = 1.0f / (lr * lr + li * li);
        const float cr = (nr * lr + ni * li) * den, ci = (ni * lr - nr * li) * den;
        unsigned char* st = p.ws + WS_S5T + (size_t)l * S5_SIZE;
        const float* bre = p.in[11] + (size_t)pi * 16; const float* bim = p.in[12] + (size_t)pi * 16;
        bf16_t* bmre = (bf16_t*)(st + S5_BMT) + (size_t)(g * 128 + pp) * 16; bf16_t* bmim = (bf16_t*)(st + S5_BMT) + (size_t)(g * 128 + 64 + pp) * 16;
#pragma unroll
        for (int c = 0; c < 16; ++c) { const float br = bre[c], bi = bim[c]; bmre[c] = f2bf(cr * br - ci * bi); bmim[c] = f2bf(cr * bi + ci * br); }
        float2* lam = (float2*)(st + S5_LAM) + g * 64 + pp; *lam = make_float2(lbr, lbi);
        float s32, c32; sincos_rev(32.0f * li * dt * 0.15915494309189535f, s32, c32); const float m32 = __expf(32.0f * lr * dt);
        float2* lam32 = (float2*)(st + S5_LAM32) + g * 64 + pp; *lam32 = make_float2(m32 * c32, m32 * s32);
    }
    for (int it = gt; it < 32 * 16 * 128; it += NGT) {
        const int pq = it & 127, c = (it >> 7) & 15, g = (it >> 11) & 31;
        const size_t src = ((size_t)((l * 32 + g) * 16 + c)) * 64 + (pq & 63);
        const float v = pq < 64 ? p.in[13][src] : -p.in[14][src];
        ((bf16_t*)(p.ws + WS_S5T + (size_t)l * S5_SIZE + S5_CMT))[(g * 16 + c) * 128 + pq] = f2bf(v);
    }
    for (int it = gt; it < 2056 * 64; it += NGT) {
        const int j = it & 63, pi = it >> 6; const double pos = (double)(pi < 2048 ? pi : 16384 + pi - 2048);
        double inv = 1.0, r = 0.86596432336006535;
        int e = j;
#pragma unroll
        for (int b = 0; b < 6; ++b) { if (e & 1) inv *= r; r *= r; e >>= 1; }
        const double rev = pos * inv * 0.15915494309189535; const double fr_ = rev - __builtin_rint(rev);
        const float f = (float)fr_;
        ((float2*)(p.ws + WS_ROPE))[it] = make_float2(__builtin_amdgcn_cosf(f), __builtin_amdgcn_sinf(f));
    }
}

template <bool SAMPLE>
__device__ __forceinline__ void s5_tile(const KPG& p, int l, int g, int row0, int bseq, int chunk, bf16_t* Sl, int lane) {
    const bf16_t* z = (const bf16_t*)(p.ws + WS_Z); bf16_t* ya = (bf16_t*)(p.ws + WS_YA);
    const unsigned char* st = p.ws + WS_S5T + (size_t)l * S5_SIZE;
    const int half = lane >> 5, li = lane & 31;
    const bf16x8 uf = *(const bf16x8*)(z + (size_t)(row0 + li) * INC + g * 16 + 8 * half);
    const int fr = lane & 15, fq = lane >> 4;
    float2 lm[2]; lm[0] = ((const float2*)(st + S5_LAM))[g * 64 + li]; lm[1] = ((const float2*)(st + S5_LAM))[g * 64 + 32 + li];
    const float* sin_ = (const float*)(p.ws + WS_SIN);
    float c0r[4][2], c0i[4][2];
#pragma unroll
    for (int k = 0; k < 4; ++k)
#pragma unroll
        for (int pt = 0; pt < 2; ++pt) {
            c0r[k][pt] = 0.f; c0i[k][pt] = 0.f;
            if (SAMPLE) { const size_t o = ((size_t)((l * 128 + bseq + k) * 32 + g)) * 64 + pt * 32 + li; c0r[k][pt] = p.in[2][o]; c0i[k][pt] = p.in[3][o]; }
        }
    float2 l32v[2]; float e_r[2][7], e_i[2][7], loc_r[2], loc_i[2];
    if (!SAMPLE) {
        const int sc = chunk >> 3;
#pragma unroll
        for (int pt = 0; pt < 2; ++pt) {
            l32v[pt] = ((const float2*)(st + S5_LAM32))[g * 64 + pt * 32 + li];
            const float* Eb = (const float*)(p.ws + WS_E) + ((size_t)((bseq * 32 + g) * 8)) * 128 + pt * 32 + li;
#pragma unroll
            for (int i = 0; i < 7; ++i) { e_r[pt][i] = 0.f; e_i[pt][i] = 0.f; if (i < sc) { e_r[pt][i] = Eb[i * 128]; e_i[pt][i] = Eb[i * 128 + 64]; } }
            const size_t o = ((size_t)((bseq * 32 + g) * 64 + chunk)) * 128 + pt * 32 + li;
            loc_r[pt] = sin_[o]; loc_i[pt] = sin_[o + 64];
        }
    }
    bf16x8 cf[4];
#pragma unroll
    for (int ks = 0; ks < 4; ++ks) cf[ks] = *(const bf16x8*)((const bf16_t*)(st + S5_CMT) + (size_t)(g * 16 + fr) * 128 + ks * 32 + 8 * fq);
    const float dv = p.in[15][l * 512 + g * 16 + fr];
    bf16_t uraw[2][4];
#pragma unroll
    for (int rt = 0; rt < 2; ++rt)
#pragma unroll
        for (int r = 0; r < 4; ++r) uraw[rt][r] = z[(size_t)(row0 + rt * 16 + 4 * fq + r) * INC + g * 16 + fr];
    f32x16 acc[4];
#pragma unroll
    for (int ct = 0; ct < 4; ++ct) {
        const bf16x8 bfr = *(const bf16x8*)((const bf16_t*)(st + S5_BMT) + (size_t)(g * 128 + ct * 32 + li) * 16 + 8 * half);
        f32x16 zz;
#pragma unroll
        for (int e = 0; e < 16; ++e) zz[e] = 0.f;
        acc[ct] = MFMA32(uf, bfr, zz);
    }
    MFMA_SETTLE();
    float sr[2] = {0.f, 0.f}, si[2] = {0.f, 0.f};
#pragma unroll
    for (int k = 0; k < 4; ++k) {
        if (SAMPLE) {
#pragma unroll
            for (int pt = 0; pt < 2; ++pt) { sr[pt] = c0r[k][pt]; si[pt] = c0i[k][pt]; }
        } else if (k == 0) {
            const int sc = chunk >> 3, jj = chunk & 7;
#pragma unroll
            for (int pt = 0; pt < 2; ++pt) {
                const float2 l32 = l32v[pt];
                const float2 l64 = make_float2(l32.x * l32.x - l32.y * l32.y, 2.0f * l32.x * l32.y);
                const float2 l128 = make_float2(l64.x * l64.x - l64.y * l64.y, 2.0f * l64.x * l64.y);
                const float2 l256 = make_float2(l128.x * l128.x - l128.y * l128.y, 2.0f * l128.x * l128.y);
                float Sr = 0.f, Si = 0.f;
#pragma unroll
                for (int i = 0; i < 7; ++i) { if (i < sc) { const float tr = l256.x * Sr - l256.y * Si + e_r[pt][i], ti = l256.x * Si + l256.y * Sr + e_i[pt][i]; Sr = tr; Si = ti; } }
                float rr = 1.0f, ri = 0.0f;
                if (jj & 1) { const float tr = rr * l32.x - ri * l32.y, ti = rr * l32.y + ri * l32.x; rr = tr; ri = ti; }
                if (jj & 2) { const float tr = rr * l64.x - ri * l64.y, ti = rr * l64.y + ri * l64.x; rr = tr; ri = ti; }
                if (jj & 4) { const float tr = rr * l128.x - ri * l128.y, ti = rr * l128.y + ri * l128.x; rr = tr; ri = ti; }
                sr[pt] = loc_r[pt] + (rr * Sr - ri * Si); si[pt] = loc_i[pt] + (rr * Si + ri * Sr);
            }
        }
#pragma unroll
        for (int hh = 0; hh < 2; ++hh) {
            const bool mine = (half == hh);
            float tr_[2] = {sr[0], sr[1]}, ti_[2] = {si[0], si[1]};
#pragma unroll
            for (int q = 0; q < 4; ++q)
#pragma unroll
                for (int pt = 0; pt < 2; ++pt) {
                    const float tr = lm[pt].x * tr_[pt] - lm[pt].y * ti_[pt] + acc[pt][4 * k + q];
                    const float ti = lm[pt].x * ti_[pt] + lm[pt].y * tr_[pt] + acc[2 + pt][4 * k + q];
                    tr_[pt] = tr; ti_[pt] = ti;
                    acc[pt][4 * k + q] = mine ? tr : acc[pt][4 * k + q]; acc[2 + pt][4 * k + q] = mine ? ti : acc[2 + pt][4 * k + q];
                }
#pragma unroll
            for (int pt = 0; pt < 2; ++pt) { sr[pt] = mine ? tr_[pt] : sr[pt]; si[pt] = mine ? ti_[pt] : si[pt]; }
            if (SAMPLE && hh == 1) {
                if (mine) {
#pragma unroll
                    for (int pt = 0; pt < 2; ++pt) { const size_t o = ((size_t)((l * 128 + bseq + k) * 32 + g)) * 64 + pt * 32 + li;
                        p.out[O_SRS + o] = sr[pt]; p.out[O_SIS + o] = si[pt]; }
                }
            }
#pragma unroll
            for (int pt = 0; pt < 2; ++pt) { const float orr = xor32(sr[pt], half), oii = xor32(si[pt], half); sr[pt] = mine ? sr[pt] : orr; si[pt] = mine ? si[pt] : oii; }
        }
    }
    if (!SAMPLE && chunk == 63 && half == 0) {
#pragma unroll
        for (int pt = 0; pt < 2; ++pt) { const size_t o = ((size_t)((l * 8 + bseq) * 32 + g)) * 64 + pt * 32 + li; p.out[O_SRP + o] = sr[pt]; p.out[O_SIP + o] = si[pt]; }
    }
#pragma unroll
    for (int ct = 0; ct < 4; ++ct)
#pragma unroll
        for (int r = 0; r < 16; ++r) { const int t = (r & 3) + 8 * (r >> 2) + 4 * half; Sl[t * 136 + ct * 32 + li] = f2bf(acc[ct][r]); }
    LDS_WAIT();
#pragma unroll
    for (int rt = 0; rt < 2; ++rt) {
        f32x4 y = {0.f, 0.f, 0.f, 0.f};
#pragma unroll
        for (int ks = 0; ks < 4; ++ks) { const bf16x8 a = *(const bf16x8*)(Sl + (rt * 16 + fr) * 136 + ks * 32 + 8 * fq); y = MFMA16(a, cf[ks], y); }
        MFMA_SETTLE();
#pragma unroll
        for (int r = 0; r < 4; ++r) { const int tok = row0 + rt * 16 + 4 * fq + r; const float uu = bf2f(uraw[rt][r]);
            ya[(size_t)tok * 512 + g * 16 + fr] = f2bf(gelu_tanh(y[r] + dv * uu)); }
    }
    LDS_WAIT();
}

__device__ __forceinline__ void s5_m1(const KPG& p, int l, int b, int g, int sc, int lane) {
    const bf16_t* z = (const bf16_t*)(p.ws + WS_Z);
    const unsigned char* st = p.ws + WS_S5T + (size_t)l * S5_SIZE;
    const int half = lane >> 5, li = lane & 31;
    bf16x8 bfr[4];
#pragma unroll
    for (int ct = 0; ct < 4; ++ct) bfr[ct] = *(const bf16x8*)((const bf16_t*)(st + S5_BMT) + (size_t)(g * 128 + ct * 32 + li) * 16 + 8 * half);
    float2 lm[2]; lm[0] = ((const float2*)(st + S5_LAM))[g * 64 + li]; lm[1] = ((const float2*)(st + S5_LAM))[g * 64 + 32 + li];
    float sr[2] = {0.f, 0.f}, si[2] = {0.f, 0.f};
    float* sin_ = (float*)(p.ws + WS_SIN);
    for (int j = 0; j < 8; ++j) {
        const int chunk = sc * 8 + j, row0 = b * 2048 + chunk * 32;
        const bf16x8 uf = *(const bf16x8*)(z + (size_t)(row0 + li) * INC + g * 16 + 8 * half);
        if (half == 0) {
#pragma unroll
            for (int pt = 0; pt < 2; ++pt) { const size_t o = ((size_t)((b * 32 + g) * 64 + chunk)) * 128 + pt * 32 + li; sin_[o] = sr[pt]; sin_[o + 64] = si[pt]; }
        }
        f32x16 acc[4];
#pragma unroll
        for (int ct = 0; ct < 4; ++ct) {
            f32x16 zz;
#pragma unroll
            for (int e = 0; e < 16; ++e) zz[e] = 0.f;
            acc[ct] = MFMA32(uf, bfr[ct], zz);
        }
        MFMA_SETTLE();
#pragma unroll
        for (int k = 0; k < 4; ++k)
#pragma unroll
            for (int hh = 0; hh < 2; ++hh) {
                const bool mine = (half == hh);
                float tr_[2] = {sr[0], sr[1]}, ti_[2] = {si[0], si[1]};
#pragma unroll
                for (int q = 0; q < 4; ++q)
#pragma unroll
                    for (int pt = 0; pt < 2; ++pt) {
                        const float tr = lm[pt].x * tr_[pt] - lm[pt].y * ti_[pt] + acc[pt][4 * k + q];
                        const float ti = lm[pt].x * ti_[pt] + lm[pt].y * tr_[pt] + acc[2 + pt][4 * k + q];
                        tr_[pt] = tr; ti_[pt] = ti;
                    }
#pragma unroll
                for (int pt = 0; pt < 2; ++pt) { sr[pt] = mine ? tr_[pt] : sr[pt]; si[pt] = mine ? ti_[pt] : si[pt]; }
#pragma unroll
                for (int pt = 0; pt < 2; ++pt) { const float orr = xor32(sr[pt], half), oii = xor32(si[pt], half); sr[pt] = mine ? sr[pt] : orr; si[pt] = mine ? si[pt] : oii; }
            }
    }
    if (half == 0) {
        float* E = (float*)(p.ws + WS_E) + ((size_t)((b * 32 + g) * 8 + sc)) * 128;
#pragma unroll
        for (int pt = 0; pt < 2; ++pt) { E[pt * 32 + li] = sr[pt]; E[64 + pt * 32 + li] = si[pt]; }
    }
}

__device__ __forceinline__ float log2_gamma(int h) { return __log2f(1.0f - exp2f(-5.0f - (float)h)); }

__device__ __forceinline__ void rot8(const u32x4& lo, const u32x4& hi, const float2* rp, float scale, float* olo, float* ohi) {
    const unsigned lw[4] = {lo.x, lo.y, lo.z, lo.w}, hw[4] = {hi.x, hi.y, hi.z, hi.w};
#pragma unroll
    for (int e = 0; e < 8; ++e) {
        const float x1 = (e & 1) ? bfhi(lw[e >> 1]) : bflo(lw[e >> 1]);
        const float x2 = (e & 1) ? bfhi(hw[e >> 1]) : bflo(hw[e >> 1]);
        const float2 cs = rp[e];
        olo[e] = (x1 * cs.x - x2 * cs.y) * scale; ohi[e] = (x1 * cs.y + x2 * cs.x) * scale;
    }
}

__device__ __forceinline__ void ret_m1_unit(const KPG& p, int l, int unit, unsigned char* lds, int wave, int lane) {
    const int tid = fresh_tid(), b = unit >> 4, h = (unit >> 2) & 3, s = unit & 3;
    const bf16_t* z = (const bf16_t*)(p.ws + WS_Z); const float2* rope = (const float2*)(p.ws + WS_ROPE);
    bf16_t* RTb = (bf16_t*)(p.ws + WS_RT);
    bf16_t* KT = (bf16_t*)lds; bf16_t* VT = KT + 128 * 136;
    const float lg2 = log2_gamma(h), cdec = exp2f(128.0f * lg2);
    const int fr = lane & 15, fq = lane >> 4;
    f32x4 R[4];
#pragma unroll
    for (int nt = 0; nt < 4; ++nt) R[nt] = (f32x4){0.f, 0.f, 0.f, 0.f};
    u32x4 kl[2], kh[2], vv[2]; f32x4 rq[2][4];
#define RM1_PREFETCH(ii) _Pragma("unroll") for (int tk = 0; tk < 2; ++tk) { const int task_ = tid + 512 * tk, j_ = task_ & 127, dg_ = task_ >> 7; const size_t zrow_ = (size_t)(b * 2048 + (ii) * 128 + j_) * INC; \
        const bf16_t* zr_ = z + zrow_ + ZK + h * 128 + dg_ * 8; kl[tk] = *(const u32x4*)zr_; kh[tk] = *(const u32x4*)(zr_ + 64); \
        const f32x4* rs_ = (const f32x4*)(rope + (size_t)((ii) * 128 + j_) * 64 + dg_ * 8); rq[tk][0] = rs_[0]; rq[tk][1] = rs_[1]; rq[tk][2] = rs_[2]; rq[tk][3] = rs_[3]; \
        vv[tk] = *(const u32x4*)(z + zrow_ + ZV + h * 256 + s * 64 + dg_ * 8); }
    RM1_PREFETCH(0)
    for (int i = 0; i < 16; ++i) {
        bf16_t* rt = RTb + ((size_t)((b * 4 + h) * 16 + i)) * 256 * 128;
#pragma unroll
        for (int nt = 0; nt < 4; ++nt) { u32x2 w; w.x = pk2(R[nt][0], R[nt][1]); w.y = pk2(R[nt][2], R[nt][3]);
            *(u32x2*)(rt + (size_t)(64 * s + 16 * nt + fr) * 128 + 16 * wave + 4 * fq) = w; }
#pragma unroll
        for (int tk = 0; tk < 2; ++tk) {
            const int task = tid + 512 * tk, j = task & 127, dg = task >> 7;
            const float sc_ = 0.08838834764831845f * exp2f((float)(127 - j) * lg2);
            const unsigned lw[4] = {kl[tk].x, kl[tk].y, kl[tk].z, kl[tk].w}, hw[4] = {kh[tk].x, kh[tk].y, kh[tk].z, kh[tk].w}, vw[4] = {vv[tk].x, vv[tk].y, vv[tk].z, vv[tk].w};
#pragma unroll
            for (int e = 0; e < 8; ++e) {
                const float x1 = (e & 1) ? bfhi(lw[e >> 1]) : bflo(lw[e >> 1]), x2 = (e & 1) ? bfhi(hw[e >> 1]) : bflo(hw[e >> 1]);
                const float cs_ = rq[tk][e >> 1][(e & 1) * 2], sn_ = rq[tk][e >> 1][(e & 1) * 2 + 1];
                KT[(dg * 8 + e) * 136 + j] = f2bf((x1 * cs_ - x2 * sn_) * sc_); KT[(64 + dg * 8 + e) * 136 + j] = f2bf((x1 * sn_ + x2 * cs_) * sc_);
                VT[(dg * 8 + e) * 136 + j] = (bf16_t)((e & 1) ? (vw[e >> 1] >> 16) : (vw[e >> 1] & 0xffffu));
            }
        }
        if (i + 1 < 16) { RM1_PREFETCH(i + 1) }
        __syncthreads();
#pragma unroll
        for (int nt = 0; nt < 4; ++nt) R[nt] = R[nt] * cdec;
#pragma unroll
        for (int ks = 0; ks < 4; ++ks) {
            const bf16x8 a = *(const bf16x8*)(KT + (16 * wave + fr) * 136 + ks * 32 + 8 * fq);
#pragma unroll
            for (int nt = 0; nt < 4; ++nt) { const bf16x8 bb = *(const bf16x8*)(VT + (16 * nt + fr) * 136 + ks * 32 + 8 * fq); R[nt] = MFMA16(a, bb, R[nt]); }
        }
        MFMA_SETTLE();
        __syncthreads();
    }
#undef RM1_PREFETCH
    float* ro = p.out + O_RP + ((size_t)((l * 8 + b) * 4 + h)) * 128 * 256;
#pragma unroll
    for (int nt = 0; nt < 4; ++nt)
#pragma unroll
        for (int r = 0; r < 4; ++r) ro[(size_t)(16 * wave + 4 * fq + r) * 256 + 64 * s + 16 * nt + fr] = R[nt][r];
}

__device__ __forceinline__ void ret_m2_unit(const KPG& p, int l, int unit, unsigned char* lds, int wave, int lane) {
    const int tid = fresh_tid(), b = unit >> 6, h = (unit >> 4) & 3, i = unit & 15;
    const bf16_t* z = (const bf16_t*)(p.ws + WS_Z); const float2* rope = (const float2*)(p.ws + WS_ROPE);
    const bf16_t* RTb = (const bf16_t*)(p.ws + WS_RT); bf16_t* ob = (bf16_t*)(p.ws + WS_O);
    bf16_t* Qs = (bf16_t*)lds; bf16_t* Ks = Qs + 128 * 136; bf16_t* BIG = Ks + 128 * 136;
    const float lg2 = log2_gamma(h);
    const int fr = lane & 15, fq = lane >> 4, row0 = b * 2048 + i * 128;
#pragma unroll
    for (int tk = 0; tk < 2; ++tk) {
        const int task = tid + 512 * tk, dg = task & 7, j = task >> 3;
        const bf16_t* zr = z + (size_t)(row0 + j) * INC + h * 128 + dg * 8;
        const float2* rp = rope + (size_t)(i * 128 + j) * 64 + dg * 8;
        float olo[8], ohi[8];
        { const u32x4 lo = *(const u32x4*)(zr + ZQ), hi = *(const u32x4*)(zr + ZQ + 64); rot8(lo, hi, rp, 1.0f, olo, ohi);
          u32x4 w; w.x = pk2(olo[0], olo[1]); w.y = pk2(olo[2], olo[3]); w.z = pk2(olo[4], olo[5]); w.w = pk2(olo[6], olo[7]); *(u32x4*)(Qs + j * 136 + dg * 8) = w;
          w.x = pk2(ohi[0], ohi[1]); w.y = pk2(ohi[2], ohi[3]); w.z = pk2(ohi[4], ohi[5]); w.w = pk2(ohi[6], ohi[7]); *(u32x4*)(Qs + j * 136 + 64 + dg * 8) = w; }
        { const u32x4 lo = *(const u32x4*)(zr + ZK), hi = *(const u32x4*)(zr + ZK + 64); rot8(lo, hi, rp, 0.08838834764831845f, olo, ohi);
          u32x4 w; w.x = pk2(olo[0], olo[1]); w.y = pk2(olo[2], olo[3]); w.z = pk2(olo[4], olo[5]); w.w = pk2(olo[6], olo[7]); *(u32x4*)(Ks + j * 136 + dg * 8) = w;
          w.x = pk2(ohi[0], ohi[1]); w.y = pk2(ohi[2], ohi[3]); w.z = pk2(ohi[4], ohi[5]); w.w = pk2(ohi[6], ohi[7]); *(u32x4*)(Ks + j * 136 + 64 + dg * 8) = w; }
    }
    {
        const bf16_t* src = RTb + ((size_t)((b * 4 + h) * 16 + i)) * 256 * 128;
#pragma unroll
        for (int k = 0; k < 8; ++k) { const int idx = tid + 512 * k, dv = idx >> 4, c16 = idx & 15; *(u32x4*)(BIG + dv * 136 + c16 * 8) = *(const u32x4*)(src + (size_t)dv * 128 + c16 * 8); }
    }
    __syncthreads();
    bf16x8 Aq[4];
#pragma unroll
    for (int ks = 0; ks < 4; ++ks) Aq[ks] = *(const bf16x8*)(Qs + (16 * wave + fr) * 136 + ks * 32 + 8 * fq);
    f32x4 S[8];
#pragma unroll
    for (int jt = 0; jt < 8; ++jt) {
        S[jt] = (f32x4){0.f, 0.f, 0.f, 0.f};
        if (jt <= wave) {
#pragma unroll
            for (int ks = 0; ks < 4; ++ks) { const bf16x8 bb = *(const bf16x8*)(Ks + (16 * jt + fr) * 136 + ks * 32 + 8 * fq); S[jt] = MFMA16(Aq[ks], bb, S[jt]); }
        }
        __builtin_amdgcn_sched_barrier(0);
    }
    f32x4 O[16];
#pragma unroll
    for (int nt = 0; nt < 16; ++nt) {
        O[nt] = (f32x4){0.f, 0.f, 0.f, 0.f};
#pragma unroll
        for (int ks = 0; ks < 4; ++ks) { const bf16x8 bb = *(const bf16x8*)(BIG + (16 * nt + fr) * 136 + ks * 32 + 8 * fq); O[nt] = MFMA16(Aq[ks], bb, O[nt]); }
        if ((nt & 1) == 1) __builtin_amdgcn_sched_barrier(0);
    }
    MFMA_SETTLE();
    {
        float inn[4];
#pragma unroll
        for (int r = 0; r < 4; ++r) inn[r] = exp2f((float)(16 * wave + 4 * fq + r + 1) * lg2);
#pragma unroll
        for (int nt = 0; nt < 16; ++nt)
#pragma unroll
            for (int r = 0; r < 4; ++r) O[nt][r] *= inn[r];
    }
    __syncthreads();
#pragma unroll
    for (int jt = 0; jt < 8; ++jt)
#pragma unroll
        for (int r = 0; r < 4; ++r) {
            const int ii = 16 * wave + 4 * fq + r, jj = 16 * jt + fr;
            const float v = (jt <= wave && ii >= jj) ? S[jt][r] * exp2f((float)(ii - jj) * lg2) : 0.0f;
            Ks[ii * 136 + jj] = f2bf(v);
        }
#pragma unroll
    for (int k = 0; k < 8; ++k) {
        const int task = tid + 512 * k, j = task & 127, vg = task >> 7;
        const u32x4 v = *(const u32x4*)(z + (size_t)(row0 + j) * INC + ZV + h * 256 + vg * 8);
        const unsigned vw[4] = {v.x, v.y, v.z, v.w};
#pragma unroll
        for (int e = 0; e < 8; ++e) BIG[(vg * 8 + e) * 136 + j] = (bf16_t)((e & 1) ? (vw[e >> 1] >> 16) : (vw[e >> 1] & 0xffffu));
    }
    __syncthreads();
#pragma unroll
    for (int ks = 0; ks < 4; ++ks) {
        if (ks <= (wave >> 1)) {
            const bf16x8 a = *(const bf16x8*)(Ks + (16 * wave + fr) * 136 + ks * 32 + 8 * fq);
#pragma unroll
            for (int nt = 0; nt < 16; ++nt) { const bf16x8 bb = *(const bf16x8*)(BIG + (16 * nt + fr) * 136 + ks * 32 + 8 * fq); O[nt] = MFMA16(a, bb, O[nt]); if ((nt & 1) == 1) __builtin_amdgcn_sched_barrier(0); }
        }
    }
    MFMA_SETTLE();
#pragma unroll
    for (int r = 0; r < 4; ++r) {
        float ss = 0.f;
#pragma unroll
        for (int nt = 0; nt < 16; ++nt) ss += O[nt][r] * O[nt][r];
        ss = row_sum16(ss);
        const float rstd = rsqrtf(ss * (1.0f / 256.0f) + EPSF);
        const size_t tok = (size_t)(row0 + 16 * wave + 4 * fq + r);
#pragma unroll
        for (int nt = 0; nt < 16; ++nt) { const int col = h * 256 + 16 * nt + fr; const float gg = bf2f(z[tok * INC + ZGR + col]);
            ob[tok * 1024 + col] = f2bf(O[nt][r] * rstd * siluf_(gg)); }
    }
    __syncthreads();
}

__device__ __forceinline__ void ret_sample_unit(const KPG& p, int l, int unit, unsigned char* lds, int wave, int lane) {
    const int tid = fresh_tid(), b = unit >> 2, h = unit & 3;
    const bf16_t* z = (const bf16_t*)(p.ws + WS_Z); const float2* rope = (const float2*)(p.ws + WS_ROPE); bf16_t* ob = (bf16_t*)(p.ws + WS_O);
    float* qT = (float*)lds; float* kT = qT + 1024; float* ktT = kT + 1024; float* vs = ktT + 1024; float* sc = vs + 2048; float* opart = sc + 64;
    const float lg2 = log2_gamma(h);
    const int row0 = MP + b * 8;
    if (tid < 64) {
        const int i = tid >> 3, dg = tid & 7;
        const bf16_t* zr = z + (size_t)(row0 + i) * INC + h * 128 + dg * 8;
        const float2* rp = rope + (size_t)(2048 + i) * 64 + dg * 8;
        float olo[8], ohi[8];
        { const u32x4 lo = *(const u32x4*)(zr + ZQ), hi = *(const u32x4*)(zr + ZQ + 64); rot8(lo, hi, rp, 1.0f, olo, ohi);
#pragma unroll
          for (int e = 0; e < 8; ++e) { qT[(dg * 8 + e) * 8 + i] = olo[e]; qT[(64 + dg * 8 + e) * 8 + i] = ohi[e]; } }
        { const u32x4 lo = *(const u32x4*)(zr + ZK), hi = *(const u32x4*)(zr + ZK + 64); rot8(lo, hi, rp, 0.08838834764831845f, olo, ohi);
          const float tl = exp2f((float)(7 - i) * lg2);
#pragma unroll
          for (int e = 0; e < 8; ++e) { kT[(dg * 8 + e) * 8 + i] = olo[e]; kT[(64 + dg * 8 + e) * 8 + i] = ohi[e]; ktT[(dg * 8 + e) * 8 + i] = olo[e] * tl; ktT[(64 + dg * 8 + e) * 8 + i] = ohi[e] * tl; } }
    }
    if (tid < 256) {
#pragma unroll
        for (int i = 0; i < 8; ++i) vs[i * 256 + tid] = bf2f(z[(size_t)(row0 + i) * INC + ZV + h * 256 + tid]);
    }
    __syncthreads();
    if (tid < 64) {
        const int i = tid >> 3, j = tid & 7; float d = 0.f;
        for (int dd = 0; dd < 128; ++dd) d += qT[dd * 8 + i] * kT[dd * 8 + j];
        sc[tid] = (j <= i) ? d * exp2f((float)(i - j) * lg2) : 0.f;
    }
    {
        const int dv4 = (tid & 63) * 4;
        f32x4 vv[8], ao[8];
#pragma unroll
        for (int j = 0; j < 8; ++j) { vv[j] = *(const f32x4*)(vs + j * 256 + dv4); ao[j] = (f32x4){0.f, 0.f, 0.f, 0.f}; }
        const size_t so = ((size_t)((l * 128 + b) * 4 + h)) * 128 * 256;
        const float* r0 = p.in[4] + so; float* rn = p.out + O_RS + so;
        const float cdec = exp2f(8.0f * lg2);
#pragma unroll 8
        for (int dd = 0; dd < 16; ++dd) {
            const int d = wave * 16 + dd;
            const f32x4 r = *(const f32x4*)(r0 + (size_t)d * 256 + dv4);
            const f32x4 qa = *(const f32x4*)(qT + d * 8), qb = *(const f32x4*)(qT + d * 8 + 4), ka = *(const f32x4*)(ktT + d * 8), kb = *(const f32x4*)(ktT + d * 8 + 4);
            ao[0] += qa[0] * r; ao[1] += qa[1] * r; ao[2] += qa[2] * r; ao[3] += qa[3] * r; ao[4] += qb[0] * r; ao[5] += qb[1] * r; ao[6] += qb[2] * r; ao[7] += qb[3] * r;
            f32x4 nr = r * cdec;
            nr += ka[0] * vv[0]; nr += ka[1] * vv[1]; nr += ka[2] * vv[2]; nr += ka[3] * vv[3]; nr += kb[0] * vv[4]; nr += kb[1] * vv[5]; nr += kb[2] * vv[6]; nr += kb[3] * vv[7];
            *(f32x4*)(rn + (size_t)d * 256 + dv4) = nr;
        }
#pragma unroll
        for (int i = 0; i < 8; ++i) *(f32x4*)(opart + (wave * 8 + i) * 256 + dv4) = ao[i];
    }
    __syncthreads();
    {
        const int i = wave, dv4 = (tid & 63) * 4;
        f32x4 a = (f32x4){0.f, 0.f, 0.f, 0.f};
#pragma unroll
        for (int w = 0; w < 8; ++w) a += *(const f32x4*)(opart + (w * 8 + i) * 256 + dv4);
        a = a * exp2f((float)(i + 1) * lg2);
#pragma unroll
        for (int j = 0; j < 8; ++j) { if (j <= i) a += sc[i * 8 + j] * *(const f32x4*)(vs + j * 256 + dv4); }
        const float ss = wave_sum(a[0] * a[0] + a[1] * a[1] + a[2] * a[2] + a[3] * a[3]);
        const float rstd = rsqrtf(ss * (1.0f / 256.0f) + EPSF);
        const size_t tok = (size_t)(row0 + i);
        const u32x2 gw = *(const u32x2*)(z + tok * INC + ZGR + h * 256 + dv4);
        u32x2 w; w.x = pk2(a[0] * rstd * siluf_(bflo(gw.x)), a[1] * rstd * siluf_(bfhi(gw.x))); w.y = pk2(a[2] * rstd * siluf_(bflo(gw.y)), a[3] * rstd * siluf_(bfhi(gw.y)));
        *(u32x2*)(ob + tok * 1024 + h * 256 + dv4) = w;
    }
    __syncthreads();
}

__device__ __forceinline__ void phase_convact(const KPG& p, int l) {
    const bf16_t* up = (const bf16_t*)(p.ws + WS_Z); bf16_t* act = (bf16_t*)(p.ws + WS_ACT);
    const float* cw = p.in[22] + (size_t)l * 3 * INC; const float* cb = p.in[23] + (size_t)l * INC;
    const int NT = (512 + 128) * 352;
    for (int task = fresh_bid() * 512 + fresh_tid(); task < NT; task += gridDim.x * 512) {
        const int cgp = task % 352, rc = task / 352, j0 = cgp * 8;
        int row0, nrows; bool sample = rc >= 512;
        if (!sample) { row0 = rc * 32; nrows = 32; } else { row0 = MP + (rc - 512) * 8; nrows = 8; }
        float w0v[8], w1v[8], w2v[8], bv[8], w0g[8], w1g[8], w2g[8], bg[8];
#pragma unroll
        for (int e = 0; e < 8; ++e) { w0v[e] = cw[j0 + e]; w1v[e] = cw[INC + j0 + e]; w2v[e] = cw[2 * INC + j0 + e]; bv[e] = cb[j0 + e];
            w0g[e] = cw[DFF + j0 + e]; w1g[e] = cw[INC + DFF + j0 + e]; w2g[e] = cw[2 * INC + DFF + j0 + e]; bg[e] = cb[DFF + j0 + e]; }
        float p2v[8], p1v[8], p2g[8], p1g[8];
        if (sample) {
            const float* sc = p.in[5] + ((size_t)(l * 128 + (rc - 512)) * 2) * INC;
#pragma unroll
            for (int e = 0; e < 8; ++e) { p2v[e] = sc[j0 + e]; p1v[e] = sc[INC + j0 + e]; p2g[e] = sc[DFF + j0 + e]; p1g[e] = sc[INC + DFF + j0 + e]; }
        } else if ((row0 & 2047) == 0) {
#pragma unroll
            for (int e = 0; e < 8; ++e) { p2v[e] = 0.f; p1v[e] = 0.f; p2g[e] = 0.f; p1g[e] = 0.f; }
        } else {
            const u32x4 a = *(const u32x4*)(up + (size_t)(row0 - 2) * INC + j0), b = *(const u32x4*)(up + (size_t)(row0 - 1) * INC + j0);
            const u32x4 c = *(const u32x4*)(up + (size_t)(row0 - 2) * INC + DFF + j0), d = *(const u32x4*)(up + (size_t)(row0 - 1) * INC + DFF + j0);
            const unsigned aw[4] = {a.x, a.y, a.z, a.w}, bw[4] = {b.x, b.y, b.z, b.w}, cw_[4] = {c.x, c.y, c.z, c.w}, dw[4] = {d.x, d.y, d.z, d.w};
#pragma unroll
            for (int e = 0; e < 8; ++e) { p2v[e] = (e & 1) ? bfhi(aw[e >> 1]) : bflo(aw[e >> 1]); p1v[e] = (e & 1) ? bfhi(bw[e >> 1]) : bflo(bw[e >> 1]);
                p2g[e] = (e & 1) ? bfhi(cw_[e >> 1]) : bflo(cw_[e >> 1]); p1g[e] = (e & 1) ? bfhi(dw[e >> 1]) : bflo(dw[e >> 1]); }
        }
        for (int r = 0; r < nrows; ++r) {
            const u32x4 a = *(const u32x4*)(up + (size_t)(row0 + r) * INC + j0), c = *(const u32x4*)(up + (size_t)(row0 + r) * INC + DFF + j0);
            const unsigned aw[4] = {a.x, a.y, a.z, a.w}, cw_[4] = {c.x, c.y, c.z, c.w};
            float o[8];
#pragma unroll
            for (int e = 0; e < 8; ++e) {
                const float cv = (e & 1) ? bfhi(aw[e >> 1]) : bflo(aw[e >> 1]), cg_ = (e & 1) ? bfhi(cw_[e >> 1]) : bflo(cw_[e >> 1]);
                const float val = bv[e] + w0v[e] * p2v[e] + w1v[e] * p1v[e] + w2v[e] * cv;
                const float gat = bg[e] + w0g[e] * p2g[e] + w1g[e] * p1g[e] + w2g[e] * cg_;
                o[e] = siluf_(gat) * val;
                p2v[e] = p1v[e]; p1v[e] = cv; p2g[e] = p1g[e]; p1g[e] = cg_;
            }
            u32x4 w; w.x = pk2(o[0], o[1]); w.y = pk2(o[2], o[3]); w.z = pk2(o[4], o[5]); w.w = pk2(o[6], o[7]);
            *(u32x4*)(act + (size_t)(row0 + r) * DFF + j0) = w;
        }
    }
}

#endif

__global__ void __launch_bounds__(512, 2) fwd_kernel(KP p) {
#if defined(__HIP_DEVICE_COMPILE__)
    extern __shared__ __attribute__((aligned(16))) unsigned char lds[];
    cg::grid_group grid = cg::this_grid();
    volatile LAS unsigned* barw = (volatile LAS unsigned*)((LAS unsigned char*)lds + LDS_BARW);
    if (threadIdx.x < 4) barw[threadIdx.x] = 0u;
    if (threadIdx.x == 0) {
        LAS unsigned long long* t = (LAS unsigned long long*)((LAS unsigned char*)lds + LDS_TAB);
#pragma unroll
        for (int i = 0; i < 26; ++i) t[i] = (unsigned long long)p.in[i];
        t[26] = (unsigned long long)p.out; t[27] = (unsigned long long)p.ws;
    }
    __syncthreads();
    (void)xcd_barrier_post((unsigned*)(p.ws + WS_CTL), barw);
#if USE_CG
#define GSYNC() grid.sync()
#else
#define GSYNC() do { XcdBarrier b_; b_.bar = (unsigned*)((GAS unsigned char*)ld_tab(lds, 27) + WS_CTL); b_.x = xb_xcc_id(); b_.st = (volatile LAS unsigned*)((LAS unsigned char*)lds + LDS_BARW); xcd_barrier(b_); } while (0)
#endif
#define PH_BEGIN const KPG q = load_kp(lds); const int tid_ = fresh_tid(), lane = tid_ & 63, wave = __builtin_amdgcn_readfirstlane(tid_ >> 6); (void)lane; (void)wave; \
                 const int G = gridDim.x, c = fresh_bid(); (void)G; (void)c; LAS unsigned char* glds = (LAS unsigned char*)lds; (void)glds;

    for (int l = 0; l < DEPTH; ++l) {
        {
            PH_BEGIN
#ifndef NO_PRO
            phase_prologue(q, l, lds, wave, lane);
#endif
            phase_rmsnorm(q, l, wave, lane);
        }
        if (l == 0) grid.sync();
        GSYNC();
        {
            PH_BEGIN
            unsigned char* wl = q.ws + WS_WT + (size_t)l * LW_SIZE;
            pg8::Sched S{(const char*)(q.ws + WS_H), (const char*)(wl + LW_IN), nullptr, nullptr, 16, 0, 1024, MT / 256, INC / 256, G, c};
            pg8::EpiStoreBf16 E{(bf16_t*)(q.ws + WS_Z), INC};
#if !defined(NO_GEMM) && (!defined(ONLY_GEMM) || ONLY_GEMM == 0)
            pg8::gemm_phase(glds, S, E);
#endif
        }
        GSYNC();
        {
            PH_BEGIN
#ifndef NO_RM1
            for (int u = c; u < 128; u += G) ret_m1_unit(q, l, u, lds, wave, lane);
#endif
#ifndef NO_RS
            for (int u = c - 128; u >= 0 && u < 512; u += 128) ret_sample_unit(q, l, u, lds, wave, lane);
#endif
        }
        {
            PH_BEGIN
#ifndef NO_SM1
            for (int u = c - 128; u >= 0 && u < 256; u += 128) { const int wt = u * 8 + wave; s5_m1(q, l, wt >> 8, (wt >> 3) & 31, wt & 7, lane); }
#endif
        }
        {
            PH_BEGIN
#ifndef NO_SS
            for (int u = c - 128; u >= 0 && u < 128; u += G) { const int g = (u >> 4) * 4 + (wave & 3), bq = (u & 15) * 2 + (wave >> 2);
                s5_tile<true>(q, l, g, MP + bq * 32, bq * 4, 0, (bf16_t*)(lds + wave * 8704), lane); }
#endif
        }
        GSYNC();
        {
            PH_BEGIN
#ifndef NO_RM2
            for (int u = c; u < 512; u += G) ret_m2_unit(q, l, u, lds, wave, lane);
#endif
        }
        {
            PH_BEGIN
#ifndef NO_SM2
            for (int uu = c; uu < 2048; uu += G) { const int chunk = (uu & 31) * 2 + (wave >> 2), g = ((uu >> 5) & 7) * 4 + (wave & 3), b = uu >> 8;
                s5_tile<false>(q, l, g, b * 2048 + chunk * 32, b, chunk, (bf16_t*)(lds + wave * 8704), lane); }
#endif
        }
        GSYNC();
        {
            PH_BEGIN
            unsigned char* wl = q.ws + WS_WT + (size_t)l * LW_SIZE;
            pg8::Sched S{(const char*)(q.ws + WS_YA), (const char*)(wl + LW_GLU), nullptr, nullptr, 8, 0, 512, MT / 256, 2, G, c};
            pg8::EpiGlu E{(const bf16_t*)(q.ws + WS_YA), (bf16_t*)(q.ws + WS_YA2)};
#if !defined(NO_GEMM) && (!defined(ONLY_GEMM) || ONLY_GEMM == 1)
            pg8::gemm_phase(glds, S, E);
#endif
        }
        GSYNC();
        {
            PH_BEGIN
            unsigned char* wl = q.ws + WS_WT + (size_t)l * LW_SIZE;
            pg8::Sched S{(const char*)(q.ws + WS_YA2), (const char*)(wl + LW_SSM), (const char*)(q.ws + WS_O), (const char*)(wl + LW_RET), 8, 16, 1024, MT / 256, 4, G, c};
            pg8::EpiMix E{(const bf16_t*)(q.ws + WS_Z), (bf16_t*)(q.ws + WS_MIX)};
#if !defined(NO_GEMM) && (!defined(ONLY_GEMM) || ONLY_GEMM == 2)
            pg8::gemm_phase(glds, S, E);
#endif
        }
        GSYNC();
        {
            PH_BEGIN
            unsigned char* wl = q.ws + WS_WT + (size_t)l * LW_SIZE;
            pg8::Sched S{(const char*)(q.ws + WS_MIX), (const char*)(wl + LW_O), nullptr, nullptr, 16, 0, 1024, MT / 256, 4, G, c};
            pg8::EpiRes E{l == 0 ? q.in[0] : (const float*)(q.ws + WS_X), l == 0 ? q.in[1] : (const float*)(q.ws + WS_X) + (size_t)MP * 1024, (float*)(q.ws + WS_X)};
#if !defined(NO_GEMM) && (!defined(ONLY_GEMM) || ONLY_GEMM == 3)
            pg8::gemm_phase(glds, S, E);
#endif
        }
        GSYNC();
        { PH_BEGIN phase_rmsnorm(q, 1, wave, lane); }
        GSYNC();
        {
            PH_BEGIN
            unsigned char* wl = q.ws + WS_WT + (size_t)l * LW_SIZE;
            pg8::Sched S{(const char*)(q.ws + WS_H), (const char*)(wl + LW_UP), nullptr, nullptr, 16, 0, 1024, MT / 256, INC / 256, G, c};
            pg8::EpiUp E{(bf16_t*)(q.ws + WS_Z), q.out + O_CP + (size_t)l * 8 * 2 * INC, q.out + O_CS + (size_t)l * 128 * 2 * INC};
#if !defined(NO_GEMM) && (!defined(ONLY_GEMM) || ONLY_GEMM == 4)
            pg8::gemm_phase(glds, S, E);
#endif
        }
        GSYNC();
        {
            PH_BEGIN
#ifndef NO_CONV
            phase_convact(q, l);
#endif
        }
        GSYNC();
        {
            PH_BEGIN
            unsigned char* wl = q.ws + WS_WT + (size_t)l * LW_SIZE;
            pg8::Sched S{(const char*)(q.ws + WS_ACT), (const char*)(wl + LW_DOWN), nullptr, nullptr, 44, 0, DFF, MT / 256, 4, G, c};
            pg8::EpiRes E{(const float*)(q.ws + WS_X), (const float*)(q.ws + WS_X) + (size_t)MP * 1024, (float*)(q.ws + WS_X)};
#if !defined(NO_GEMM) && (!defined(ONLY_GEMM) || ONLY_GEMM == 5)
            pg8::gemm_phase(glds, S, E);
#endif
        }
        GSYNC();
    }
    {
        PH_BEGIN
        const float* xb = (const float*)(q.ws + WS_X); const float* gf = q.in[25];
        for (int row = c * 8 + wave; row < MT; row += G * 8) {
            const f32x4* xr = (const f32x4*)(xb + (size_t)row * 1024) + lane; const f32x4* gr = (const f32x4*)gf + lane;
            f32x4 v[4]; float s = 0.f;
#pragma unroll
            for (int j = 0; j < 4; ++j) { v[j] = xr[64 * j]; s += (v[j].x * v[j].x + v[j].y * v[j].y) + (v[j].z * v[j].z + v[j].w * v[j].w); }
            const float rstd = rsqrtf(wave_sum(s) * (1.f / 1024.f) + EPSF);
            f32x4* o = (f32x4*)(q.out + O_YP + (size_t)row * 1024) + lane;
#pragma unroll
            for (int j = 0; j < 4; ++j) o[64 * j] = v[j] * rstd * gr[64 * j];
        }
    }
#endif
}

extern "C" void kernel_launch(void* const* d_in, const int* in_sizes, int n_in, void* d_out, int out_size, void* d_ws, size_t ws_size, hipStream_t stream) {
    static int grid = 0;
    if (grid == 0) {
        if (n_in != 26 || ws_size < WS_END) { fprintf(stderr, "kernel_launch: unexpected shapes (n_in %d, ws %zu < %zu)\n", n_in, ws_size, (size_t)WS_END); grid = -1; return; }
        int dev = 0, cus = 0, per_cu = 0;
        hipGetDevice(&dev);
        hipDeviceGetAttribute(&cus, hipDeviceAttributeMultiprocessorCount, dev);
        if (hipFuncSetAttribute((const void*)fwd_kernel, hipFuncAttributeMaxDynamicSharedMemorySize, LDS_BYTES) != hipSuccess) { fprintf(stderr, "kernel_launch: hipFuncSetAttribute failed\n"); grid = -1; return; }
        hipOccupancyMaxActiveBlocksPerMultiprocessor(&per_cu, (const void*)fwd_kernel, 512, LDS_BYTES);
        (void)hipGetLastError();
        if (per_cu < 1) per_cu = 1;
        grid = cus * 1;
    }
    if (grid < 0) return;
    hipMemsetAsync((char*)d_ws + WS_CTL, 0, 65536, stream);
    KP p{};
    for (int i = 0; i < 26; ++i) p.in[i] = (const float*)d_in[i];
    p.out = (float*)d_out; p.ws = (unsigned char*)d_ws;
    void* args[] = {&p};
    hipError_t e = hipLaunchCooperativeKernel((const void*)fwd_kernel, dim3(grid), dim3(512), args, LDS_BYTES, stream);
    if (e != hipSuccess) fprintf(stderr, "cooperative launch failed: %s (grid %d)\n", hipGetErrorString(e), grid);
}
```

```cpp
#include <hip/hip_runtime.h>
#include <hip/hip_cooperative_groups.h>
#include <cstdio>
#include <cstdint>
namespace cg = cooperative_groups;

#ifndef USE_CG
#define USE_CG 0
#endif

#define LAS __attribute__((address_space(3)))
typedef unsigned short bf16_t;
typedef short bf16x8 __attribute__((ext_vector_type(8)));
typedef float f32x4 __attribute__((ext_vector_type(4)));
typedef float f32x16 __attribute__((ext_vector_type(16)));
typedef unsigned u32x4 __attribute__((ext_vector_type(4)));
typedef unsigned u32x2 __attribute__((ext_vector_type(2)));

constexpr int DM = 1024, MP = 16384, MS = 1024, MT = MP + MS, DEPTH = 4;
constexpr int INC = 5632, DFF = 2816, DSSM = 512;
constexpr int ZQ = 512, ZK = 1024, ZV = 1536, ZGR = 2560, ZGA = 3584, ZGB = 4608;
constexpr float EPSF = 1e-6f;
constexpr size_t O_YP = 0, O_YS = 16777216, O_SRP = 17825792, O_SIP = 17891328, O_RP = 17956864, O_CP = 22151168,
                 O_SRS = 22511616, O_SIS = 23560192, O_RS = 24608768, O_CS = 91717632;
constexpr size_t WS_CTL = 0;
constexpr size_t WS_WT = 65536;
constexpr size_t LW_IN = 0, LW_UP = 11534336, LW_DOWN = LW_UP + 11534336, LW_O = LW_DOWN + 5767168, LW_RET = LW_O + 2097152,
                 LW_SSM = LW_RET + 2097152, LW_GLU = LW_SSM + 2097152, LW_SIZE = LW_GLU + 524288;
constexpr size_t WS_S5T = WS_WT + 4 * LW_SIZE;
constexpr size_t S5_MB = 0, S5_BMT = 4194304, S5_CMT = S5_BMT + 131072, S5_LAM = S5_CMT + 131072, S5_LAM32 = S5_LAM + 16384, S5_SIZE = S5_LAM32 + 16384;
constexpr size_t WS_ROPE = WS_S5T + 4 * S5_SIZE;
constexpr size_t WS_X = WS_ROPE + 1052672;
constexpr size_t WS_H = WS_X + (size_t)MT * 1024 * 4;
constexpr size_t WS_Z = WS_H + (size_t)MT * 1024 * 2;
constexpr size_t WS_YA = WS_Z + (size_t)MT * INC * 2;
constexpr size_t WS_YA2 = WS_YA + (size_t)MT * 512 * 2;
constexpr size_t WS_O = WS_YA2 + (size_t)MT * 1024 * 2;
constexpr size_t WS_MIX = WS_O + (size_t)MT * 1024 * 2;
constexpr size_t WS_ACT = WS_MIX + (size_t)MT * 1024 * 2;
constexpr size_t WS_SIN = WS_ACT + (size_t)MT * DFF * 2;
constexpr size_t WS_RT = WS_SIN + (size_t)8 * 32 * 64 * 128 * 4;
constexpr size_t WS_E = WS_RT + (size_t)32 * 16 * 256 * 128 * 2;
constexpr size_t WS_END = WS_E + (size_t)8 * 32 * 8 * 128 * 4;

constexpr int LDS_BYTES = 147456;
constexpr int LDS_BARW = LDS_BYTES - 16;

#define GAS __attribute__((address_space(1)))
struct KP { const float* in[26]; float* out; unsigned char* ws; };
#if defined(__HIP_DEVICE_COMPILE__)
struct KPG { const GAS float* in[26]; GAS float* out; GAS unsigned char* ws; };
constexpr int LDS_TAB = LDS_BYTES - 16 - 256;
__device__ __forceinline__ unsigned long long ld_tab(const unsigned char* lds, int i) {
    unsigned off = (unsigned)(LDS_TAB + 8 * i); asm volatile("" : "+v"(off));
    const unsigned long long v = *(const LAS unsigned long long*)((const LAS unsigned char*)lds + off);
    const unsigned lo = __builtin_amdgcn_readfirstlane((unsigned)v), hi = __builtin_amdgcn_readfirstlane((unsigned)(v >> 32));
    return ((unsigned long long)hi << 32) | lo;
}
__device__ __forceinline__ KPG load_kp(const unsigned char* lds) {
    KPG q; asm volatile("" ::: "memory");
#pragma unroll
    for (int i = 0; i < 26; ++i) q.in[i] = (const GAS float*)ld_tab(lds, i);
    q.out = (GAS float*)ld_tab(lds, 26); q.ws = (GAS unsigned char*)ld_tab(lds, 27);
    return q;
}
__device__ __forceinline__ int fresh_tid() { int t = threadIdx.x; asm volatile("" : "+v"(t)); return t; }
__device__ __forceinline__ int fresh_bid() { int b = blockIdx.x; asm volatile("" : "+s"(b)); return b; }

__device__ __forceinline__ float bf2f(bf16_t b) { return __uint_as_float(((unsigned)b) << 16); }
__device__ __forceinline__ float bflo(unsigned w) { return __uint_as_float(w << 16); }
__device__ __forceinline__ float bfhi(unsigned w) { return __uint_as_float(w & 0xffff0000u); }
__device__ __forceinline__ bf16_t f2bf(float f) { unsigned u = __float_as_uint(f); u += 0x7FFFu + ((u >> 16) & 1u); return (bf16_t)(u >> 16); }
__device__ __forceinline__ unsigned pk2(float lo, float hi) { unsigned r; asm volatile("v_cvt_pk_bf16_f32 %0, %1, %2" : "=v"(r) : "v"(lo), "v"(hi)); return r; }
template <int CTRL> __device__ __forceinline__ float dppf(float x) { return __uint_as_float((unsigned)__builtin_amdgcn_update_dpp(0, (int)__float_as_uint(x), CTRL, 0xf, 0xf, false)); }
__device__ __forceinline__ float row_sum16(float x) {
    x += dppf<0xB1>(x); x += dppf<0x4E>(x); x += dppf<0x141>(x); x += dppf<0x140>(x); return x;
}
__device__ __forceinline__ float wave_sum(float v) {
    const float r = row_sum16(v);
    return (__builtin_amdgcn_readlane(r, 0) + __builtin_amdgcn_readlane(r, 16)) + (__builtin_amdgcn_readlane(r, 32) + __builtin_amdgcn_readlane(r, 48));
}
__device__ __forceinline__ float xor32(float x, int half) { const unsigned u = __float_as_uint(x); auto r = __builtin_amdgcn_permlane32_swap(u, u, false, false); return __uint_as_float(half ? r[0] : r[1]); }
__device__ __forceinline__ float sigmoidf_(float x) { return __builtin_amdgcn_rcpf(1.0f + __expf(-x)); }
__device__ __forceinline__ float siluf_(float x) { return x * __builtin_amdgcn_rcpf(1.0f + __expf(-x)); }
__device__ __forceinline__ float gelu_tanh(float x) { const float u = 0.7978845608028654f * (x + 0.044715f * x * x * x); return x * __builtin_amdgcn_rcpf(1.0f + __expf(-2.0f * u)); }
__device__ __forceinline__ void sincos_rev(float rev, float& s, float& c) {
    const float f = rev - rintf(rev);
    s = __builtin_amdgcn_sinf(f); c = __builtin_amdgcn_cosf(f);
}
#define LDS_WAIT() asm volatile("s_waitcnt lgkmcnt(0)" ::: "memory")
#define MFMA16(a, b, c) __builtin_amdgcn_mfma_f32_16x16x32_bf16((a), (b), (c), 0, 0, 0)
#define MFMA32(a, b, c) __builtin_amdgcn_mfma_f32_32x32x16_bf16((a), (b), (c), 0, 0, 0)
#define MFMA_SETTLE() do { __builtin_amdgcn_sched_barrier(0); asm volatile("s_nop 15\n\ts_nop 15\n\ts_nop 15\n\ts_nop 15" ::: "memory"); __builtin_amdgcn_sched_barrier(0); } while (0)

#define XB_TMO      128
#define XB_XCNT(j)  (256  + 64 * (j))
#define XB_XSUB(j)  (1280 + 64 * (j))
#define XB_XGEN(j)  (2304 + 64 * (j))
#define XB_TOP      3328
#define XB_TOPGEN   3392
#define XCD_BAR_WORDS 3456
#define XB_SPIN_CAP (1u << 22)
__device__ __forceinline__ unsigned xb_ld(unsigned* p)              { return __hip_atomic_load(p, __ATOMIC_RELAXED, __HIP_MEMORY_SCOPE_AGENT); }
__device__ __forceinline__ unsigned xb_add(unsigned* p, unsigned v) { return __hip_atomic_fetch_add(p, v, __ATOMIC_RELAXED, __HIP_MEMORY_SCOPE_AGENT); }
__device__ __forceinline__ unsigned xb_xcc_id() { return (unsigned)__builtin_amdgcn_s_getreg((3 << 11) | 20) & 0xFu; }
#define XB_SPIN(cond, bar) do { unsigned _sp = 0; while (cond) { __builtin_amdgcn_s_sleep(1); \
    if ((++_sp & 255u) == 0u) { if (xb_ld(&(bar)[XB_TMO])) break; if (_sp > XB_SPIN_CAP) { atomicAdd(&(bar)[XB_TMO], 1u); break; } } } } while (0)
struct XcdBarrier { unsigned* bar; unsigned x; volatile LAS unsigned* st; };
__device__ __forceinline__ XcdBarrier xcd_barrier_post(unsigned* bar, volatile LAS unsigned* st) {
    XcdBarrier b; b.bar = bar; b.x = xb_xcc_id(); b.st = st;
    if (threadIdx.x == 0) (void)xb_add(&bar[XB_XCNT(b.x)], 1u);
    return b;
}
__device__ __forceinline__ void xcd_barrier_complete(unsigned* bar, unsigned x, unsigned& nloc, unsigned& nx) {
    const unsigned G = gridDim.x * gridDim.y * gridDim.z;
    unsigned sum, cnt, mine, sp = 0u;
    for (;;) {
        sum = 0u; cnt = 0u; mine = 0u;
#pragma unroll
        for (unsigned j = 0; j < 16; ++j) { const unsigned c = xb_ld(&bar[XB_XCNT(j)]); sum += c; cnt += (c > 0u) ? 1u : 0u; mine = (j == x) ? c : mine; }
        if (sum == G) break;
        __builtin_amdgcn_s_sleep(1);
        if ((++sp & 255u) == 0u) { if (xb_ld(&bar[XB_TMO])) break; if (sp > XB_SPIN_CAP) { atomicAdd(&bar[XB_TMO], 1u); break; } }
    }
    nloc = mine > 0u ? mine : 1u; nx = cnt > 0u ? cnt : 1u;
}
__device__ __forceinline__ void xcd_barrier(const XcdBarrier& b) {
    asm volatile("s_waitcnt vmcnt(0)" ::: "memory");
    __syncthreads();
    if (threadIdx.x == 0) {
        unsigned* bar = b.bar;
        __builtin_amdgcn_s_waitcnt(0);
        unsigned nloc = b.st[0], nx = b.st[1];
        if (nloc == 0u) { xcd_barrier_complete(bar, b.x, nloc, nx); b.st[0] = nloc; b.st[1] = nx; }
        const unsigned old = xb_add(&bar[XB_XSUB(b.x)], 1u);
        const unsigned gen = old / nloc;
        if (old + 1u == (gen + 1u) * nloc) {
            __builtin_amdgcn_fence(__ATOMIC_RELEASE, "agent");
            asm volatile("s_waitcnt vmcnt(0)" ::: "memory");
            const unsigned og = xb_add(&bar[XB_TOP], 1u);
            const unsigned tg = og / nx;
            if (og + 1u == (tg + 1u) * nx) xb_add(&bar[XB_TOPGEN], 1u);
            else XB_SPIN(xb_ld(&bar[XB_TOPGEN]) == tg, bar);
            __builtin_amdgcn_fence(__ATOMIC_ACQUIRE, "agent");
            xb_add(&bar[XB_XGEN(b.x)], 1u);
            asm volatile("s_waitcnt vmcnt(0)" ::: "memory");
        } else {
            XB_SPIN(xb_ld(&bar[XB_XGEN(b.x)]) == gen, bar);
            __builtin_amdgcn_fence(__ATOMIC_ACQUIRE, "agent");
            asm volatile("s_waitcnt vmcnt(0)" ::: "memory");
        }
    }
    __syncthreads();
}

namespace pg8 {
constexpr int BM = 256, BK = 64, HALF = 128, HTB = HALF * BK * 2, STAGE_BYTES = 8 * HTB, NXCD = 8, WGM = 8;
__device__ __forceinline__ int lds_byte(int r, int c) { const int st = (r >> 4) * 2 + (c >> 5), rr = r & 15, cc = c & 31, ob = rr * 64 + cc * 2; return st * 1024 + (ob ^ (((ob >> 9) & 1) << 5)); }
__device__ __forceinline__ void stage_rc(int b, int& R, int& C) { const int st = b / 1024, sb = b % 1024, swz = sb ^ (((sb >> 9) & 1) << 5); R = (st >> 1) * 16 + swz / 64; C = (st & 1) * 32 + (swz % 64) / 2; }
__device__ __forceinline__ int perm32(int rho) { const int n = rho >> 4, i = rho & 15; return 8 * (i >> 2) + 4 * n + (i & 3); }

struct Unit { const char* A; const char* B; int nt, mode, pm, pn; };
struct Sched {
    const char *A0, *B0, *A1, *B1; int nt0, nt1, ld, nM, nN, G, c;
    __device__ __forceinline__ bool next(int i, Unit& u) const {
        const int dual = (A1 != nullptr) ? 1 : 0; const int ti = dual ? (i >> 1) : i, sub = dual ? (i & 1) : 0;
        const int nwg = nM * nN; const long L = (long)ti * G + c; if (L >= nwg) return false;
        int wgid = (int)L; { const int q = nwg / NXCD, r = nwg % NXCD, xcd = wgid % NXCD, off = wgid / NXCD; wgid = (xcd < r ? xcd * (q + 1) : r * (q + 1) + (xcd - r) * q) + off; }
        const int nig = WGM * nN, gid = wgid / nig, fm = gid * WGM, gsz = (nM - fm) < WGM ? (nM - fm) : WGM;
        u.pm = fm + ((wgid % nig) % gsz); u.pn = (wgid % nig) / gsz;
        const size_t tstep = (size_t)BM * ld * 2;
        u.A = (sub ? A1 : A0) + (size_t)u.pm * tstep; u.B = (sub ? B1 : B0) + (size_t)u.pn * tstep; u.nt = sub ? nt1 : nt0; u.mode = dual ? (sub ? 2 : 1) : 0;
        return true;
    }
};
typedef f32x4 Acc[2][2][4][2];

template <class Epi>
__device__ __forceinline__ void gemm_phase(LAS unsigned char* lds, const Sched& S, const Epi& E) {
    const int tid = fresh_tid(), wid = __builtin_amdgcn_readfirstlane(tid >> 6), lane = tid & 63, wr = wid >> 2, wc = wid & 3, fr = lane & 15, fq = lane >> 4;
    const int ld = S.ld;
    unsigned voffA[2], voffB[2];
#pragma unroll
    for (int i = 0; i < 2; ++i) { int R, C; stage_rc(tid * 16 + i * 8192, R, C); const int Rb = (R & ~31) + perm32(R & 31);
        voffA[i] = (unsigned)(R * ld + C) * 2u; voffB[i] = (unsigned)(Rb * ld + C) * 2u; }
    const size_t kstep = (size_t)(BK * 2);
    const size_t hstep = (size_t)HALF * ld * 2;
    const unsigned ldsw = (unsigned)wid * 1024u;
    const int aoff = lds_byte(wr * 64 + fr, fq * 8), boff = lds_byte(wc * 32 + fr, fq * 8);
#define PG8_SA(b, h) (((b) * 2 + (h)) * HTB)
#define PG8_SB(b, h) ((4 + (b) * 2 + (h)) * HTB)
#define PG8_STAGE(bufoff, gbase, voff) do { _Pragma("unroll") for (int _i = 0; _i < 2; ++_i) \
        __builtin_amdgcn_global_load_lds((const unsigned*)((const char*)(gbase) + (voff)[_i]), (LAS unsigned*)(lds + (bufoff) + ldsw + _i * 8192), 16, 0, 0); } while (0)
#define PG8_LDA(dst, b, h) do { _Pragma("unroll") for (int m = 0; m < 4; ++m) _Pragma("unroll") for (int k = 0; k < 2; ++k) dst[m][k] = *(const LAS bf16x8*)(lds + PG8_SA(b, h) + aoff + m * 2048 + k * 1024); } while (0)
#define PG8_LDB(dst, b, h) do { _Pragma("unroll") for (int n = 0; n < 2; ++n) _Pragma("unroll") for (int k = 0; k < 2; ++k) dst[n][k] = *(const LAS bf16x8*)(lds + PG8_SB(b, h) + boff + n * 2048 + k * 1024); } while (0)
#define PG8_MMA(ai, bj, At, Bt) do { __builtin_amdgcn_s_setprio(1); _Pragma("unroll") for (int m = 0; m < 4; ++m) _Pragma("unroll") for (int n = 0; n < 2; ++n) _Pragma("unroll") for (int k = 0; k < 2; ++k) \
        acc[ai][bj][m][n] = __builtin_amdgcn_mfma_f32_16x16x32_bf16(Bt[n][k], At[m][k], acc[ai][bj][m][n], 0, 0, 0); __builtin_amdgcn_s_setprio(0); } while (0)
#define PG8_WAIT_V(n) asm volatile("s_waitcnt vmcnt(" #n ")" ::: "memory")
#define PG8_WAIT_L(n) asm volatile("s_waitcnt lgkmcnt(" #n ")" ::: "memory")
#define PG8_BAR __builtin_amdgcn_s_barrier()
#define PG8_SCHED __builtin_amdgcn_sched_barrier(0)
    Unit cur, nxt; int ui = 0;
    if (!S.next(0, cur)) return;
    Acc acc;
#pragma unroll
    for (int a = 0; a < 2; ++a)
#pragma unroll
        for (int b = 0; b < 2; ++b)
#pragma unroll
            for (int m = 0; m < 4; ++m)
#pragma unroll
                for (int n = 0; n < 2; ++n) acc[a][b][m][n] = (f32x4){0.f, 0.f, 0.f, 0.f};
    bf16x8 At[4][2], B0[2][2], B1[2][2];
    const char* cA = cur.A; const char* cB = cur.B;
    PG8_STAGE(PG8_SB(0, 0), cB, voffB); PG8_STAGE(PG8_SA(0, 0), cA, voffA); PG8_STAGE(PG8_SB(0, 1), cB + hstep, voffB); PG8_STAGE(PG8_SA(0, 1), cA + hstep, voffA);
    if (wr == 1) PG8_BAR;
    PG8_WAIT_V(4); PG8_BAR;
    PG8_STAGE(PG8_SB(1, 0), cB + kstep, voffB); PG8_STAGE(PG8_SA(1, 0), cA + kstep, voffA); PG8_STAGE(PG8_SB(1, 1), cB + hstep + kstep, voffB);
    PG8_WAIT_V(6); PG8_BAR;
    for (;;) {
        const bool has_next = S.next(ui + 1, nxt);
        const char* nA = has_next ? nxt.A : cA; const char* nB = has_next ? nxt.B : cB;
        const int nt = cur.nt;
        for (int t = 0; t < nt; t += 2) {
            const bool last = (t == nt - 2);
            const char* a1 = cA + (size_t)(t + 1) * kstep;
            const char* a2 = last ? nA : cA + (size_t)(t + 2) * kstep; const char* b2 = last ? nB : cB + (size_t)(t + 2) * kstep;
            const char* a3 = a2 + kstep; const char* b3 = b2 + kstep;
            PG8_LDB(B0, 0, 0); PG8_SCHED; PG8_LDA(At, 0, 0); PG8_STAGE(PG8_SA(1, 1), a1 + hstep, voffA);
            PG8_WAIT_L(8); PG8_BAR; PG8_WAIT_L(0); PG8_MMA(0, 0, At, B0); PG8_BAR; PG8_SCHED;
            PG8_LDB(B1, 0, 1); PG8_STAGE(PG8_SB(0, 0), b2, voffB);
            PG8_BAR; PG8_WAIT_L(0); PG8_MMA(0, 1, At, B1); PG8_BAR;
            PG8_LDA(At, 0, 1); PG8_STAGE(PG8_SA(0, 0), a2, voffA);
            PG8_BAR; PG8_WAIT_L(0); PG8_MMA(1, 0, At, B0); PG8_BAR; PG8_SCHED;
            PG8_STAGE(PG8_SB(0, 1), b2 + hstep, voffB);
            PG8_WAIT_V(6); PG8_BAR; PG8_MMA(1, 1, At, B1); PG8_BAR;
            PG8_LDB(B0, 1, 0); PG8_SCHED; PG8_LDA(At, 1, 0); PG8_STAGE(PG8_SA(0, 1), a2 + hstep, voffA);
            PG8_WAIT_L(8); PG8_BAR; PG8_WAIT_L(0); PG8_MMA(0, 0, At, B0); PG8_BAR; PG8_SCHED;
            PG8_LDB(B1, 1, 1); PG8_STAGE(PG8_SB(1, 0), b3, voffB);
            PG8_BAR; PG8_WAIT_L(0); PG8_MMA(0, 1, At, B1); PG8_BAR;
            PG8_LDA(At, 1, 1); PG8_STAGE(PG8_SA(1, 0), a3, voffA);
            PG8_BAR; PG8_WAIT_L(0); PG8_MMA(1, 0, At, B0); PG8_BAR; PG8_SCHED;
            PG8_STAGE(PG8_SB(1, 1), b3 + hstep, voffB);
            PG8_WAIT_V(6); PG8_BAR; PG8_MMA(1, 1, At, B1); PG8_BAR;
        }
        MFMA_SETTLE();
        E(acc, cur, wr, wc, fr, fq);
        if (!has_next) break;
        if (cur.mode != 1) {
#pragma unroll
            for (int a = 0; a < 2; ++a)
#pragma unroll
                for (int b = 0; b < 2; ++b)
#pragma unroll
                    for (int m = 0; m < 4; ++m)
#pragma unroll
                        for (int n = 0; n < 2; ++n) acc[a][b][m][n] = (f32x4){0.f, 0.f, 0.f, 0.f};
        }
        cur = nxt; cA = nA; cB = nB; ++ui;
    }
    PG8_WAIT_V(0);
    if (wr == 0) PG8_BAR;
    PG8_BAR;
#undef PG8_SA
#undef PG8_SB
#undef PG8_STAGE
#undef PG8_LDA
#undef PG8_LDB
#undef PG8_MMA
#undef PG8_WAIT_V
#undef PG8_WAIT_L
#undef PG8_BAR
#undef PG8_SCHED
}

#define EPI_ROWS_BEGIN \
    _Pragma("unroll") for (int ai = 0; ai < 2; ++ai) _Pragma("unroll") for (int m = 0; m < 4; ++m) { const int row = u.pm * 256 + ai * 128 + wr * 64 + m * 16 + fr; \
    _Pragma("unroll") for (int bj = 0; bj < 2; ++bj) { const int col = u.pn * 256 + bj * 128 + wc * 32 + 8 * fq; f32x4& v0 = acc[ai][bj][m][0]; f32x4& v1 = acc[ai][bj][m][1];
#define EPI_ROWS_END } __builtin_amdgcn_sched_barrier(0); }

struct EpiStoreBf16 {
    bf16_t* O; int ldc;
    __device__ __forceinline__ void operator()(Acc& acc, const Unit& u, int wr, int wc, int fr, int fq) const {
        EPI_ROWS_BEGIN
            u32x4 w; w.x = pk2(v0[0], v0[1]); w.y = pk2(v0[2], v0[3]); w.z = pk2(v1[0], v1[1]); w.w = pk2(v1[2], v1[3]);
            *(u32x4*)(O + (size_t)row * ldc + col) = w;
        EPI_ROWS_END
    }
};
struct EpiGlu {
    const bf16_t* ya; bf16_t* ya2;
    __device__ __forceinline__ void operator()(Acc& acc, const Unit& u, int wr, int wc, int fr, int fq) const {
        EPI_ROWS_BEGIN
            const u32x4 y = *(const u32x4*)(ya + (size_t)row * 512 + col);
            u32x4 w;
            w.x = pk2(bflo(y.x) * sigmoidf_(v0[0]), bfhi(y.x) * sigmoidf_(v0[1]));
            w.y = pk2(bflo(y.y) * sigmoidf_(v0[2]), bfhi(y.y) * sigmoidf_(v0[3]));
            w.z = pk2(bflo(y.z) * sigmoidf_(v1[0]), bfhi(y.z) * sigmoidf_(v1[1]));
            w.w = pk2(bflo(y.w) * sigmoidf_(v1[2]), bfhi(y.w) * sigmoidf_(v1[3]));
            *(u32x4*)(ya2 + (size_t)row * 1024 + col) = w;
        EPI_ROWS_END
    }
};
struct EpiMix {
    const bf16_t* z; bf16_t* mix;
    __device__ __forceinline__ void operator()(Acc& acc, const Unit& u, int wr, int wc, int fr, int fq) const {
        if (u.mode == 1) {
            EPI_ROWS_BEGIN
                const u32x4 ga = *(const u32x4*)(z + (size_t)row * INC + ZGA + col);
                const u32x4 gb = *(const u32x4*)(z + (size_t)row * INC + ZGB + col);
#define RATIO(a, b) ((1.0f + __expf(-(b))) * __builtin_amdgcn_rcpf(1.0f + __expf(-(a))))
                v0[0] *= RATIO(bflo(ga.x), bflo(gb.x)); v0[1] *= RATIO(bfhi(ga.x), bfhi(gb.x));
                v0[2] *= RATIO(bflo(ga.y), bflo(gb.y)); v0[3] *= RATIO(bfhi(ga.y), bfhi(gb.y));
                v1[0] *= RATIO(bflo(ga.z), bflo(gb.z)); v1[1] *= RATIO(bfhi(ga.z), bfhi(gb.z));
                v1[2] *= RATIO(bflo(ga.w), bflo(gb.w)); v1[3] *= RATIO(bfhi(ga.w), bfhi(gb.w));
#undef RATIO
            EPI_ROWS_END
        } else {
            EPI_ROWS_BEGIN
                const u32x4 gb = *(const u32x4*)(z + (size_t)row * INC + ZGB + col);
                u32x4 w;
                w.x = pk2(v0[0] * sigmoidf_(bflo(gb.x)), v0[1] * sigmoidf_(bfhi(gb.x)));
                w.y = pk2(v0[2] * sigmoidf_(bflo(gb.y)), v0[3] * sigmoidf_(bfhi(gb.y)));
                w.z = pk2(v1[0] * sigmoidf_(bflo(gb.z)), v1[1] * sigmoidf_(bfhi(gb.z)));
                w.w = pk2(v1[2] * sigmoidf_(bflo(gb.w)), v1[3] * sigmoidf_(bfhi(gb.w)));
                *(u32x4*)(mix + (size_t)row * 1024 + col) = w;
            EPI_ROWS_END
        }
    }
};
struct EpiRes {
    const float* xinP; const float* xinS; float* xout;
    __device__ __forceinline__ void operator()(Acc& acc, const Unit& u, int wr, int wc, int fr, int fq) const {
        EPI_ROWS_BEGIN
            const float* xi = (row < MP ? xinP + (size_t)row * 1024 : xinS + (size_t)(row - MP) * 1024) + col;
            const f32x4 a = *(const f32x4*)xi, b = *(const f32x4*)(xi + 4);
            float* xo = xout + (size_t)row * 1024 + col;
            *(f32x4*)xo = a + v0; *(f32x4*)(xo + 4) = b + v1;
        EPI_ROWS_END
    }
};
struct EpiUp {
    bf16_t* up; float* convP; float* convS;
    __device__ __forceinline__ void operator()(Acc& acc, const Unit& u, int wr, int wc, int fr, int fq) const {
        EPI_ROWS_BEGIN
            u32x4 w; w.x = pk2(v0[0], v0[1]); w.y = pk2(v0[2], v0[3]); w.z = pk2(v1[0], v1[1]); w.w = pk2(v1[2], v1[3]);
            *(u32x4*)(up + (size_t)row * INC + col) = w;
            float* cp = nullptr;
            if (row < MP) { const int t = row & 2047; if (t >= 2046) cp = convP + ((size_t)((row >> 11) * 2 + (t - 2046))) * INC + col; }
            else { const int r2 = row - MP, t = r2 & 7; if (t >= 6) cp = convS + ((size_t)((r2 >> 3) * 2 + (t - 6))) * INC + col; }
            if (cp) { *(f32x4*)cp = v0; *(f32x4*)(cp + 4) = v1; }
        EPI_ROWS_END
    }
};
}

__device__ __forceinline__ void transpose_item(const float* W, int K, int N, bf16_t* WT, int ldd, const float* gk, float* scr, int item, int lane) {
    const int nblk = N / 32, kb = item / nblk, nb = item % nblk, k0 = 64 * kb, n0 = 32 * nb;
#pragma unroll 8
    for (int i = 0; i < 32; ++i) { const int kk = 2 * i + (lane >> 5); float v = W[(size_t)(k0 + kk) * N + n0 + (lane & 31)]; if (gk) v *= gk[k0 + kk]; scr[kk * 33 + (lane & 31)] = v; }
    LDS_WAIT();
    const int c = lane & 7;
#pragma unroll
    for (int j = 0; j < 4; ++j) { const int n = (lane >> 3) + 8 * j; const float* s = scr + (8 * c) * 33 + n;
        u32x4 o; o.x = pk2(s[0 * 33], s[1 * 33]); o.y = pk2(s[2 * 33], s[3 * 33]); o.z = pk2(s[4 * 33], s[5 * 33]); o.w = pk2(s[6 * 33], s[7 * 33]);
        *(u32x4*)(WT + (size_t)(n0 + n) * ldd + k0 + 8 * c) = o; }
    LDS_WAIT();
}

__device__ __forceinline__ void rms_row_to_bf16(const float* xrow, bf16_t* orow, int lane) {
    const f32x4* xr = (const f32x4*)xrow + lane;
    f32x4 v[4]; float s = 0.f;
#pragma unroll
    for (int j = 0; j < 4; ++j) { v[j] = xr[64 * j]; s += (v[j].x * v[j].x + v[j].y * v[j].y) + (v[j].z * v[j].z + v[j].w * v[j].w); }
    const float rstd = rsqrtf(wave_sum(s) * (1.f / 1024.f) + EPSF);
    u32x2* o8 = (u32x2*)orow + lane;
#pragma unroll
    for (int j = 0; j < 4; ++j) { u32x2 w; w.x = pk2(v[j].x * rstd, v[j].y * rstd); w.y = pk2(v[j].z * rstd, v[j].w * rstd); o8[64 * j] = w; }
}

__device__ __forceinline__ void phase_rmsnorm(const KPG& p, int l, int wave, int lane) {
    const float* xb = (const float*)(p.ws + WS_X); bf16_t* h = (bf16_t*)(p.ws + WS_H);
    for (int row = fresh_bid() * 8 + wave; row < MT; row += gridDim.x * 8) {
        const float* xr = (l == 0) ? (row < MP ? p.in[0] + (size_t)row * 1024 : p.in[1] + (size_t)(row - MP) * 1024) : xb + (size_t)row * 1024;
        rms_row_to_bf16(xr, h + (size_t)row * 1024, lane);
    }
}

__device__ __forceinline__ void phase_prologue(const KPG& p, int l, unsigned char* lds, int wave, int lane) {
    float* scr = (float*)(lds + wave * 8448);
    const int gw = fresh_bid() * 8 + wave, NGW = gridDim.x * 8;
    constexpr int I_IN = 16 * 176, I_UP = 16 * 176, I_DN = 44 * 32, I_O = 16 * 32, I_RET = 16 * 32, I_SSM = 8 * 32, I_GLU = 8 * 16;
    constexpr int I_L = I_IN + I_UP + I_DN + I_O + I_RET + I_SSM + I_GLU;
    for (int it = gw; it < I_L; it += NGW) {
        int r = it;
        unsigned char* wl = p.ws + WS_WT + (size_t)l * LW_SIZE;
        if (r < I_IN) { transpose_item(p.in[7] + (size_t)l * 1024 * INC, 1024, INC, (bf16_t*)(wl + LW_IN), 1024, p.in[6] + l * 1024, scr, r, lane); continue; } r -= I_IN;
        if (r < I_UP) { transpose_item(p.in[21] + (size_t)l * 1024 * INC, 1024, INC, (bf16_t*)(wl + LW_UP), 1024, p.in[20] + l * 1024, scr, r, lane); continue; } r -= I_UP;
        if (r < I_DN) { transpose_item(p.in[24] + (size_t)l * DFF * 1024, DFF, 1024, (bf16_t*)(wl + LW_DOWN), DFF, nullptr, scr, r, lane); continue; } r -= I_DN;
        if (r < I_O) { transpose_item(p.in[19] + (size_t)l * 1024 * 1024, 1024, 1024, (bf16_t*)(wl + LW_O), 1024, nullptr, scr, r, lane); continue; } r -= I_O;
        if (r < I_RET) { transpose_item(p.in[18] + (size_t)l * 1024 * 1024, 1024, 1024, (bf16_t*)(wl + LW_RET), 1024, nullptr, scr, r, lane); continue; } r -= I_RET;
        if (r < I_SSM) { transpose_item(p.in[17] + (size_t)l * 512 * 1024, 512, 1024, (bf16_t*)(wl + LW_SSM), 1024, nullptr, scr, r, lane); continue; } r -= I_SSM;
        transpose_item(p.in[16] + (size_t)l * 512 * 512, 512, 512, (bf16_t*)(wl + LW_GLU), 512, nullptr, scr, r, lane);
    }
    const int gt = fresh_bid() * 512 + fresh_tid(), NGT = gridDim.x * 512;
    for (int it = gt; it < 32 * 64; it += NGT) {
        const int pp = it & 63, g = (it >> 6) & 31;
        const int gi = l * 32 + g, pi = gi * 64 + pp;
        const float dt = __expf(p.in[10][gi]), lr = p.in[8][pi], li = p.in[9][pi];
        float s1, c1; sincos_rev(li * dt * 0.15915494309189535f, s1, c1);
        const float m1 = __expf(lr * dt); const float lbr = m1 * c1, lbi = m1 * s1;
        const float nr = lbr - 1.0f, ni = lbi, den = 1.0f / (lr * lr + li * li);
        const float cr = (nr * lr + ni * li) * den, ci = (ni * lr - nr * li) * den;
        unsigned char* st = p.ws + WS_S5T + (size_t)l * S5_SIZE;
        const float* bre = p.in[11] + (size_t)pi * 16; const float* bim = p.in[12] + (size_t)pi * 16;
        bf16_t* bmre = (bf16_t*)(st + S5_BMT) + (size_t)(g * 128 + pp) * 16; bf16_t* bmim = (bf16_t*)(st + S5_BMT) + (size_t)(g * 128 + 64 + pp) * 16;
#pragma unroll
        for (int c = 0; c < 16; ++c) { const float br = bre[c], bi = bim[c]; bmre[c] = f2bf(cr * br - ci * bi); bmim[c] = f2bf(cr * bi + ci * br); }
        float2* lam = (float2*)(st + S5_LAM) + g * 64 + pp; *lam = make_float2(lbr, lbi);
        float s32, c32; sincos_rev(32.0f * li * dt * 0.15915494309189535f, s32, c32); const float m32 = __expf(32.0f * lr * dt);
        float2* lam32 = (float2*)(st + S5_LAM32) + g * 64 + pp; *lam32 = make_float2(m32 * c32, m32 * s32);
    }
    for (int it = gt; it < 32 * 16 * 128; it += NGT) {
        const int pq = it & 127, c = (it >> 7) & 15, g = (it >> 11) & 31;
        const size_t src = ((size_t)((l * 32 + g) * 16 + c)) * 64 + (pq & 63);
        const float v = pq < 64 ? p.in[13][src] : -p.in[14][src];
        ((bf16_t*)(p.ws + WS_S5T + (size_t)l * S5_SIZE + S5_CMT))[(g * 16 + c) * 128 + pq] = f2bf(v);
    }
    for (int it = gt; it < 2056 * 64; it += NGT) {
        const int j = it & 63, pi = it >> 6; const double pos = (double)(pi < 2048 ? pi : 16384 + pi - 2048);
        double inv = 1.0, r = 0.86596432336006535;
        int e = j;
#pragma unroll
        for (int b = 0; b < 6; ++b) { if (e & 1) inv *= r; r *= r; e >>= 1; }
        const double rev = pos * inv * 0.15915494309189535; const double fr_ = rev - __builtin_rint(rev);
        const float f = (float)fr_;
        ((float2*)(p.ws + WS_ROPE))[it] = make_float2(__builtin_amdgcn_cosf(f), __builtin_amdgcn_sinf(f));
    }
}

template <bool SAMPLE>
__device__ __forceinline__ void s5_tile(const KPG& p, int l, int g, int row0, int bseq, int chunk, bf16_t* Sl, int lane) {
    const bf16_t* z = (const bf16_t*)(p.ws + WS_Z); bf16_t* ya = (bf16_t*)(p.ws + WS_YA);
    const unsigned char* st = p.ws + WS_S5T + (size_t)l * S5_SIZE;
    const int half = lane >> 5, li = lane & 31;
    const bf16x8 uf = *(const bf16x8*)(z + (size_t)(row0 + li) * INC + g * 16 + 8 * half);
    const int fr = lane & 15, fq = lane >> 4;
    float2 lm[2]; lm[0] = ((const float2*)(st + S5_LAM))[g * 64 + li]; lm[1] = ((const float2*)(st + S5_LAM))[g * 64 + 32 + li];
    const float* sin_ = (const float*)(p.ws + WS_SIN);
    float c0r[4][2], c0i[4][2];
#pragma unroll
    for (int k = 0; k < 4; ++k)
#pragma unroll
        for (int pt = 0; pt < 2; ++pt) {
            c0r[k][pt] = 0.f; c0i[k][pt] = 0.f;
            if (SAMPLE) { const size_t o = ((size_t)((l * 128 + bseq + k) * 32 + g)) * 64 + pt * 32 + li; c0r[k][pt] = p.in[2][o]; c0i[k][pt] = p.in[3][o]; }
        }
    float2 l32v[2]; float e_r[2][7], e_i[2][7], loc_r[2], loc_i[2];
    if (!SAMPLE) {
        const int sc = chunk >> 3;
#pragma unroll
        for (int pt = 0; pt < 2; ++pt) {
            l32v[pt] = ((const float2*)(st + S5_LAM32))[g * 64 + pt * 32 + li];
            const float* Eb = (const float*)(p.ws + WS_E) + ((size_t)((bseq * 32 + g) * 8)) * 128 + pt * 32 + li;
#pragma unroll
            for (int i = 0; i < 7; ++i) { e_r[pt][i] = 0.f; e_i[pt][i] = 0.f; if (i < sc) { e_r[pt][i] = Eb[i * 128]; e_i[pt][i] = Eb[i * 128 + 64]; } }
            const size_t o = ((size_t)((bseq * 32 + g) * 64 + chunk)) * 128 + pt * 32 + li;
            loc_r[pt] = sin_[o]; loc_i[pt] = sin_[o + 64];
        }
    }
    bf16x8 cf[4];
#pragma unroll
    for (int ks = 0; ks < 4; ++ks) cf[ks] = *(const bf16x8*)((const bf16_t*)(st + S5_CMT) + (size_t)(g * 16 + fr) * 128 + ks * 32 + 8 * fq);
    const float dv = p.in[15][l * 512 + g * 16 + fr];
    bf16_t uraw[2][4];
#pragma unroll
    for (int rt = 0; rt < 2; ++rt)
#pragma unroll
        for (int r = 0; r < 4; ++r) uraw[rt][r] = z[(size_t)(row0 + rt * 16 + 4 * fq + r) * INC + g * 16 + fr];
    f32x16 acc[4];
#pragma unroll
    for (int ct = 0; ct < 4; ++ct) {
        const bf16x8 bfr = *(const bf16x8*)((const bf16_t*)(st + S5_BMT) + (size_t)(g * 128 + ct * 32 + li) * 16 + 8 * half);
        f32x16 zz;
#pragma unroll
        for (int e = 0; e < 16; ++e) zz[e] = 0.f;
        acc[ct] = MFMA32(uf, bfr, zz);
    }
    MFMA_SETTLE();
    float sr[2] = {0.f, 0.f}, si[2] = {0.f, 0.f};
#pragma unroll
    for (int k = 0; k < 4; ++k) {
        if (SAMPLE) {
#pragma unroll
            for (int pt = 0; pt < 2; ++pt) { sr[pt] = c0r[k][pt]; si[pt] = c0i[k][pt]; }
        } else if (k == 0) {
            const int sc = chunk >> 3, jj = chunk & 7;
#pragma unroll
            for (int pt = 0; pt < 2; ++pt) {
                const float2 l32 = l32v[pt];
                const float2 l64 = make_float2(l32.x * l32.x - l32.y * l32.y, 2.0f * l32.x * l32.y);
                const float2 l128 = make_float2(l64.x * l64.x - l64.y * l64.y, 2.0f * l64.x * l64.y);
                const float2 l256 = make_float2(l128.x * l128.x - l128.y * l128.y, 2.0f * l128.x * l128.y);
                float Sr = 0.f, Si = 0.f;
#pragma unroll
                for (int i = 0; i < 7; ++i) { if (i < sc) { const float tr = l256.x * Sr - l256.y * Si + e_r[pt][i], ti = l256.x * Si + l256.y * Sr + e_i[pt][i]; Sr = tr; Si = ti; } }
                float rr = 1.0f, ri = 0.0f;
                if (jj & 1) { const float tr = rr * l32.x - ri * l32.y, ti = rr * l32.y + ri * l32.x; rr = tr; ri = ti; }
                if (jj & 2) { const float tr = rr * l64.x - ri * l64.y, ti = rr * l64.y + ri * l64.x; rr = tr; ri = ti; }
                if (jj & 4) { const float tr = rr * l128.x - ri * l128.y, ti = rr * l128.y + ri * l128.x; rr = tr; ri = ti; }
                sr[pt] = loc_r[pt] + (rr * Sr - ri * Si); si[pt] = loc_i[pt] + (rr * Si + ri * Sr);
            }
        }
#pragma unroll
        for (int hh = 0; hh < 2; ++hh) {
            const bool mine = (half == hh);
            float tr_[2] = {sr[0], sr[1]}, ti_[2] = {si[0], si[1]};
#pragma unroll
            for (int q = 0; q < 4; ++q)
#pragma unroll
                for (int pt = 0; pt < 2; ++pt) {
                    const float tr = lm[pt].x * tr_[pt] - lm[pt].y * ti_[pt] + acc[pt][4 * k + q];
                    const float ti = lm[pt].x * ti_[pt] + lm[pt].y * tr_[pt] + acc[2 + pt][4 * k + q];
                    tr_[pt] = tr; ti_[pt] = ti;
                    acc[pt][4 * k + q] = mine ? tr : acc[pt][4 * k + q]; acc[2 + pt][4 * k + q] = mine ? ti : acc[2 + pt][4 * k + q];
                }
#pragma unroll
            for (int pt = 0; pt < 2; ++pt) { sr[pt] = mine ? tr_[pt] : sr[pt]; si[pt] = mine ? ti_[pt] : si[pt]; }
            if (SAMPLE && hh == 1) {
                if (mine) {
#pragma unroll
                    for (int pt = 0; pt < 2; ++pt) { const size_t o = ((size_t)((l * 128 + bseq + k) * 32 + g)) * 64 + pt * 32 + li;
                        p.out[O_SRS + o] = sr[pt]; p.out[O_SIS + o] = si[pt]; }
                }
            }
#pragma unroll
            for (int pt = 0; pt < 2; ++pt) { const float orr = xor32(sr[pt], half), oii = xor32(si[pt], half); sr[pt] = mine ? sr[pt] : orr; si[pt] = mine ? si[pt] : oii; }
        }
    }
    if (!SAMPLE && chunk == 63 && half == 0) {
#pragma unroll
        for (int pt = 0; pt < 2; ++pt) { const size_t o = ((size_t)((l * 8 + bseq) * 32 + g)) * 64 + pt * 32 + li; p.out[O_SRP + o] = sr[pt]; p.out[O_SIP + o] = si[pt]; }
    }
#pragma unroll
    for (int ct = 0; ct < 4; ++ct)
#pragma unroll
        for (int r = 0; r < 16; ++r) { const int t = (r & 3) + 8 * (r >> 2) + 4 * half; Sl[t * 136 + ct * 32 + li] = f2bf(acc[ct][r]); }
    LDS_WAIT();
#pragma unroll
    for (int rt = 0; rt < 2; ++rt) {
        f32x4 y = {0.f, 0.f, 0.f, 0.f};
#pragma unroll
        for (int ks = 0; ks < 4; ++ks) { const bf16x8 a = *(const bf16x8*)(Sl + (rt * 16 + fr) * 136 + ks * 32 + 8 * fq); y = MFMA16(a, cf[ks], y); }
        MFMA_SETTLE();
#pragma unroll
        for (int r = 0; r < 4; ++r) { const int tok = row0 + rt * 16 + 4 * fq + r; const float uu = bf2f(uraw[rt][r]);
            ya[(size_t)tok * 512 + g * 16 + fr] = f2bf(gelu_tanh(y[r] + dv * uu)); }
    }
    LDS_WAIT();
}

__device__ __forceinline__ void s5_m1(const KPG& p, int l, int b, int g, int sc, int lane) {
    const bf16_t* z = (const bf16_t*)(p.ws + WS_Z);
    const unsigned char* st = p.ws + WS_S5T + (size_t)l * S5_SIZE;
    const int half = lane >> 5, li = lane & 31;
    bf16x8 bfr[4];
#pragma unroll
    for (int ct = 0; ct < 4; ++ct) bfr[ct] = *(const bf16x8*)((const bf16_t*)(st + S5_BMT) + (size_t)(g * 128 + ct * 32 + li) * 16 + 8 * half);
    float2 lm[2]; lm[0] = ((const float2*)(st + S5_LAM))[g * 64 + li]; lm[1] = ((const float2*)(st + S5_LAM))[g * 64 + 32 + li];
    float sr[2] = {0.f, 0.f}, si[2] = {0.f, 0.f};
    float* sin_ = (float*)(p.ws + WS_SIN);
    for (int j = 0; j < 8; ++j) {
        const int chunk = sc * 8 + j, row0 = b * 2048 + chunk * 32;
        const bf16x8 uf = *(const bf16x8*)(z + (size_t)(row0 + li) * INC + g * 16 + 8 * half);
        if (half == 0) {
#pragma unroll
            for (int pt = 0; pt < 2; ++pt) { const size_t o = ((size_t)((b * 32 + g) * 64 + chunk)) * 128 + pt * 32 + li; sin_[o] = sr[pt]; sin_[o + 64] = si[pt]; }
        }
        f32x16 acc[4];
#pragma unroll
        for (int ct = 0; ct < 4; ++ct) {
            f32x16 zz;
#pragma unroll
            for (int e = 0; e < 16; ++e) zz[e] = 0.f;
            acc[ct] = MFMA32(uf, bfr[ct], zz);
        }
        MFMA_SETTLE();
#pragma unroll
        for (int k = 0; k < 4; ++k)
#pragma unroll
            for (int hh = 0; hh < 2; ++hh) {
                const bool mine = (half == hh);
                float tr_[2] = {sr[0], sr[1]}, ti_[2] = {si[0], si[1]};
#pragma unroll
                for (int q = 0; q < 4; ++q)
#pragma unroll
                    for (int pt = 0; pt < 2; ++pt) {
                        const float tr = lm[pt].x * tr_[pt] - lm[pt].y * ti_[pt] + acc[pt][4 * k + q];
                        const float ti = lm[pt].x * ti_[pt] + lm[pt].y * tr_[pt] + acc[2 + pt][4 * k + q];
                        tr_[pt] = tr; ti_[pt] = ti;
                    }
#pragma unroll
                for (int pt = 0; pt < 2; ++pt) { sr[pt] = mine ? tr_[pt] : sr[pt]; si[pt] = mine ? ti_[pt] : si[pt]; }
#pragma unroll
                for (int pt = 0; pt < 2; ++pt) { const float orr = xor32(sr[pt], half), oii = xor32(si[pt], half); sr[pt] = mine ? sr[pt] : orr; si[pt] = mine ? si[pt] : oii; }
            }
    }
    if (half == 0) {
        float* E = (float*)(p.ws + WS_E) + ((size_t)((b * 32 + g) * 8 + sc)) * 128;
#pragma unroll
        for (int pt = 0; pt < 2; ++pt) { E[pt * 32 + li] = sr[pt]; E[64 + pt * 32 + li] = si[pt]; }
    }
}

__device__ __forceinline__ float log2_gamma(int h) { return __log2f(1.0f - exp2f(-5.0f - (float)h)); }

__device__ __forceinline__ void rot8(const u32x4& lo, const u32x4& hi, const float2* rp, float scale, float* olo, float* ohi) {
    const unsigned lw[4] = {lo.x, lo.y, lo.z, lo.w}, hw[4] = {hi.x, hi.y, hi.z, hi.w};
#pragma unroll
    for (int e = 0; e < 8; ++e) {
        const float x1 = (e & 1) ? bfhi(lw[e >> 1]) : bflo(lw[e >> 1]);
        const float x2 = (e & 1) ? bfhi(hw[e >> 1]) : bflo(hw[e >> 1]);
        const float2 cs = rp[e];
        olo[e] = (x1 * cs.x - x2 * cs.y) * scale; ohi[e] = (x1 * cs.y + x2 * cs.x) * scale;
    }
}

__device__ __forceinline__ void ret_m1_unit(const KPG& p, int l, int unit, unsigned char* lds, int wave, int lane) {
    const int tid = fresh_tid(), b = unit >> 4, h = (unit >> 2) & 3, s = unit & 3;
    const bf16_t* z = (const bf16_t*)(p.ws + WS_Z); const float2* rope = (const float2*)(p.ws + WS_ROPE);
    bf16_t* RTb = (bf16_t*)(p.ws + WS_RT);
    bf16_t* KT = (bf16_t*)lds; bf16_t* VT = KT + 128 * 136;
    const float lg2 = log2_gamma(h), cdec = exp2f(128.0f * lg2);
    const int fr = lane & 15, fq = lane >> 4;
    f32x4 R[4];
#pragma unroll
    for (int nt = 0; nt < 4; ++nt) R[nt] = (f32x4){0.f, 0.f, 0.f, 0.f};
    u32x4 kl[2], kh[2], vv[2]; f32x4 rq[2][4];
#define RM1_PREFETCH(ii) _Pragma("unroll") for (int tk = 0; tk < 2; ++tk) { const int task_ = tid + 512 * tk, j_ = task_ & 127, dg_ = task_ >> 7; const size_t zrow_ = (size_t)(b * 2048 + (ii) * 128 + j_) * INC; \
        const bf16_t* zr_ = z + zrow_ + ZK + h * 128 + dg_ * 8; kl[tk] = *(const u32x4*)zr_; kh[tk] = *(const u32x4*)(zr_ + 64); \
        const f32x4* rs_ = (const f32x4*)(rope + (size_t)((ii) * 128 + j_) * 64 + dg_ * 8); rq[tk][0] = rs_[0]; rq[tk][1] = rs_[1]; rq[tk][2] = rs_[2]; rq[tk][3] = rs_[3]; \
        vv[tk] = *(const u32x4*)(z + zrow_ + ZV + h * 256 + s * 64 + dg_ * 8); }
    RM1_PREFETCH(0)
    for (int i = 0; i < 16; ++i) {
        bf16_t* rt = RTb + ((size_t)((b * 4 + h) * 16 + i)) * 256 * 128;
#pragma unroll
        for (int nt = 0; nt < 4; ++nt) { u32x2 w; w.x = pk2(R[nt][0], R[nt][1]); w.y = pk2(R[nt][2], R[nt][3]);
            *(u32x2*)(rt + (size_t)(64 * s + 16 * nt + fr) * 128 + 16 * wave + 4 * fq) = w; }
#pragma unroll
        for (int tk = 0; tk < 2; ++tk) {
            const int task = tid + 512 * tk, j = task & 127, dg = task >> 7;
            const float sc_ = 0.08838834764831845f * exp2f((float)(127 - j) * lg2);
            const unsigned lw[4] = {kl[tk].x, kl[tk].y, kl[tk].z, kl[tk].w}, hw[4] = {kh[tk].x, kh[tk].y, kh[tk].z, kh[tk].w}, vw[4] = {vv[tk].x, vv[tk].y, vv[tk].z, vv[tk].w};
#pragma unroll
            for (int e = 0; e < 8; ++e) {
                const float x1 = (e & 1) ? bfhi(lw[e >> 1]) : bflo(lw[e >> 1]), x2 = (e & 1) ? bfhi(hw[e >> 1]) : bflo(hw[e >> 1]);
                const float cs_ = rq[tk][e >> 1][(e & 1) * 2], sn_ = rq[tk][e >> 1][(e & 1) * 2 + 1];
                KT[(dg * 8 + e) * 136 + j] = f2bf((x1 * cs_ - x2 * sn_) * sc_); KT[(64 + dg * 8 + e) * 136 + j] = f2bf((x1 * sn_ + x2 * cs_) * sc_);
                VT[(dg * 8 + e) * 136 + j] = (bf16_t)((e & 1) ? (vw[e >> 1] >> 16) : (vw[e >> 1] & 0xffffu));
            }
        }
        if (i + 1 < 16) { RM1_PREFETCH(i + 1) }
        __syncthreads();
#pragma unroll
        for (int nt = 0; nt < 4; ++nt) R[nt] = R[nt] * cdec;
#pragma unroll
        for (int ks = 0; ks < 4; ++ks) {
            const bf16x8 a = *(const bf16x8*)(KT + (16 * wave + fr) * 136 + ks * 32 + 8 * fq);
#pragma unroll
            for (int nt = 0; nt < 4; ++nt) { const bf16x8 bb = *(const bf16x8*)(VT + (16 * nt + fr) * 136 + ks * 32 + 8 * fq); R[nt] = MFMA16(a, bb, R[nt]); }
        }
        MFMA_SETTLE();
        __syncthreads();
    }
#undef RM1_PREFETCH
    float* ro = p.out + O_RP + ((size_t)((l * 8 + b) * 4 + h)) * 128 * 256;
#pragma unroll
    for (int nt = 0; nt < 4; ++nt)
#pragma unroll
        for (int r = 0; r < 4; ++r) ro[(size_t)(16 * wave + 4 * fq + r) * 256 + 64 * s + 16 * nt + fr] = R[nt][r];
}

__device__ __forceinline__ void ret_m2_unit(const KPG& p, int l, int unit, unsigned char* lds, int wave, int lane) {
    const int tid = fresh_tid(), b = unit >> 6, h = (unit >> 4) & 3, i = unit & 15;
    const bf16_t* z = (const bf16_t*)(p.ws + WS_Z); const float2* rope = (const float2*)(p.ws + WS_ROPE);
    const bf16_t* RTb = (const bf16_t*)(p.ws + WS_RT); bf16_t* ob = (bf16_t*)(p.ws + WS_O);
    bf16_t* Qs = (bf16_t*)lds; bf16_t* Ks = Qs + 128 * 136; bf16_t* BIG = Ks + 128 * 136;
    const float lg2 = log2_gamma(h);
    const int fr = lane & 15, fq = lane >> 4, row0 = b * 2048 + i * 128;
#pragma unroll
    for (int tk = 0; tk < 2; ++tk) {
        const int task = tid + 512 * tk, dg = task & 7, j = task >> 3;
        const bf16_t* zr = z + (size_t)(row0 + j) * INC + h * 128 + dg * 8;
        const float2* rp = rope + (size_t)(i * 128 + j) * 64 + dg * 8;
        float olo[8], ohi[8];
        { const u32x4 lo = *(const u32x4*)(zr + ZQ), hi = *(const u32x4*)(zr + ZQ + 64); rot8(lo, hi, rp, 1.0f, olo, ohi);
          u32x4 w; w.x = pk2(olo[0], olo[1]); w.y = pk2(olo[2], olo[3]); w.z = pk2(olo[4], olo[5]); w.w = pk2(olo[6], olo[7]); *(u32x4*)(Qs + j * 136 + dg * 8) = w;
          w.x = pk2(ohi[0], ohi[1]); w.y = pk2(ohi[2], ohi[3]); w.z = pk2(ohi[4], ohi[5]); w.w = pk2(ohi[6], ohi[7]); *(u32x4*)(Qs + j * 136 + 64 + dg * 8) = w; }
        { const u32x4 lo = *(const u32x4*)(zr + ZK), hi = *(const u32x4*)(zr + ZK + 64); rot8(lo, hi, rp, 0.08838834764831845f, olo, ohi);
          u32x4 w; w.x = pk2(olo[0], olo[1]); w.y = pk2(olo[2], olo[3]); w.z = pk2(olo[4], olo[5]); w.w = pk2(olo[6], olo[7]); *(u32x4*)(Ks + j * 136 + dg * 8) = w;
          w.x = pk2(ohi[0], ohi[1]); w.y = pk2(ohi[2], ohi[3]); w.z = pk2(ohi[4], ohi[5]); w.w = pk2(ohi[6], ohi[7]); *(u32x4*)(Ks + j * 136 + 64 + dg * 8) = w; }
    }
    {
        const bf16_t* src = RTb + ((size_t)((b * 4 + h) * 16 + i)) * 256 * 128;
#pragma unroll
        for (int k = 0; k < 8; ++k) { const int idx = tid + 512 * k, dv = idx >> 4, c16 = idx & 15; *(u32x4*)(BIG + dv * 136 + c16 * 8) = *(const u32x4*)(src + (size_t)dv * 128 + c16 * 8); }
    }
    __syncthreads();
    bf16x8 Aq[4];
#pragma unroll
    for (int ks = 0; ks < 4; ++ks) Aq[ks] = *(const bf16x8*)(Qs + (16 * wave + fr) * 136 + ks * 32 + 8 * fq);
    f32x4 S[8];
#pragma unroll
    for (int jt = 0; jt < 8; ++jt) {
        S[jt] = (f32x4){0.f, 0.f, 0.f, 0.f};
        if (jt <= wave) {
#pragma unroll
            for (int ks = 0; ks < 4; ++ks) { const bf16x8 bb = *(const bf16x8*)(Ks + (16 * jt + fr) * 136 + ks * 32 + 8 * fq); S[jt] = MFMA16(Aq[ks], bb, S[jt]); }
        }
        __builtin_amdgcn_sched_barrier(0);
    }
    f32x4 O[16];
#pragma unroll
    for (int nt = 0; nt < 16; ++nt) {
        O[nt] = (f32x4){0.f, 0.f, 0.f, 0.f};
#pragma unroll
        for (int ks = 0; ks < 4; ++ks) { const bf16x8 bb = *(const bf16x8*)(BIG + (16 * nt + fr) * 136 + ks * 32 + 8 * fq); O[nt] = MFMA16(Aq[ks], bb, O[nt]); }
        if ((nt & 1) == 1) __builtin_amdgcn_sched_barrier(0);
    }
    MFMA_SETTLE();
    {
        float inn[4];
#pragma unroll
        for (int r = 0; r < 4; ++r) inn[r] = exp2f((float)(16 * wave + 4 * fq + r + 1) * lg2);
#pragma unroll
        for (int nt = 0; nt < 16; ++nt)
#pragma unroll
            for (int r = 0; r < 4; ++r) O[nt][r] *= inn[r];
    }
    __syncthreads();
#pragma unroll
    for (int jt = 0; jt < 8; ++jt)
#pragma unroll
        for (int r = 0; r < 4; ++r) {
            const int ii = 16 * wave + 4 * fq + r, jj = 16 * jt + fr;
            const float v = (jt <= wave && ii >= jj) ? S[jt][r] * exp2f((float)(ii - jj) * lg2) : 0.0f;
            Ks[ii * 136 + jj] = f2bf(v);
        }
#pragma unroll
    for (int k = 0; k < 8; ++k) {
        const int task = tid + 512 * k, j = task & 127, vg = task >> 7;
        const u32x4 v = *(const u32x4*)(z + (size_t)(row0 + j) * INC + ZV + h * 256 + vg * 8);
        const unsigned vw[4] = {v.x, v.y, v.z, v.w};
#pragma unroll
        for (int e = 0; e < 8; ++e) BIG[(vg * 8 + e) * 136 + j] = (bf16_t)((e & 1) ? (vw[e >> 1] >> 16) : (vw[e >> 1] & 0xffffu));
    }
    __syncthreads();
#pragma unroll
    for (int ks = 0; ks < 4; ++ks) {
        if (ks <= (wave >> 1)) {
            const bf16x8 a = *(const bf16x8*)(Ks + (16 * wave + fr) * 136 + ks * 32 + 8 * fq);
#pragma unroll
            for (int nt = 0; nt < 16; ++nt) { const bf16x8 bb = *(const bf16x8*)(BIG + (16 * nt + fr) * 136 + ks * 32 + 8 * fq); O[nt] = MFMA16(a, bb, O[nt]); if ((nt & 1) == 1) __builtin_amdgcn_sched_barrier(0); }
        }
    }
    MFMA_SETTLE();
#pragma unroll
    for (int r = 0; r < 4; ++r) {
        float ss = 0.f;
#pragma unroll
        for (int nt = 0; nt < 16; ++nt) ss += O[nt][r] * O[nt][r];
        ss = row_sum16(ss);
        const float rstd = rsqrtf(ss * (1.0f / 256.0f) + EPSF);
        const size_t tok = (size_t)(row0 + 16 * wave + 4 * fq + r);
#pragma unroll
        for (int nt = 0; nt < 16; ++nt) { const int col = h * 256 + 16 * nt + fr; const float gg = bf2f(z[tok * INC + ZGR + col]);
            ob[tok * 1024 + col] = f2bf(O[nt][r] * rstd * siluf_(gg)); }
    }
    __syncthreads();
}

__device__ __forceinline__ void ret_sample_unit(const KPG& p, int l, int unit, unsigned char* lds, int wave, int lane) {
    const int tid = fresh_tid(), b = unit >> 2, h = unit & 3;
    const bf16_t* z = (const bf16_t*)(p.ws + WS_Z); const float2* rope = (const float2*)(p.ws + WS_ROPE); bf16_t* ob = (bf16_t*)(p.ws + WS_O);
    float* qT = (float*)lds; float* kT = qT + 1024; float* ktT = kT + 1024; float* vs = ktT + 1024; float* sc = vs + 2048; float* opart = sc + 64;
    const float lg2 = log2_gamma(h);
    const int row0 = MP + b * 8;
    if (tid < 64) {
        const int i = tid >> 3, dg = tid & 7;
        const bf16_t* zr = z + (size_t)(row0 + i) * INC + h * 128 + dg * 8;
        const float2* rp = rope + (size_t)(2048 + i) * 64 + dg * 8;
        float olo[8], ohi[8];
        { const u32x4 lo = *(const u32x4*)(zr + ZQ), hi = *(const u32x4*)(zr + ZQ + 64); rot8(lo, hi, rp, 1.0f, olo, ohi);
#pragma unroll
          for (int e = 0; e < 8; ++e) { qT[(dg * 8 + e) * 8 + i] = olo[e]; qT[(64 + dg * 8 + e) * 8 + i] = ohi[e]; } }
        { const u32x4 lo = *(const u32x4*)(zr + ZK), hi = *(const u32x4*)(zr + ZK + 64); rot8(lo, hi, rp, 0.08838834764831845f, olo, ohi);
          const float tl = exp2f((float)(7 - i) * lg2);
#pragma unroll
          for (int e = 0; e < 8; ++e) { kT[(dg * 8 + e) * 8 + i] = olo[e]; kT[(64 + dg * 8 + e) * 8 + i] = ohi[e]; ktT[(dg * 8 + e) * 8 + i] = olo[e] * tl; ktT[(64 + dg * 8 + e) * 8 + i] = ohi[e] * tl; } }
    }
    if (tid < 256) {
#pragma unroll
        for (int i = 0; i < 8; ++i) vs[i * 256 + tid] = bf2f(z[(size_t)(row0 + i) * INC + ZV + h * 256 + tid]);
    }
    __syncthreads();
    if (tid < 64) {
        const int i = tid >> 3, j = tid & 7; float d = 0.f;
        for (int dd = 0; dd < 128; ++dd) d += qT[dd * 8 + i] * kT[dd * 8 + j];
        sc[tid] = (j <= i) ? d * exp2f((float)(i - j) * lg2) : 0.f;
    }
    {
        const int dv4 = (tid & 63) * 4;
        f32x4 vv[8], ao[8];
#pragma unroll
        for (int j = 0; j < 8; ++j) { vv[j] = *(const f32x4*)(vs + j * 256 + dv4); ao[j] = (f32x4){0.f, 0.f, 0.f, 0.f}; }
        const size_t so = ((size_t)((l * 128 + b) * 4 + h)) * 128 * 256;
        const float* r0 = p.in[4] + so; float* rn = p.out + O_RS + so;
        const float cdec = exp2f(8.0f * lg2);
#pragma unroll 16
        for (int dd = 0; dd < 16; ++dd) {
            const int d = wave * 16 + dd;
            const f32x4 r = *(const f32x4*)(r0 + (size_t)d * 256 + dv4);
            const f32x4 qa = *(const f32x4*)(qT + d * 8), qb = *(const f32x4*)(qT + d * 8 + 4), ka = *(const f32x4*)(ktT + d * 8), kb = *(const f32x4*)(ktT + d * 8 + 4);
            ao[0] += qa[0] * r; ao[1] += qa[1] * r; ao[2] += qa[2] * r; ao[3] += qa[3] * r; ao[4] += qb[0] * r; ao[5] += qb[1] * r; ao[6] += qb[2] * r; ao[7] += qb[3] * r;
            f32x4 nr = r * cdec;
            nr += ka[0] * vv[0]; nr += ka[1] * vv[1]; nr += ka[2] * vv[2]; nr += ka[3] * vv[3]; nr += kb[0] * vv[4]; nr += kb[1] * vv[5]; nr += kb[2] * vv[6]; nr += kb[3] * vv[7];
            *(f32x4*)(rn + (size_t)d * 256 + dv4) = nr;
        }
#pragma unroll
        for (int i = 0; i < 8; ++i) *(f32x4*)(opart + (wave * 8 + i) * 256 + dv4) = ao[i];
    }
    __syncthreads();
    {
        const int i = wave, dv4 = (tid & 63) * 4;
        f32x4 a = (f32x4){0.f, 0.f, 0.f, 0.f};
#pragma unroll
        for (int w = 0; w < 8; ++w) a += *(const f32x4*)(opart + (w * 8 + i) * 256 + dv4);
        a = a * exp2f((float)(i + 1) * lg2);
#pragma unroll
        for (int j = 0; j < 8; ++j) { if (j <= i) a += sc[i * 8 + j] * *(const f32x4*)(vs + j * 256 + dv4); }
        const float ss = wave_sum(a[0] * a[0] + a[1] * a[1] + a[2] * a[2] + a[3] * a[3]);
        const float rstd = rsqrtf(ss * (1.0f / 256.0f) + EPSF);
        const size_t tok = (size_t)(row0 + i);
        const u32x2 gw = *(const u32x2*)(z + tok * INC + ZGR + h * 256 + dv4);
        u32x2 w; w.x = pk2(a[0] * rstd * siluf_(bflo(gw.x)), a[1] * rstd * siluf_(bfhi(gw.x))); w.y = pk2(a[2] * rstd * siluf_(bflo(gw.y)), a[3] * rstd * siluf_(bfhi(gw.y)));
        *(u32x2*)(ob + tok * 1024 + h * 256 + dv4) = w;
    }
    __syncthreads();
}

__device__ __forceinline__ void phase_convact(const KPG& p, int l) {
    const bf16_t* up = (const bf16_t*)(p.ws + WS_Z); bf16_t* act = (bf16_t*)(p.ws + WS_ACT);
    const float* cw = p.in[22] + (size_t)l * 3 * INC; const float* cb = p.in[23] + (size_t)l * INC;
    const int NT = (512 + 128) * 352;
    for (int task = fresh_bid() * 512 + fresh_tid(); task < NT; task += gridDim.x * 512) {
        const int cgp = task % 352, rc = task / 352, j0 = cgp * 8;
        int row0, nrows; bool sample = rc >= 512;
        if (!sample) { row0 = rc * 32; nrows = 32; } else { row0 = MP + (rc - 512) * 8; nrows = 8; }
        float w0v[8], w1v[8], w2v[8], bv[8], w0g[8], w1g[8], w2g[8], bg[8];
#pragma unroll
        for (int e = 0; e < 8; ++e) { w0v[e] = cw[j0 + e]; w1v[e] = cw[INC + j0 + e]; w2v[e] = cw[2 * INC + j0 + e]; bv[e] = cb[j0 + e];
            w0g[e] = cw[DFF + j0 + e]; w1g[e] = cw[INC + DFF + j0 + e]; w2g[e] = cw[2 * INC + DFF + j0 + e]; bg[e] = cb[DFF + j0 + e]; }
        float p2v[8], p1v[8], p2g[8], p1g[8];
        if (sample) {
            const float* sc = p.in[5] + ((size_t)(l * 128 + (rc - 512)) * 2) * INC;
#pragma unroll
            for (int e = 0; e < 8; ++e) { p2v[e] = sc[j0 + e]; p1v[e] = sc[INC + j0 + e]; p2g[e] = sc[DFF + j0 + e]; p1g[e] = sc[INC + DFF + j0 + e]; }
        } else if ((row0 & 2047) == 0) {
#pragma unroll
            for (int e = 0; e < 8; ++e) { p2v[e] = 0.f; p1v[e] = 0.f; p2g[e] = 0.f; p1g[e] = 0.f; }
        } else {
            const u32x4 a = *(const u32x4*)(up + (size_t)(row0 - 2) * INC + j0), b = *(const u32x4*)(up + (size_t)(row0 - 1) * INC + j0);
            const u32x4 c = *(const u32x4*)(up + (size_t)(row0 - 2) * INC + DFF + j0), d = *(const u32x4*)(up + (size_t)(row0 - 1) * INC + DFF + j0);
            const unsigned aw[4] = {a.x, a.y, a.z, a.w}, bw[4] = {b.x, b.y, b.z, b.w}, cw_[4] = {c.x, c.y, c.z, c.w}, dw[4] = {d.x, d.y, d.z, d.w};
#pragma unroll
            for (int e = 0; e < 8; ++e) { p2v[e] = (e & 1) ? bfhi(aw[e >> 1]) : bflo(aw[e >> 1]); p1v[e] = (e & 1) ? bfhi(bw[e >> 1]) : bflo(bw[e >> 1]);
                p2g[e] = (e & 1) ? bfhi(cw_[e >> 1]) : bflo(cw_[e >> 1]); p1g[e] = (e & 1) ? bfhi(dw[e >> 1]) : bflo(dw[e >> 1]); }
        }
        for (int r = 0; r < nrows; ++r) {
            const u32x4 a = *(const u32x4*)(up + (size_t)(row0 + r) * INC + j0), c = *(const u32x4*)(up + (size_t)(row0 + r) * INC + DFF + j0);
            const unsigned aw[4] = {a.x, a.y, a.z, a.w}, cw_[4] = {c.x, c.y, c.z, c.w};
            float o[8];
#pragma unroll
            for (int e = 0; e < 8; ++e) {
                const float cv = (e & 1) ? bfhi(aw[e >> 1]) : bflo(aw[e >> 1]), cg_ = (e & 1) ? bfhi(cw_[e >> 1]) : bflo(cw_[e >> 1]);
                const float val = bv[e] + w0v[e] * p2v[e] + w1v[e] * p1v[e] + w2v[e] * cv;
                const float gat = bg[e] + w0g[e] * p2g[e] + w1g[e] * p1g[e] + w2g[e] * cg_;
                o[e] = siluf_(gat) * val;
                p2v[e] = p1v[e]; p1v[e] = cv; p2g[e] = p1g[e]; p1g[e] = cg_;
            }
            u32x4 w; w.x = pk2(o[0], o[1]); w.y = pk2(o[2], o[3]); w.z = pk2(o[4], o[5]); w.w = pk2(o[6], o[7]);
            *(u32x4*)(act + (size_t)(row0 + r) * DFF + j0) = w;
        }
    }
}

#endif

__global__ void __launch_bounds__(512, 2) fwd_kernel(KP p) {
#if defined(__HIP_DEVICE_COMPILE__)
    extern __shared__ __attribute__((aligned(16))) unsigned char lds[];
    cg::grid_group grid = cg::this_grid();
    volatile LAS unsigned* barw = (volatile LAS unsigned*)((LAS unsigned char*)lds + LDS_BARW);
    if (threadIdx.x < 4) barw[threadIdx.x] = 0u;
    if (threadIdx.x == 0) {
        LAS unsigned long long* t = (LAS unsigned long long*)((LAS unsigned char*)lds + LDS_TAB);
#pragma unroll
        for (int i = 0; i < 26; ++i) t[i] = (unsigned long long)p.in[i];
        t[26] = (unsigned long long)p.out; t[27] = (unsigned long long)p.ws;
    }
    __syncthreads();
    (void)xcd_barrier_post((unsigned*)(p.ws + WS_CTL), barw);
#if USE_CG
#define GSYNC() grid.sync()
#else
#define GSYNC() do { XcdBarrier b_; b_.bar = (unsigned*)((GAS unsigned char*)ld_tab(lds, 27) + WS_CTL); b_.x = xb_xcc_id(); b_.st = (volatile LAS unsigned*)((LAS unsigned char*)lds + LDS_BARW); xcd_barrier(b_); } while (0)
#endif
#define PH_BEGIN const KPG q = load_kp(lds); const int tid_ = fresh_tid(), lane = tid_ & 63, wave = __builtin_amdgcn_readfirstlane(tid_ >> 6); (void)lane; (void)wave; \
                 const int G = gridDim.x, c = fresh_bid(); (void)G; (void)c; LAS unsigned char* glds = (LAS unsigned char*)lds; (void)glds;

    for (int l = 0; l < DEPTH; ++l) {
        {
            PH_BEGIN
#ifndef NO_PRO
            phase_prologue(q, l, lds, wave, lane);
#endif
            phase_rmsnorm(q, l, wave, lane);
        }
        if (l == 0) grid.sync();
        GSYNC();
        {
            PH_BEGIN
            unsigned char* wl = q.ws + WS_WT + (size_t)l * LW_SIZE;
            pg8::Sched S{(const char*)(q.ws + WS_H), (const char*)(wl + LW_IN), nullptr, nullptr, 16, 0, 1024, MT / 256, INC / 256, G, c};
            pg8::EpiStoreBf16 E{(bf16_t*)(q.ws + WS_Z), INC};
#if !defined(NO_GEMM) && (!defined(ONLY_GEMM) || ONLY_GEMM == 0)
            pg8::gemm_phase(glds, S, E);
#endif
        }
        GSYNC();
        {
            PH_BEGIN
#ifndef NO_RM1
            for (int u = c; u < 128; u += G) ret_m1_unit(q, l, u, lds, wave, lane);
#endif
#ifndef NO_RS
            for (int u = c - 128; u >= 0 && u < 512; u += 128) ret_sample_unit(q, l, u, lds, wave, lane);
#endif
        }
        {
            PH_BEGIN
#ifndef NO_SM1
            for (int u = c - 128; u >= 0 && u < 256; u += 128) { const int wt = u * 8 + wave; s5_m1(q, l, wt >> 8, (wt >> 3) & 31, wt & 7, lane); }
#endif
        }
        {
            PH_BEGIN
#ifndef NO_SS
            for (int u = c - 128; u >= 0 && u < 128; u += G) { const int g = (u >> 4) * 4 + (wave & 3), bq = (u & 15) * 2 + (wave >> 2);
                s5_tile<true>(q, l, g, MP + bq * 32, bq * 4, 0, (bf16_t*)(lds + wave * 8704), lane); }
#endif
        }
        GSYNC();
        {
            PH_BEGIN
#ifndef NO_RM2
            for (int u = c; u < 512; u += G) ret_m2_unit(q, l, u, lds, wave, lane);
#endif
        }
        {
            PH_BEGIN
#ifndef NO_SM2
            for (int uu = c; uu < 2048; uu += G) { const int chunk = (uu & 31) * 2 + (wave >> 2), g = ((uu >> 5) & 7) * 4 + (wave & 3), b = uu >> 8;
                s5_tile<false>(q, l, g, b * 2048 + chunk * 32, b, chunk, (bf16_t*)(lds + wave * 8704), lane); }
#endif
        }
        GSYNC();
        {
            PH_BEGIN
            unsigned char* wl = q.ws + WS_WT + (size_t)l * LW_SIZE;
            pg8::Sched S{(const char*)(q.ws + WS_YA), (const char*)(wl + LW_GLU), nullptr, nullptr, 8, 0, 512, MT / 256, 2, G, c};
            pg8::EpiGlu E{(const bf16_t*)(q.ws + WS_YA), (bf16_t*)(q.ws + WS_YA2)};
#if !defined(NO_GEMM) && (!defined(ONLY_GEMM) || ONLY_GEMM == 1)
            pg8::gemm_phase(glds, S, E);
#endif
        }
        GSYNC();
        {
            PH_BEGIN
            unsigned char* wl = q.ws + WS_WT + (size_t)l * LW_SIZE;
            pg8::Sched S{(const char*)(q.ws + WS_YA2), (const char*)(wl + LW_SSM), (const char*)(q.ws + WS_O), (const char*)(wl + LW_RET), 8, 16, 1024, MT / 256, 4, G, c};
            pg8::EpiMix E{(const bf16_t*)(q.ws + WS_Z), (bf16_t*)(q.ws + WS_MIX)};
#if !defined(NO_GEMM) && (!defined(ONLY_GEMM) || ONLY_GEMM == 2)
            pg8::gemm_phase(glds, S, E);
#endif
        }
        GSYNC();
        {
            PH_BEGIN
            unsigned char* wl = q.ws + WS_WT + (size_t)l * LW_SIZE;
            pg8::Sched S{(const char*)(q.ws + WS_MIX), (const char*)(wl + LW_O), nullptr, nullptr, 16, 0, 1024, MT / 256, 4, G, c};
            pg8::EpiRes E{l == 0 ? q.in[0] : (const float*)(q.ws + WS_X), l == 0 ? q.in[1] : (const float*)(q.ws + WS_X) + (size_t)MP * 1024, (float*)(q.ws + WS_X)};
#if !defined(NO_GEMM) && (!defined(ONLY_GEMM) || ONLY_GEMM == 3)
            pg8::gemm_phase(glds, S, E);
#endif
        }
        GSYNC();
        { PH_BEGIN phase_rmsnorm(q, 1, wave, lane); }
        GSYNC();
        {
            PH_BEGIN
            unsigned char* wl = q.ws + WS_WT + (size_t)l * LW_SIZE;
            pg8::Sched S{(const char*)(q.ws + WS_H), (const char*)(wl + LW_UP), nullptr, nullptr, 16, 0, 1024, MT / 256, INC / 256, G, c};
            pg8::EpiUp E{(bf16_t*)(q.ws + WS_Z), q.out + O_CP + (size_t)l * 8 * 2 * INC, q.out + O_CS + (size_t)l * 128 * 2 * INC};
#if !defined(NO_GEMM) && (!defined(ONLY_GEMM) || ONLY_GEMM == 4)
            pg8::gemm_phase(glds, S, E);
#endif
        }
        GSYNC();
        {
            PH_BEGIN
#ifndef NO_CONV
            phase_convact(q, l);
#endif
        }
        GSYNC();
        {
            PH_BEGIN
            unsigned char* wl = q.ws + WS_WT + (size_t)l * LW_SIZE;
            pg8::Sched S{(const char*)(q.ws + WS_ACT), (const char*)(wl + LW_DOWN), nullptr, nullptr, 44, 0, DFF, MT / 256, 4, G, c};
            pg8::EpiRes E{(const float*)(q.ws + WS_X), (const float*)(q.ws + WS_X) + (size_t)MP * 1024, (float*)(q.ws + WS_X)};
#if !defined(NO_GEMM) && (!defined(ONLY_GEMM) || ONLY_GEMM == 5)
            pg8::gemm_phase(glds, S, E);
#endif
        }
        GSYNC();
    }
    {
        PH_BEGIN
        const float* xb = (const float*)(q.ws + WS_X); const float* gf = q.in[25];
        for (int row = c * 8 + wave; row < MT; row += G * 8) {
            const f32x4* xr = (const f32x4*)(xb + (size_t)row * 1024) + lane; const f32x4* gr = (const f32x4*)gf + lane;
            f32x4 v[4]; float s = 0.f;
#pragma unroll
            for (int j = 0; j < 4; ++j) { v[j] = xr[64 * j]; s += (v[j].x * v[j].x + v[j].y * v[j].y) + (v[j].z * v[j].z + v[j].w * v[j].w); }
            const float rstd = rsqrtf(wave_sum(s) * (1.f / 1024.f) + EPSF);
            f32x4* o = (f32x4*)(q.out + O_YP + (size_t)row * 1024) + lane;
#pragma unroll
            for (int j = 0; j < 4; ++j) o[64 * j] = v[j] * rstd * gr[64 * j];
        }
    }
#endif
}

extern "C" void kernel_launch(void* const* d_in, const int* in_sizes, int n_in, void* d_out, int out_size, void* d_ws, size_t ws_size, hipStream_t stream) {
    static int grid = 0;
    if (grid == 0) {
        if (n_in != 26 || ws_size < WS_END) { fprintf(stderr, "kernel_launch: unexpected shapes (n_in %d, ws %zu < %zu)\n", n_in, ws_size, (size_t)WS_END); grid = -1; return; }
        int dev = 0, cus = 0, per_cu = 0;
        hipGetDevice(&dev);
        hipDeviceGetAttribute(&cus, hipDeviceAttributeMultiprocessorCount, dev);
        if (hipFuncSetAttribute((const void*)fwd_kernel, hipFuncAttributeMaxDynamicSharedMemorySize, LDS_BYTES) != hipSuccess) { fprintf(stderr, "kernel_launch: hipFuncSetAttribute failed\n"); grid = -1; return; }
        hipOccupancyMaxActiveBlocksPerMultiprocessor(&per_cu, (const void*)fwd_kernel, 512, LDS_BYTES);
        (void)hipGetLastError();
        if (per_cu < 1) per_cu = 1;
        grid = cus * 1;
    }
    if (grid < 0) return;
    hipMemsetAsync((char*)d_ws + WS_CTL, 0, 65536, stream);
    KP p{};
    for (int i = 0; i < 26; ++i) p.in[i] = (const float*)d_in[i];
    p.out = (float*)d_out; p.ws = (unsigned char*)d_ws;
    void* args[] = {&p};
    hipError_t e = hipLaunchCooperativeKernel((const void*)fwd_kernel, dim3(grid), dim3(512), args, LDS_BYTES, stream);
    if (e != hipSuccess) fprintf(stderr, "cooperative launch failed: %s (grid %d)\n", hipGetErrorString(e), grid);
}
```

```cpp
#include <hip/hip_runtime.h>
#include <hip/hip_cooperative_groups.h>
#include <cstdio>
#include <cstdint>
namespace cg = cooperative_groups;

#ifndef USE_CG
#define USE_CG 0
#endif

#define LAS __attribute__((address_space(3)))
typedef unsigned short bf16_t;
typedef short bf16x8 __attribute__((ext_vector_type(8)));
typedef float f32x4 __attribute__((ext_vector_type(4)));
typedef float f32x16 __attribute__((ext_vector_type(16)));
typedef unsigned u32x4 __attribute__((ext_vector_type(4)));
typedef unsigned u32x2 __attribute__((ext_vector_type(2)));

constexpr int DM = 1024, MP = 16384, MS = 1024, MT = MP + MS, DEPTH = 4;
constexpr int INC = 5632, DFF = 2816, DSSM = 512;
constexpr int ZQ = 512, ZK = 1024, ZV = 1536, ZGR = 2560, ZGA = 3584, ZGB = 4608;
constexpr float EPSF = 1e-6f;
constexpr size_t O_YP = 0, O_YS = 16777216, O_SRP = 17825792, O_SIP = 17891328, O_RP = 17956864, O_CP = 22151168,
                 O_SRS = 22511616, O_SIS = 23560192, O_RS = 24608768, O_CS = 91717632;
constexpr size_t WS_CTL = 0;
constexpr size_t WS_WT = 65536;
constexpr size_t LW_IN = 0, LW_UP = 11534336, LW_DOWN = LW_UP + 11534336, LW_O = LW_DOWN + 5767168, LW_RET = LW_O + 2097152,
                 LW_SSM = LW_RET + 2097152, LW_GLU = LW_SSM + 2097152, LW_SIZE = LW_GLU + 524288;
constexpr size_t WS_S5T = WS_WT + 4 * LW_SIZE;
constexpr size_t S5_MB = 0, S5_BMT = 4194304, S5_CMT = S5_BMT + 131072, S5_LAM = S5_CMT + 131072, S5_LAM32 = S5_LAM + 16384, S5_SIZE = S5_LAM32 + 16384;
constexpr size_t WS_ROPE = WS_S5T + 4 * S5_SIZE;
constexpr size_t WS_X = WS_ROPE + 1052672;
constexpr size_t WS_H = WS_X + (size_t)MT * 1024 * 4;
constexpr size_t WS_Z = WS_H + (size_t)MT * 1024 * 2;
constexpr size_t WS_YA = WS_Z + (size_t)MT * INC * 2;
constexpr size_t WS_YA2 = WS_YA + (size_t)MT * 512 * 2;
constexpr size_t WS_O = WS_YA2 + (size_t)MT * 1024 * 2;
constexpr size_t WS_MIX = WS_O + (size_t)MT * 1024 * 2;
constexpr size_t WS_ACT = WS_MIX + (size_t)MT * 1024 * 2;
constexpr size_t WS_SIN = WS_ACT + (size_t)MT * DFF * 2;
constexpr size_t WS_RT = WS_SIN + (size_t)8 * 32 * 64 * 128 * 4;
constexpr size_t WS_E = WS_RT + (size_t)32 * 16 * 256 * 128 * 2;
constexpr size_t WS_END = WS_E + (size_t)8 * 32 * 8 * 128 * 4;

constexpr int LDS_BYTES = 147456;
constexpr int LDS_BARW = LDS_BYTES - 16;

#define GAS __attribute__((address_space(1)))
struct KP { const float* in[26]; float* out; unsigned char* ws; };
#if defined(__HIP_DEVICE_COMPILE__)
struct KPG { const GAS float* in[26]; GAS float* out; GAS unsigned char* ws; };
constexpr int LDS_TAB = LDS_BYTES - 16 - 256;
__device__ __forceinline__ unsigned long long ld_tab(const unsigned char* lds, int i) {
    unsigned off = (unsigned)(LDS_TAB + 8 * i); asm volatile("" : "+v"(off));
    const unsigned long long v = *(const LAS unsigned long long*)((const LAS unsigned char*)lds + off);
    const unsigned lo = __builtin_amdgcn_readfirstlane((unsigned)v), hi = __builtin_amdgcn_readfirstlane((unsigned)(v >> 32));
    return ((unsigned long long)hi << 32) | lo;
}
__device__ __forceinline__ KPG load_kp(const unsigned char* lds) {
    KPG q; asm volatile("" ::: "memory");
#pragma unroll
    for (int i = 0; i < 26; ++i) q.in[i] = (const GAS float*)ld_tab(lds, i);
    q.out = (GAS float*)ld_tab(lds, 26); q.ws = (GAS unsigned char*)ld_tab(lds, 27);
    return q;
}
__device__ __forceinline__ int fresh_tid() { int t = threadIdx.x; asm volatile("" : "+v"(t)); return t; }
__device__ __forceinline__ int fresh_bid() { int b = blockIdx.x; asm volatile("" : "+s"(b)); return b; }

__device__ __forceinline__ float bf2f(bf16_t b) { return __uint_as_float(((unsigned)b) << 16); }
__device__ __forceinline__ float bflo(unsigned w) { return __uint_as_float(w << 16); }
__device__ __forceinline__ float bfhi(unsigned w) { return __uint_as_float(w & 0xffff0000u); }
__device__ __forceinline__ bf16_t f2bf(float f) { unsigned u = __float_as_uint(f); u += 0x7FFFu + ((u >> 16) & 1u); return (bf16_t)(u >> 16); }
__device__ __forceinline__ unsigned pk2(float lo, float hi) { unsigned r; asm volatile("v_cvt_pk_bf16_f32 %0, %1, %2" : "=v"(r) : "v"(lo), "v"(hi)); return r; }
template <int CTRL> __device__ __forceinline__ float dppf(float x) { return __uint_as_float((unsigned)__builtin_amdgcn_update_dpp(0, (int)__float_as_uint(x), CTRL, 0xf, 0xf, false)); }
__device__ __forceinline__ float row_sum16(float x) {
    x += dppf<0xB1>(x); x += dppf<0x4E>(x); x += dppf<0x141>(x); x += dppf<0x140>(x); return x;
}
__device__ __forceinline__ float wave_sum(float v) {
    const float r = row_sum16(v);
    return (__builtin_amdgcn_readlane(r, 0) + __builtin_amdgcn_readlane(r, 16)) + (__builtin_amdgcn_readlane(r, 32) + __builtin_amdgcn_readlane(r, 48));
}
__device__ __forceinline__ float xor32(float x, int half) { const unsigned u = __float_as_uint(x); auto r = __builtin_amdgcn_permlane32_swap(u, u, false, false); return __uint_as_float(half ? r[0] : r[1]); }
__device__ __forceinline__ float sigmoidf_(float x) { return __builtin_amdgcn_rcpf(1.0f + __expf(-x)); }
__device__ __forceinline__ float siluf_(float x) { return x * __builtin_amdgcn_rcpf(1.0f + __expf(-x)); }
__device__ __forceinline__ float gelu_tanh(float x) { const float u = 0.7978845608028654f * (x + 0.044715f * x * x * x); return x * __builtin_amdgcn_rcpf(1.0f + __expf(-2.0f * u)); }
__device__ __forceinline__ void sincos_rev(float rev, float& s, float& c) {
    const float f = rev - rintf(rev);
    s = __builtin_amdgcn_sinf(f); c = __builtin_amdgcn_cosf(f);
}
#define LDS_WAIT() asm volatile("s_waitcnt lgkmcnt(0)" ::: "memory")
#define MFMA16(a, b, c) __builtin_amdgcn_mfma_f32_16x16x32_bf16((a), (b), (c), 0, 0, 0)
#define MFMA32(a, b, c) __builtin_amdgcn_mfma_f32_32x32x16_bf16((a), (b), (c), 0, 0, 0)
#define MFMA_SETTLE() do { __builtin_amdgcn_sched_barrier(0); asm volatile("s_nop 15\n\ts_nop 15\n\ts_nop 15\n\ts_nop 15" ::: "memory"); __builtin_amdgcn_sched_barrier(0); } while (0)

#define XB_TMO      128
#define XB_XCNT(j)  (256  + 64 * (j))
#define XB_XSUB(j)  (1280 + 64 * (j))
#define XB_XGEN(j)  (2304 + 64 * (j))
#define XB_TOP      3328
#define XB_TOPGEN   3392
#define XCD_BAR_WORDS 3456
#define XB_SPIN_CAP (1u << 22)
__device__ __forceinline__ unsigned xb_ld(unsigned* p)              { return __hip_atomic_load(p, __ATOMIC_RELAXED, __HIP_MEMORY_SCOPE_AGENT); }
__device__ __forceinline__ unsigned xb_add(unsigned* p, unsigned v) { return __hip_atomic_fetch_add(p, v, __ATOMIC_RELAXED, __HIP_MEMORY_SCOPE_AGENT); }
__device__ __forceinline__ unsigned xb_xcc_id() { return (unsigned)__builtin_amdgcn_s_getreg((3 << 11) | 20) & 0xFu; }
#define XB_SPIN(cond, bar) do { unsigned _sp = 0; while (cond) { __builtin_amdgcn_s_sleep(1); \
    if ((++_sp & 255u) == 0u) { if (xb_ld(&(bar)[XB_TMO])) break; if (_sp > XB_SPIN_CAP) { atomicAdd(&(bar)[XB_TMO], 1u); break; } } } } while (0)
struct XcdBarrier { unsigned* bar; unsigned x; volatile LAS unsigned* st; };
__device__ __forceinline__ XcdBarrier xcd_barrier_post(unsigned* bar, volatile LAS unsigned* st) {
    XcdBarrier b; b.bar = bar; b.x = xb_xcc_id(); b.st = st;
    if (threadIdx.x == 0) (void)xb_add(&bar[XB_XCNT(b.x)], 1u);
    return b;
}
__device__ __forceinline__ void xcd_barrier_complete(unsigned* bar, unsigned x, unsigned& nloc, unsigned& nx) {
    const unsigned G = gridDim.x * gridDim.y * gridDim.z;
    unsigned sum, cnt, mine, sp = 0u;
    for (;;) {
        sum = 0u; cnt = 0u; mine = 0u;
#pragma unroll
        for (unsigned j = 0; j < 16; ++j) { const unsigned c = xb_ld(&bar[XB_XCNT(j)]); sum += c; cnt += (c > 0u) ? 1u : 0u; mine = (j == x) ? c : mine; }
        if (sum == G) break;
        __builtin_amdgcn_s_sleep(1);
        if ((++sp & 255u) == 0u) { if (xb_ld(&bar[XB_TMO])) break; if (sp > XB_SPIN_CAP) { atomicAdd(&bar[XB_TMO], 1u); break; } }
    }
    nloc = mine > 0u ? mine : 1u; nx = cnt > 0u ? cnt : 1u;
}
__device__ __forceinline__ void xcd_barrier(const XcdBarrier& b) {
    asm volatile("s_waitcnt vmcnt(0)" ::: "memory");
    __syncthreads();
    if (threadIdx.x == 0) {
        unsigned* bar = b.bar;
        __builtin_amdgcn_s_waitcnt(0);
        unsigned nloc = b.st[0], nx = b.st[1];
        if (nloc == 0u) { xcd_barrier_complete(bar, b.x, nloc, nx); b.st[0] = nloc; b.st[1] = nx; }
        const unsigned old = xb_add(&bar[XB_XSUB(b.x)], 1u);
        const unsigned gen = old / nloc;
        if (old + 1u == (gen + 1u) * nloc) {
            __builtin_amdgcn_fence(__ATOMIC_RELEASE, "agent");
            asm volatile("s_waitcnt vmcnt(0)" ::: "memory");
            const unsigned og = xb_add(&bar[XB_TOP], 1u);
            const unsigned tg = og / nx;
            if (og + 1u == (tg + 1u) * nx) xb_add(&bar[XB_TOPGEN], 1u);
            else XB_SPIN(xb_ld(&bar[XB_TOPGEN]) == tg, bar);
            __builtin_amdgcn_fence(__ATOMIC_ACQUIRE, "agent");
            xb_add(&bar[XB_XGEN(b.x)], 1u);
            asm volatile("s_waitcnt vmcnt(0)" ::: "memory");
        } else {
            XB_SPIN(xb_ld(&bar[XB_XGEN(b.x)]) == gen, bar);
            __builtin_amdgcn_fence(__ATOMIC_ACQUIRE, "agent");
            asm volatile("s_waitcnt vmcnt(0)" ::: "memory");
        }
    }
    __syncthreads();
}

namespace pg8 {
constexpr int BM = 256, BK = 64, HALF = 128, HTB = HALF * BK * 2, STAGE_BYTES = 8 * HTB, NXCD = 8, WGM = 8;
__device__ __forceinline__ int lds_byte(int r, int c) { const int st = (r >> 4) * 2 + (c >> 5), rr = r & 15, cc = c & 31, ob = rr * 64 + cc * 2; return st * 1024 + (ob ^ (((ob >> 9) & 1) << 5)); }
__device__ __forceinline__ void stage_rc(int b, int& R, int& C) { const int st = b / 1024, sb = b % 1024, swz = sb ^ (((sb >> 9) & 1) << 5); R = (st >> 1) * 16 + swz / 64; C = (st & 1) * 32 + (swz % 64) / 2; }
__device__ __forceinline__ int perm32(int rho) { const int n = rho >> 4, i = rho & 15; return 8 * (i >> 2) + 4 * n + (i & 3); }

struct Unit { const char* A; const char* B; int nt, mode, pm, pn; };
struct Sched {
    const char *A0, *B0, *A1, *B1; int nt0, nt1, ld, nM, nN, G, c;
    __device__ __forceinline__ bool next(int i, Unit& u) const {
        const int dual = (A1 != nullptr) ? 1 : 0; const int ti = dual ? (i >> 1) : i, sub = dual ? (i & 1) : 0;
        const int nwg = nM * nN; const long L = (long)ti * G + c; if (L >= nwg) return false;
        int wgid = (int)L; { const int q = nwg / NXCD, r = nwg % NXCD, xcd = wgid % NXCD, off = wgid / NXCD; wgid = (xcd < r ? xcd * (q + 1) : r * (q + 1) + (xcd - r) * q) + off; }
        const int nig = WGM * nN, gid = wgid / nig, fm = gid * WGM, gsz = (nM - fm) < WGM ? (nM - fm) : WGM;
        u.pm = fm + ((wgid % nig) % gsz); u.pn = (wgid % nig) / gsz;
        const size_t tstep = (size_t)BM * ld * 2;
        u.A = (sub ? A1 : A0) + (size_t)u.pm * tstep; u.B = (sub ? B1 : B0) + (size_t)u.pn * tstep; u.nt = sub ? nt1 : nt0; u.mode = dual ? (sub ? 2 : 1) : 0;
        return true;
    }
};
typedef f32x4 Acc[2][2][4][2];

template <class Epi>
__device__ __forceinline__ void gemm_phase(LAS unsigned char* lds, const Sched& S, const Epi& E) {
    const int tid = fresh_tid(), wid = __builtin_amdgcn_readfirstlane(tid >> 6), lane = tid & 63, wr = wid >> 2, wc = wid & 3, fr = lane & 15, fq = lane >> 4;
    const int ld = S.ld;
    unsigned voffA[2], voffB[2];
#pragma unroll
    for (int i = 0; i < 2; ++i) { int R, C; stage_rc(tid * 16 + i * 8192, R, C); const int Rb = (R & ~31) + perm32(R & 31);
        voffA[i] = (unsigned)(R * ld + C) * 2u; voffB[i] = (unsigned)(Rb * ld + C) * 2u; }
    const size_t kstep = (size_t)(BK * 2);
    const size_t hstep = (size_t)HALF * ld * 2;
    const unsigned ldsw = (unsigned)wid * 1024u;
    const int aoff = lds_byte(wr * 64 + fr, fq * 8), boff = lds_byte(wc * 32 + fr, fq * 8);
#define PG8_SA(b, h) (((b) * 2 + (h)) * HTB)
#define PG8_SB(b, h) ((4 + (b) * 2 + (h)) * HTB)
#define PG8_STAGE(bufoff, gbase, voff) do { _Pragma("unroll") for (int _i = 0; _i < 2; ++_i) \
        __builtin_amdgcn_global_load_lds((const unsigned*)((const char*)(gbase) + (voff)[_i]), (LAS unsigned*)(lds + (bufoff) + ldsw + _i * 8192), 16, 0, 0); } while (0)
#define PG8_LDA(dst, b, h) do { _Pragma("unroll") for (int m = 0; m < 4; ++m) _Pragma("unroll") for (int k = 0; k < 2; ++k) dst[m][k] = *(const LAS bf16x8*)(lds + PG8_SA(b, h) + aoff + m * 2048 + k * 1024); } while (0)
#define PG8_LDB(dst, b, h) do { _Pragma("unroll") for (int n = 0; n < 2; ++n) _Pragma("unroll") for (int k = 0; k < 2; ++k) dst[n][k] = *(const LAS bf16x8*)(lds + PG8_SB(b, h) + boff + n * 2048 + k * 1024); } while (0)
#define PG8_MMA(ai, bj, At, Bt) do { __builtin_amdgcn_s_setprio(1); _Pragma("unroll") for (int m = 0; m < 4; ++m) _Pragma("unroll") for (int n = 0; n < 2; ++n) _Pragma("unroll") for (int k = 0; k < 2; ++k) \
        acc[ai][bj][m][n] = __builtin_amdgcn_mfma_f32_16x16x32_bf16(Bt[n][k], At[m][k], acc[ai][bj][m][n], 0, 0, 0); __builtin_amdgcn_s_setprio(0); } while (0)
#define PG8_WAIT_V(n) asm volatile("s_waitcnt vmcnt(" #n ")" ::: "memory")
#define PG8_WAIT_L(n) asm volatile("s_waitcnt lgkmcnt(" #n ")" ::: "memory")
#define PG8_BAR __builtin_amdgcn_s_barrier()
#define PG8_SCHED __builtin_amdgcn_sched_barrier(0)
    Unit cur, nxt; int ui = 0;
    if (!S.next(0, cur)) return;
    Acc acc;
#pragma unroll
    for (int a = 0; a < 2; ++a)
#pragma unroll
        for (int b = 0; b < 2; ++b)
#pragma unroll
            for (int m = 0; m < 4; ++m)
#pragma unroll
                for (int n = 0; n < 2; ++n) acc[a][b][m][n] = (f32x4){0.f, 0.f, 0.f, 0.f};
    bf16x8 At[4][2], B0[2][2], B1[2][2];
    const char* cA = cur.A; const char* cB = cur.B;
    PG8_STAGE(PG8_SB(0, 0), cB, voffB); PG8_STAGE(PG8_SA(0, 0), cA, voffA); PG8_STAGE(PG8_SB(0, 1), cB + hstep, voffB); PG8_STAGE(PG8_SA(0, 1), cA + hstep, voffA);
    if (wr == 1) PG8_BAR;
    PG8_WAIT_V(4); PG8_BAR;
    PG8_STAGE(PG8_SB(1, 0), cB + kstep, voffB); PG8_STAGE(PG8_SA(1, 0), cA + kstep, voffA); PG8_STAGE(PG8_SB(1, 1), cB + hstep + kstep, voffB);
    PG8_WAIT_V(6); PG8_BAR;
    for (;;) {
        const bool has_next = S.next(ui + 1, nxt);
        const char* nA = has_next ? nxt.A : cA; const char* nB = has_next ? nxt.B : cB;
        const int nt = cur.nt;
        for (int t = 0; t < nt; t += 2) {
            const bool last = (t == nt - 2);
            const char* a1 = cA + (size_t)(t + 1) * kstep;
            const char* a2 = last ? nA : cA + (size_t)(t + 2) * kstep; const char* b2 = last ? nB : cB + (size_t)(t + 2) * kstep;
            const char* a3 = a2 + kstep; const char* b3 = b2 + kstep;
            PG8_LDB(B0, 0, 0); PG8_SCHED; PG8_LDA(At, 0, 0); PG8_STAGE(PG8_SA(1, 1), a1 + hstep, voffA);
            PG8_WAIT_L(8); PG8_BAR; PG8_WAIT_L(0); PG8_MMA(0, 0, At, B0); PG8_BAR; PG8_SCHED;
            PG8_LDB(B1, 0, 1); PG8_STAGE(PG8_SB(0, 0), b2, voffB);
            PG8_BAR; PG8_WAIT_L(0); PG8_MMA(0, 1, At, B1); PG8_BAR;
            PG8_LDA(At, 0, 1); PG8_STAGE(PG8_SA(0, 0), a2, voffA);
            PG8_BAR; PG8_WAIT_L(0); PG8_MMA(1, 0, At, B0); PG8_BAR; PG8_SCHED;
            PG8_STAGE(PG8_SB(0, 1), b2 + hstep, voffB);
            PG8_WAIT_V(6); PG8_BAR; PG8_MMA(1, 1, At, B1); PG8_BAR;
            PG8_LDB(B0, 1, 0); PG8_SCHED; PG8_LDA(At, 1, 0); PG8_STAGE(PG8_SA(0, 1), a2 + hstep, voffA);
            PG8_WAIT_L(8); PG8_BAR; PG8_WAIT_L(0); PG8_MMA(0, 0, At, B0); PG8_BAR; PG8_SCHED;
            PG8_LDB(B1, 1, 1); PG8_STAGE(PG8_SB(1, 0), b3, voffB);
            PG8_BAR; PG8_WAIT_L(0); PG8_MMA(0, 1, At, B1); PG8_BAR;
            PG8_LDA(At, 1, 1); PG8_STAGE(PG8_SA(1, 0), a3, voffA);
            PG8_BAR; PG8_WAIT_L(0); PG8_MMA(1, 0, At, B0); PG8_BAR; PG8_SCHED;
            PG8_STAGE(PG8_SB(1, 1), b3 + hstep, voffB);
            PG8_WAIT_V(6); PG8_BAR; PG8_MMA(1, 1, At, B1); PG8_BAR;
        }
        MFMA_SETTLE();
        E(acc, cur, wr, wc, fr, fq);
        if (!has_next) break;
        if (cur.mode != 1) {
#pragma unroll
            for (int a = 0; a < 2; ++a)
#pragma unroll
                for (int b = 0; b < 2; ++b)
#pragma unroll
                    for (int m = 0; m < 4; ++m)
#pragma unroll
                        for (int n = 0; n < 2; ++n) acc[a][b][m][n] = (f32x4){0.f, 0.f, 0.f, 0.f};
        }
        cur = nxt; cA = nA; cB = nB; ++ui;
    }
    PG8_WAIT_V(0);
    if (wr == 0) PG8_BAR;
    PG8_BAR;
#undef PG8_SA
#undef PG8_SB
#undef PG8_STAGE
#undef PG8_LDA
#undef PG8_LDB
#undef PG8_MMA
#undef PG8_WAIT_V
#undef PG8_WAIT_L
#undef PG8_BAR
#undef PG8_SCHED
}

#define EPI_ROWS_BEGIN \
    _Pragma("unroll") for (int ai = 0; ai < 2; ++ai) _Pragma("unroll") for (int m = 0; m < 4; ++m) { const int row = u.pm * 256 + ai * 128 + wr * 64 + m * 16 + fr; \
    _Pragma("unroll") for (int bj = 0; bj < 2; ++bj) { const int col = u.pn * 256 + bj * 128 + wc * 32 + 8 * fq; f32x4& v0 = acc[ai][bj][m][0]; f32x4& v1 = acc[ai][bj][m][1];
#define EPI_ROWS_END } __builtin_amdgcn_sched_barrier(0); }

struct EpiStoreBf16 {
    bf16_t* O; int ldc;
    __device__ __forceinline__ void operator()(Acc& acc, const Unit& u, int wr, int wc, int fr, int fq) const {
        EPI_ROWS_BEGIN
            u32x4 w; w.x = pk2(v0[0], v0[1]); w.y = pk2(v0[2], v0[3]); w.z = pk2(v1[0], v1[1]); w.w = pk2(v1[2], v1[3]);
            *(u32x4*)(O + (size_t)row * ldc + col) = w;
        EPI_ROWS_END
    }
};
struct EpiGlu {
    const bf16_t* ya; bf16_t* ya2;
    __device__ __forceinline__ void operator()(Acc& acc, const Unit& u, int wr, int wc, int fr, int fq) const {
        EPI_ROWS_BEGIN
            const u32x4 y = *(const u32x4*)(ya + (size_t)row * 512 + col);
            u32x4 w;
            w.x = pk2(bflo(y.x) * sigmoidf_(v0[0]), bfhi(y.x) * sigmoidf_(v0[1]));
            w.y = pk2(bflo(y.y) * sigmoidf_(v0[2]), bfhi(y.y) * sigmoidf_(v0[3]));
            w.z = pk2(bflo(y.z) * sigmoidf_(v1[0]), bfhi(y.z) * sigmoidf_(v1[1]));
            w.w = pk2(bflo(y.w) * sigmoidf_(v1[2]), bfhi(y.w) * sigmoidf_(v1[3]));
            *(u32x4*)(ya2 + (size_t)row * 1024 + col) = w;
        EPI_ROWS_END
    }
};
struct EpiMix {
    const bf16_t* z; bf16_t* mix;
    __device__ __forceinline__ void operator()(Acc& acc, const Unit& u, int wr, int wc, int fr, int fq) const {
        if (u.mode == 1) {
            EPI_ROWS_BEGIN
                const u32x4 ga = *(const u32x4*)(z + (size_t)row * INC + ZGA + col);
                const u32x4 gb = *(const u32x4*)(z + (size_t)row * INC + ZGB + col);
#define RATIO(a, b) ((1.0f + __expf(-(b))) * __builtin_amdgcn_rcpf(1.0f + __expf(-(a))))
                v0[0] *= RATIO(bflo(ga.x), bflo(gb.x)); v0[1] *= RATIO(bfhi(ga.x), bfhi(gb.x));
                v0[2] *= RATIO(bflo(ga.y), bflo(gb.y)); v0[3] *= RATIO(bfhi(ga.y), bfhi(gb.y));
                v1[0] *= RATIO(bflo(ga.z), bflo(gb.z)); v1[1] *= RATIO(bfhi(ga.z), bfhi(gb.z));
                v1[2] *= RATIO(bflo(ga.w), bflo(gb.w)); v1[3] *= RATIO(bfhi(ga.w), bfhi(gb.w));
#undef RATIO
            EPI_ROWS_END
        } else {
            EPI_ROWS_BEGIN
                const u32x4 gb = *(const u32x4*)(z + (size_t)row * INC + ZGB + col);
                u32x4 w;
                w.x = pk2(v0[0] * sigmoidf_(bflo(gb.x)), v0[1] * sigmoidf_(bfhi(gb.x)));
                w.y = pk2(v0[2] * sigmoidf_(bflo(gb.y)), v0[3] * sigmoidf_(bfhi(gb.y)));
                w.z = pk2(v1[0] * sigmoidf_(bflo(gb.z)), v1[1] * sigmoidf_(bfhi(gb.z)));
                w.w = pk2(v1[2] * sigmoidf_(bflo(gb.w)), v1[3] * sigmoidf_(bfhi(gb.w)));
                *(u32x4*)(mix + (size_t)row * 1024 + col) = w;
            EPI_ROWS_END
        }
    }
};
struct EpiRes {
    const float* xinP; const float* xinS; float* xout;
    __device__ __forceinline__ void operator()(Acc& acc, const Unit& u, int wr, int wc, int fr, int fq) const {
        EPI_ROWS_BEGIN
            const float* xi = (row < MP ? xinP + (size_t)row * 1024 : xinS + (size_t)(row - MP) * 1024) + col;
            const f32x4 a = *(const f32x4*)xi, b = *(const f32x4*)(xi + 4);
            float* xo = xout + (size_t)row * 1024 + col;
            *(f32x4*)xo = a + v0; *(f32x4*)(xo + 4) = b + v1;
        EPI_ROWS_END
    }
};
struct EpiUp {
    bf16_t* up; float* convP; float* convS;
    __device__ __forceinline__ void operator()(Acc& acc, const Unit& u, int wr, int wc, int fr, int fq) const {
        EPI_ROWS_BEGIN
            u32x4 w; w.x = pk2(v0[0], v0[1]); w.y = pk2(v0[2], v0[3]); w.z = pk2(v1[0], v1[1]); w.w = pk2(v1[2], v1[3]);
            *(u32x4*)(up + (size_t)row * INC + col) = w;
            float* cp = nullptr;
            if (row < MP) { const int t = row & 2047; if (t >= 2046) cp = convP + ((size_t)((row >> 11) * 2 + (t - 2046))) * INC + col; }
            else { const int r2 = row - MP, t = r2 & 7; if (t >= 6) cp = convS + ((size_t)((r2 >> 3) * 2 + (t - 6))) * INC + col; }
            if (cp) { *(f32x4*)cp = v0; *(f32x4*)(cp + 4) = v1; }
        EPI_ROWS_END
    }
};
}

__device__ __forceinline__ void transpose_item(const float* W, int K, int N, bf16_t* WT, int ldd, const float* gk, float* scr, int item, int lane) {
    const int nblk = N / 32, kb = item / nblk, nb = item % nblk, k0 = 64 * kb, n0 = 32 * nb;
#pragma unroll 8
    for (int i = 0; i < 32; ++i) { const int kk = 2 * i + (lane >> 5); float v = W[(size_t)(k0 + kk) * N + n0 + (lane & 31)]; if (gk) v *= gk[k0 + kk]; scr[kk * 33 + (lane & 31)] = v; }
    LDS_WAIT();
    const int c = lane & 7;
#pragma unroll
    for (int j = 0; j < 4; ++j) { const int n = (lane >> 3) + 8 * j; const float* s = scr + (8 * c) * 33 + n;
        u32x4 o; o.x = pk2(s[0 * 33], s[1 * 33]); o.y = pk2(s[2 * 33], s[3 * 33]); o.z = pk2(s[4 * 33], s[5 * 33]); o.w = pk2(s[6 * 33], s[7 * 33]);
        *(u32x4*)(WT + (size_t)(n0 + n) * ldd + k0 + 8 * c) = o; }
    LDS_WAIT();
}

__device__ __forceinline__ void rms_row_to_bf16(const float* xrow, bf16_t* orow, int lane) {
    const f32x4* xr = (const f32x4*)xrow + lane;
    f32x4 v[4]; float s = 0.f;
#pragma unroll
    for (int j = 0; j < 4; ++j) { v[j] = xr[64 * j]; s += (v[j].x * v[j].x + v[j].y * v[j].y) + (v[j].z * v[j].z + v[j].w * v[j].w); }
    const float rstd = rsqrtf(wave_sum(s) * (1.f / 1024.f) + EPSF);
    u32x2* o8 = (u32x2*)orow + lane;
#pragma unroll
    for (int j = 0; j < 4; ++j) { u32x2 w; w.x = pk2(v[j].x * rstd, v[j].y * rstd); w.y = pk2(v[j].z * rstd, v[j].w * rstd); o8[64 * j] = w; }
}

__device__ __forceinline__ void phase_rmsnorm(const KPG& p, int l, int wave, int lane) {
    const float* xb = (const float*)(p.ws + WS_X); bf16_t* h = (bf16_t*)(p.ws + WS_H);
    for (int row = fresh_bid() * 8 + wave; row < MT; row += gridDim.x * 8) {
        const float* xr = (l == 0) ? (row < MP ? p.in[0] + (size_t)row * 1024 : p.in[1] + (size_t)(row - MP) * 1024) : xb + (size_t)row * 1024;
        rms_row_to_bf16(xr, h + (size_t)row * 1024, lane);
    }
}

__device__ __forceinline__ void phase_prologue(const KPG& p, int l, unsigned char* lds, int wave, int lane) {
    float* scr = (float*)(lds + wave * 8448);
    const int gw = fresh_bid() * 8 + wave, NGW = gridDim.x * 8;
    constexpr int I_IN = 16 * 176, I_UP = 16 * 176, I_DN = 44 * 32, I_O = 16 * 32, I_RET = 16 * 32, I_SSM = 8 * 32, I_GLU = 8 * 16;
    constexpr int I_L = I_IN + I_UP + I_DN + I_O + I_RET + I_SSM + I_GLU;
    for (int it = gw; it < I_L; it += NGW) {
        int r = it;
        unsigned char* wl = p.ws + WS_WT + (size_t)l * LW_SIZE;
        if (r < I_IN) { transpose_item(p.in[7] + (size_t)l * 1024 * INC, 1024, INC, (bf16_t*)(wl + LW_IN), 1024, p.in[6] + l * 1024, scr, r, lane); continue; } r -= I_IN;
        if (r < I_UP) { transpose_item(p.in[21] + (size_t)l * 1024 * INC, 1024, INC, (bf16_t*)(wl + LW_UP), 1024, p.in[20] + l * 1024, scr, r, lane); continue; } r -= I_UP;
        if (r < I_DN) { transpose_item(p.in[24] + (size_t)l * DFF * 1024, DFF, 1024, (bf16_t*)(wl + LW_DOWN), DFF, nullptr, scr, r, lane); continue; } r -= I_DN;
        if (r < I_O) { transpose_item(p.in[19] + (size_t)l * 1024 * 1024, 1024, 1024, (bf16_t*)(wl + LW_O), 1024, nullptr, scr, r, lane); continue; } r -= I_O;
        if (r < I_RET) { transpose_item(p.in[18] + (size_t)l * 1024 * 1024, 1024, 1024, (bf16_t*)(wl + LW_RET), 1024, nullptr, scr, r, lane); continue; } r -= I_RET;
        if (r < I_SSM) { transpose_item(p.in[17] + (size_t)l * 512 * 1024, 512, 1024, (bf16_t*)(wl + LW_SSM), 1024, nullptr, scr, r, lane); continue; } r -= I_SSM;
        transpose_item(p.in[16] + (size_t)l * 512 * 512, 512, 512, (bf16_t*)(wl + LW_GLU), 512, nullptr, scr, r, lane);
    }
    const int gt = fresh_bid() * 512 + fresh_tid(), NGT = gridDim.x * 512;
    for (int it = gt; it < 32 * 64; it += NGT) {
        const int pp = it & 63, g = (it >> 6) & 31;
        const int gi = l * 32 + g, pi = gi * 64 + pp;
        const float dt = __expf(p.in[10][gi]), lr = p.in[8][pi], li = p.in[9][pi];
        float s1, c1; sincos_rev(li * dt * 0.15915494309189535f, s1, c1);
        const float m1 = __expf(lr * dt); const float lbr = m1 * c1, lbi = m1 * s1;
        const float nr = lbr - 1.0f, ni = lbi, den = 1.0f / (lr * lr + li * li);
        const float cr = (nr * lr + ni * li) * den, ci = (ni * lr - nr * li) * den;
        unsigned char* st = p.ws + WS_S5T + (size_t)l * S5_SIZE;
        const float* bre = p.in[11] + (size_t)pi * 16; const float* bim = p.in[12] + (size_t)pi * 16;
        bf16_t* bmre = (bf16_t*)(st + S5_BMT) + (size_t)(g * 128 + pp) * 16; bf16_t* bmim = (bf16_t*)(st + S5_BMT) + (size_t)(g * 128 + 64 + pp) * 16;
#pragma unroll
        for (int c = 0; c < 16; ++c) { const float br = bre[c], bi = bim[c]; bmre[c] = f2bf(cr * br - ci * bi); bmim[c] = f2bf(cr * bi + ci * br); }
        float2* lam = (float2*)(st + S5_LAM) + g * 64 + pp; *lam = make_float2(lbr, lbi);
        float s32, c32; sincos_rev(32.0f * li * dt * 0.15915494309189535f, s32, c32); const float m32 = __expf(32.0f * lr * dt);
        float2* lam32 = (float2*)(st + S5_LAM32) + g * 64 + pp; *lam32 = make_float2(m32 * c32, m32 * s32);
    }
    for (int it = gt; it < 32 * 16 * 128; it += NGT) {
        const int pq = it & 127, c = (it >> 7) & 15, g = (it >> 11) & 31;
        const size_t src = ((size_t)((l * 32 + g) * 16 + c)) * 64 + (pq & 63);
        const float v = pq < 64 ? p.in[13][src] : -p.in[14][src];
        ((bf16_t*)(p.ws + WS_S5T + (size_t)l * S5_SIZE + S5_CMT))[(g * 16 + c) * 128 + pq] = f2bf(v);
    }
    for (int it = gt; it < 2056 * 64; it += NGT) {
        const int j = it & 63, pi = it >> 6; const double pos = (double)(pi < 2048 ? pi : 16384 + pi - 2048);
        double inv = 1.0, r = 0.86596432336006535;
        int e = j;
#pragma unroll
        for (int b = 0; b < 6; ++b) { if (e & 1) inv *= r; r *= r; e >>= 1; }
        const double rev = pos * inv * 0.15915494309189535; const double fr_ = rev - __builtin_rint(rev);
        const float f = (float)fr_;
        ((float2*)(p.ws + WS_ROPE))[it] = make_float2(__builtin_amdgcn_cosf(f), __builtin_amdgcn_sinf(f));
    }
}

template <bool SAMPLE>
__device__ __forceinline__ void s5_tile(const KPG& p, int l, int g, int row0, int bseq, int chunk, bf16_t* Sl, int lane) {
    const bf16_t* z = (const bf16_t*)(p.ws + WS_Z); bf16_t* ya = (bf16_t*)(p.ws + WS_YA);
    const unsigned char* st = p.ws + WS_S5T + (size_t)l * S5_SIZE;
    const int half = lane >> 5, li = lane & 31;
    const bf16x8 uf = *(const bf16x8*)(z + (size_t)(row0 + li) * INC + g * 16 + 8 * half);
    const int fr = lane & 15, fq = lane >> 4;
    float2 lm[2]; lm[0] = ((const float2*)(st + S5_LAM))[g * 64 + li]; lm[1] = ((const float2*)(st + S5_LAM))[g * 64 + 32 + li];
    const float* sin_ = (const float*)(p.ws + WS_SIN);
    float c0r[4][2], c0i[4][2];
#pragma unroll
    for (int k = 0; k < 4; ++k)
#pragma unroll
        for (int pt = 0; pt < 2; ++pt) {
            c0r[k][pt] = 0.f; c0i[k][pt] = 0.f;
            if (SAMPLE) { const size_t o = ((size_t)((l * 128 + bseq + k) * 32 + g)) * 64 + pt * 32 + li; c0r[k][pt] = p.in[2][o]; c0i[k][pt] = p.in[3][o]; }
        }
    float2 l32v[2]; float e_r[2][7], e_i[2][7], loc_r[2], loc_i[2];
    if (!SAMPLE) {
        const int sc = chunk >> 3;
#pragma unroll
        for (int pt = 0; pt < 2; ++pt) {
            l32v[pt] = ((const float2*)(st + S5_LAM32))[g * 64 + pt * 32 + li];
            const float* Eb = (const float*)(p.ws + WS_E) + ((size_t)((bseq * 32 + g) * 8)) * 128 + pt * 32 + li;
#pragma unroll
            for (int i = 0; i < 7; ++i) { e_r[pt][i] = 0.f; e_i[pt][i] = 0.f; if (i < sc) { e_r[pt][i] = Eb[i * 128]; e_i[pt][i] = Eb[i * 128 + 64]; } }
            const size_t o = ((size_t)((bseq * 32 + g) * 64 + chunk)) * 128 + pt * 32 + li;
            loc_r[pt] = sin_[o]; loc_i[pt] = sin_[o + 64];
        }
    }
    bf16x8 cf[4];
#pragma unroll
    for (int ks = 0; ks < 4; ++ks) cf[ks] = *(const bf16x8*)((const bf16_t*)(st + S5_CMT) + (size_t)(g * 16 + fr) * 128 + ks * 32 + 8 * fq);
    const float dv = p.in[15][l * 512 + g * 16 + fr];
    bf16_t uraw[2][4];
#pragma unroll
    for (int rt = 0; rt < 2; ++rt)
#pragma unroll
        for (int r = 0; r < 4; ++r) uraw[rt][r] = z[(size_t)(row0 + rt * 16 + 4 * fq + r) * INC + g * 16 + fr];
    f32x16 acc[4];
#pragma unroll
    for (int ct = 0; ct < 4; ++ct) {
        const bf16x8 bfr = *(const bf16x8*)((const bf16_t*)(st + S5_BMT) + (size_t)(g * 128 + ct * 32 + li) * 16 + 8 * half);
        f32x16 zz;
#pragma unroll
        for (int e = 0; e < 16; ++e) zz[e] = 0.f;
        acc[ct] = MFMA32(uf, bfr, zz);
    }
    MFMA_SETTLE();
    float sr[2] = {0.f, 0.f}, si[2] = {0.f, 0.f};
#pragma unroll
    for (int k = 0; k < 4; ++k) {
        if (SAMPLE) {
#pragma unroll
            for (int pt = 0; pt < 2; ++pt) { sr[pt] = c0r[k][pt]; si[pt] = c0i[k][pt]; }
        } else if (k == 0) {
            const int sc = chunk >> 3, jj = chunk & 7;
#pragma unroll
            for (int pt = 0; pt < 2; ++pt) {
                const float2 l32 = l32v[pt];
                const float2 l64 = make_float2(l32.x * l32.x - l32.y * l32.y, 2.0f * l32.x * l32.y);
                const float2 l128 = make_float2(l64.x * l64.x - l64.y * l64.y, 2.0f * l64.x * l64.y);
                const float2 l256 = make_float2(l128.x * l128.x - l128.y * l128.y, 2.0f * l128.x * l128.y);
                float Sr = 0.f, Si = 0.f;
#pragma unroll
                for (int i = 0; i < 7; ++i) { if (i < sc) { const float tr = l256.x * Sr - l256.y * Si + e_r[pt][i], ti = l256.x * Si + l256.y * Sr + e_i[pt][i]; Sr = tr; Si = ti; } }
                float rr = 1.0f, ri = 0.0f;
                if (jj & 1) { const float tr = rr * l32.x - ri * l32.y, ti = rr * l32.y + ri * l32.x; rr = tr; ri = ti; }
                if (jj & 2) { const float tr = rr * l64.x - ri * l64.y, ti = rr * l64.y + ri * l64.x; rr = tr; ri = ti; }
                if (jj & 4) { const float tr = rr * l128.x - ri * l128.y, ti = rr * l128.y + ri * l128.x; rr = tr; ri = ti; }
                sr[pt] = loc_r[pt] + (rr * Sr - ri * Si); si[pt] = loc_i[pt] + (rr * Si + ri * Sr);
            }
        }
#pragma unroll
        for (int hh = 0; hh < 2; ++hh) {
            const bool mine = (half == hh);
            float tr_[2] = {sr[0], sr[1]}, ti_[2] = {si[0], si[1]};
#pragma unroll
            for (int q = 0; q < 4; ++q)
#pragma unroll
                for (int pt = 0; pt < 2; ++pt) {
                    const float tr = lm[pt].x * tr_[pt] - lm[pt].y * ti_[pt] + acc[pt][4 * k + q];
                    const float ti = lm[pt].x * ti_[pt] + lm[pt].y * tr_[pt] + acc[2 + pt][4 * k + q];
                    tr_[pt] = tr; ti_[pt] = ti;
                    acc[pt][4 * k + q] = mine ? tr : acc[pt][4 * k + q]; acc[2 + pt][4 * k + q] = mine ? ti : acc[2 + pt][4 * k + q];
                }
#pragma unroll
            for (int pt = 0; pt < 2; ++pt) { sr[pt] = mine ? tr_[pt] : sr[pt]; si[pt] = mine ? ti_[pt] : si[pt]; }
            if (SAMPLE && hh == 1) {
                if (mine) {
#pragma unroll
                    for (int pt = 0; pt < 2; ++pt) { const size_t o = ((size_t)((l * 128 + bseq + k) * 32 + g)) * 64 + pt * 32 + li;
                        p.out[O_SRS + o] = sr[pt]; p.out[O_SIS + o] = si[pt]; }
                }
            }
#pragma unroll
            for (int pt = 0; pt < 2; ++pt) { const float orr = xor32(sr[pt], half), oii = xor32(si[pt], half); sr[pt] = mine ? sr[pt] : orr; si[pt] = mine ? si[pt] : oii; }
        }
    }
    if (!SAMPLE && chunk == 63 && half == 0) {
#pragma unroll
        for (int pt = 0; pt < 2; ++pt) { const size_t o = ((size_t)((l * 8 + bseq) * 32 + g)) * 64 + pt * 32 + li; p.out[O_SRP + o] = sr[pt]; p.out[O_SIP + o] = si[pt]; }
    }
#pragma unroll
    for (int ct = 0; ct < 4; ++ct)
#pragma unroll
        for (int r = 0; r < 16; ++r) { const int t = (r & 3) + 8 * (r >> 2) + 4 * half; Sl[t * 136 + ct * 32 + li] = f2bf(acc[ct][r]); }
    LDS_WAIT();
#pragma unroll
    for (int rt = 0; rt < 2; ++rt) {
        f32x4 y = {0.f, 0.f, 0.f, 0.f};
#pragma unroll
        for (int ks = 0; ks < 4; ++ks) { const bf16x8 a = *(const bf16x8*)(Sl + (rt * 16 + fr) * 136 + ks * 32 + 8 * fq); y = MFMA16(a, cf[ks], y); }
        MFMA_SETTLE();
#pragma unroll
        for (int r = 0; r < 4; ++r) { const int tok = row0 + rt * 16 + 4 * fq + r; const float uu = bf2f(uraw[rt][r]);
            ya[(size_t)tok * 512 + g * 16 + fr] = f2bf(gelu_tanh(y[r] + dv * uu)); }
    }
    LDS_WAIT();
}

__device__ __forceinline__ void s5_m1(const KPG& p, int l, int b, int g, int sc, int lane) {
    const bf16_t* z = (const bf16_t*)(p.ws + WS_Z);
    const unsigned char* st = p.ws + WS_S5T + (size_t)l * S5_SIZE;
    const int half = lane >> 5, li = lane & 31;
    bf16x8 bfr[4];
#pragma unroll
    for (int ct = 0; ct < 4; ++ct) bfr[ct] = *(const bf16x8*)((const bf16_t*)(st + S5_BMT) + (size_t)(g * 128 + ct * 32 + li) * 16 + 8 * half);
    float2 lm[2]; lm[0] = ((const float2*)(st + S5_LAM))[g * 64 + li]; lm[1] = ((const float2*)(st + S5_LAM))[g * 64 + 32 + li];
    float sr[2] = {0.f, 0.f}, si[2] = {0.f, 0.f};
    float* sin_ = (float*)(p.ws + WS_SIN);
    for (int j = 0; j < 8; ++j) {
        const int chunk = sc * 8 + j, row0 = b * 2048 + chunk * 32;
        const bf16x8 uf = *(const bf16x8*)(z + (size_t)(row0 + li) * INC + g * 16 + 8 * half);
        if (half == 0) {
#pragma unroll
            for (int pt = 0; pt < 2; ++pt) { const size_t o = ((size_t)((b * 32 + g) * 64 + chunk)) * 128 + pt * 32 + li; sin_[o] = sr[pt]; sin_[o + 64] = si[pt]; }
        }
        f32x16 acc[4];
#pragma unroll
        for (int ct = 0; ct < 4; ++ct) {
            f32x16 zz;
#pragma unroll
            for (int e = 0; e < 16; ++e) zz[e] = 0.f;
            acc[ct] = MFMA32(uf, bfr[ct], zz);
        }
        MFMA_SETTLE();
#pragma unroll
        for (int k = 0; k < 4; ++k)
#pragma unroll
            for (int hh = 0; hh < 2; ++hh) {
                const bool mine = (half == hh);
                float tr_[2] = {sr[0], sr[1]}, ti_[2] = {si[0], si[1]};
#pragma unroll
                for (int q = 0; q < 4; ++q)
#pragma unroll
                    for (int pt = 0; pt < 2; ++pt) {
                        const float tr = lm[pt].x * tr_[pt] - lm[pt].y * ti_[pt] + acc[pt][4 * k + q];
                        const float ti = lm[pt].x * ti_[pt] + lm[pt].y * tr_[pt] + acc[2 + pt][4 * k + q];
                        tr_[pt] = tr; ti_[pt] = ti;
                    }
#pragma unroll
                for (int pt = 0; pt < 2; ++pt) { sr[pt] = mine ? tr_[pt] : sr[pt]; si[pt] = mine ? ti_[pt] : si[pt]; }
#pragma unroll
                for (int pt = 0; pt < 2; ++pt) { const float orr = xor32(sr[pt], half), oii = xor32(si[pt], half); sr[pt] = mine ? sr[pt] : orr; si[pt] = mine ? si[pt] : oii; }
            }
    }
    if (half == 0) {
        float* E = (float*)(p.ws + WS_E) + ((size_t)((b * 32 + g) * 8 + sc)) * 128;
#pragma unroll
        for (int pt = 0; pt < 2; ++pt) { E[pt * 32 + li] = sr[pt]; E[64 + pt * 32 + li] = si[pt]; }
    }
}

__device__ __forceinline__ float log2_gamma(int h) { return __log2f(1.0f - exp2f(-5.0f - (float)h)); }

__device__ __forceinline__ void rot8(const u32x4& lo, const u32x4& hi, const float2* rp, float scale, float* olo, float* ohi) {
    const unsigned lw[4] = {lo.x, lo.y, lo.z, lo.w}, hw[4] = {hi.x, hi.y, hi.z, hi.w};
#pragma unroll
    for (int e = 0; e < 8; ++e) {
        const float x1 = (e & 1) ? bfhi(lw[e >> 1]) : bflo(lw[e >> 1]);
        const float x2 = (e & 1) ? bfhi(hw[e >> 1]) : bflo(hw[e >> 1]);
        const float2 cs = rp[e];
        olo[e] = (x1 * cs.x - x2 * cs.y) * scale; ohi[e] = (x1 * cs.y + x2 * cs.x) * scale;
    }
}

__device__ __forceinline__ void ret_m1_unit(const KPG& p, int l, int unit, unsigned char* lds, int wave, int lane) {
    const int tid = fresh_tid(), b = unit >> 4, h = (unit >> 2) & 3, s = unit & 3;
    const bf16_t* z = (const bf16_t*)(p.ws + WS_Z); const float2* rope = (const float2*)(p.ws + WS_ROPE);
    bf16_t* RTb = (bf16_t*)(p.ws + WS_RT);
    bf16_t* KT = (bf16_t*)lds; bf16_t* VT = KT + 128 * 136;
    const float lg2 = log2_gamma(h), cdec = exp2f(128.0f * lg2);
    const int fr = lane & 15, fq = lane >> 4;
    f32x4 R[4];
#pragma unroll
    for (int nt = 0; nt < 4; ++nt) R[nt] = (f32x4){0.f, 0.f, 0.f, 0.f};
    u32x4 kl[2], kh[2], vv[2]; f32x4 rq[2][4];
#define RM1_PREFETCH(ii) _Pragma("unroll") for (int tk = 0; tk < 2; ++tk) { const int task_ = tid + 512 * tk, j_ = task_ & 127, dg_ = task_ >> 7; const size_t zrow_ = (size_t)(b * 2048 + (ii) * 128 + j_) * INC; \
        const bf16_t* zr_ = z + zrow_ + ZK + h * 128 + dg_ * 8; kl[tk] = *(const u32x4*)zr_; kh[tk] = *(const u32x4*)(zr_ + 64); \
        const f32x4* rs_ = (const f32x4*)(rope + (size_t)((ii) * 128 + j_) * 64 + dg_ * 8); rq[tk][0] = rs_[0]; rq[tk][1] = rs_[1]; rq[tk][2] = rs_[2]; rq[tk][3] = rs_[3]; \
        vv[tk] = *(const u32x4*)(z + zrow_ + ZV + h * 256 + s * 64 + dg_ * 8); }
    RM1_PREFETCH(0)
    for (int i = 0; i < 16; ++i) {
        bf16_t* rt = RTb + ((size_t)((b * 4 + h) * 16 + i)) * 256 * 128;
#pragma unroll
        for (int nt = 0; nt < 4; ++nt) { u32x2 w; w.x = pk2(R[nt][0], R[nt][1]); w.y = pk2(R[nt][2], R[nt][3]);
            *(u32x2*)(rt + (size_t)(64 * s + 16 * nt + fr) * 128 + 16 * wave + 4 * fq) = w; }
#pragma unroll
        for (int tk = 0; tk < 2; ++tk) {
            const int task = tid + 512 * tk, j = task & 127, dg = task >> 7;
            const float sc_ = 0.08838834764831845f * exp2f((float)(127 - j) * lg2);
            const unsigned lw[4] = {kl[tk].x, kl[tk].y, kl[tk].z, kl[tk].w}, hw[4] = {kh[tk].x, kh[tk].y, kh[tk].z, kh[tk].w}, vw[4] = {vv[tk].x, vv[tk].y, vv[tk].z, vv[tk].w};
#pragma unroll
            for (int e = 0; e < 8; ++e) {
                const float x1 = (e & 1) ? bfhi(lw[e >> 1]) : bflo(lw[e >> 1]), x2 = (e & 1) ? bfhi(hw[e >> 1]) : bflo(hw[e >> 1]);
                const float cs_ = rq[tk][e >> 1][(e & 1) * 2], sn_ = rq[tk][e >> 1][(e & 1) * 2 + 1];
                KT[(dg * 8 + e) * 136 + j] = f2bf((x1 * cs_ - x2 * sn_) * sc_); KT[(64 + dg * 8 + e) * 136 + j] = f2bf((x1 * sn_ + x2 * cs_) * sc_);
                VT[(dg * 8 + e) * 136 + j] = (bf16_t)((e & 1) ? (vw[e >> 1] >> 16) : (vw[e >> 1] & 0xffffu));
            }
        }
        if (i + 1 < 16) { RM1_PREFETCH(i + 1) }
        __syncthreads();
#pragma unroll
        for (int nt = 0; nt < 4; ++nt) R[nt] = R[nt] * cdec;
#pragma unroll
        for (int ks = 0; ks < 4; ++ks) {
            const bf16x8 a = *(const bf16x8*)(KT + (16 * wave + fr) * 136 + ks * 32 + 8 * fq);
#pragma unroll
            for (int nt = 0; nt < 4; ++nt) { const bf16x8 bb = *(const bf16x8*)(VT + (16 * nt + fr) * 136 + ks * 32 + 8 * fq); R[nt] = MFMA16(a, bb, R[nt]); }
        }
        MFMA_SETTLE();
        __syncthreads();
    }
#undef RM1_PREFETCH
    float* ro = p.out + O_RP + ((size_t)((l * 8 + b) * 4 + h)) * 128 * 256;
#pragma unroll
    for (int nt = 0; nt < 4; ++nt)
#pragma unroll
        for (int r = 0; r < 4; ++r) ro[(size_t)(16 * wave + 4 * fq + r) * 256 + 64 * s + 16 * nt + fr] = R[nt][r];
}

__device__ __forceinline__ void ret_m2_unit(const KPG& p, int l, int unit, unsigned char* lds, int wave, int lane) {
    const int tid = fresh_tid(), b = unit >> 6, h = (unit >> 4) & 3, i = unit & 15;
    const bf16_t* z = (const bf16_t*)(p.ws + WS_Z); const float2* rope = (const float2*)(p.ws + WS_ROPE);
    const bf16_t* RTb = (const bf16_t*)(p.ws + WS_RT); bf16_t* ob = (bf16_t*)(p.ws + WS_O);
    bf16_t* Qs = (bf16_t*)lds; bf16_t* Ks = Qs + 128 * 136; bf16_t* BIG = Ks + 128 * 136;
    const float lg2 = log2_gamma(h);
    const int fr = lane & 15, fq = lane >> 4, row0 = b * 2048 + i * 128;
#pragma unroll
    for (int tk = 0; tk < 2; ++tk) {
        const int task = tid + 512 * tk, dg = task & 7, j = task >> 3;
        const bf16_t* zr = z + (size_t)(row0 + j) * INC + h * 128 + dg * 8;
        const float2* rp = rope + (size_t)(i * 128 + j) * 64 + dg * 8;
        float olo[8], ohi[8];
        { const u32x4 lo = *(const u32x4*)(zr + ZQ), hi = *(const u32x4*)(zr + ZQ + 64); rot8(lo, hi, rp, 1.0f, olo, ohi);
          u32x4 w; w.x = pk2(olo[0], olo[1]); w.y = pk2(olo[2], olo[3]); w.z = pk2(olo[4], olo[5]); w.w = pk2(olo[6], olo[7]); *(u32x4*)(Qs + j * 136 + dg * 8) = w;
          w.x = pk2(ohi[0], ohi[1]); w.y = pk2(ohi[2], ohi[3]); w.z = pk2(ohi[4], ohi[5]); w.w = pk2(ohi[6], ohi[7]); *(u32x4*)(Qs + j * 136 + 64 + dg * 8) = w; }
        { const u32x4 lo = *(const u32x4*)(zr + ZK), hi = *(const u32x4*)(zr + ZK + 64); rot8(lo, hi, rp, 0.08838834764831845f, olo, ohi);
          u32x4 w; w.x = pk2(olo[0], olo[1]); w.y = pk2(olo[2], olo[3]); w.z = pk2(olo[4], olo[5]); w.w = pk2(olo[6], olo[7]); *(u32x4*)(Ks + j * 136 + dg * 8) = w;
          w.x = pk2(ohi[0], ohi[1]); w.y = pk2(ohi[2], ohi[3]); w.z = pk2(ohi[4], ohi[5]); w.w = pk2(ohi[6], ohi[7]); *(u32x4*)(Ks + j * 136 + 64 + dg * 8) = w; }
    }
    {
        const bf16_t* src = RTb + ((size_t)((b * 4 + h) * 16 + i)) * 256 * 128;
#pragma unroll
        for (int k = 0; k < 8; ++k) { const int idx = tid + 512 * k, dv = idx >> 4, c16 = idx & 15; *(u32x4*)(BIG + dv * 136 + c16 * 8) = *(const u32x4*)(src + (size_t)dv * 128 + c16 * 8); }
    }
    __syncthreads();
    bf16x8 Aq[4];
#pragma unroll
    for (int ks = 0; ks < 4; ++ks) Aq[ks] = *(const bf16x8*)(Qs + (16 * wave + fr) * 136 + ks * 32 + 8 * fq);
    f32x4 S[8];
#pragma unroll
    for (int jt = 0; jt < 8; ++jt) {
        S[jt] = (f32x4){0.f, 0.f, 0.f, 0.f};
        if (jt <= wave) {
#pragma unroll
            for (int ks = 0; ks < 4; ++ks) { const bf16x8 bb = *(const bf16x8*)(Ks + (16 * jt + fr) * 136 + ks * 32 + 8 * fq); S[jt] = MFMA16(Aq[ks], bb, S[jt]); }
        }
        __builtin_amdgcn_sched_barrier(0);
    }
    f32x4 O[16];
#pragma unroll
    for (int nt = 0; nt < 16; ++nt) {
        O[nt] = (f32x4){0.f, 0.f, 0.f, 0.f};
#pragma unroll
        for (int ks = 0; ks < 4; ++ks) { const bf16x8 bb = *(const bf16x8*)(BIG + (16 * nt + fr) * 136 + ks * 32 + 8 * fq); O[nt] = MFMA16(Aq[ks], bb, O[nt]); }
        if ((nt & 1) == 1) __builtin_amdgcn_sched_barrier(0);
    }
    MFMA_SETTLE();
    {
        float inn[4];
#pragma unroll
        for (int r = 0; r < 4; ++r) inn[r] = exp2f((float)(16 * wave + 4 * fq + r + 1) * lg2);
#pragma unroll
        for (int nt = 0; nt < 16; ++nt)
#pragma unroll
            for (int r = 0; r < 4; ++r) O[nt][r] *= inn[r];
    }
    __syncthreads();
#pragma unroll
    for (int jt = 0; jt < 8; ++jt)
#pragma unroll
        for (int r = 0; r < 4; ++r) {
            const int ii = 16 * wave + 4 * fq + r, jj = 16 * jt + fr;
            const float v = (jt <= wave && ii >= jj) ? S[jt][r] * exp2f((float)(ii - jj) * lg2) : 0.0f;
            Ks[ii * 136 + jj] = f2bf(v);
        }
#pragma unroll
    for (int k = 0; k < 8; ++k) {
        const int task = tid + 512 * k, j = task & 127, vg = task >> 7;
        const u32x4 v = *(const u32x4*)(z + (size_t)(row0 + j) * INC + ZV + h * 256 + vg * 8);
        const unsigned vw[4] = {v.x, v.y, v.z, v.w};
#pragma unroll
        for (int e = 0; e < 8; ++e) BIG[(vg * 8 + e) * 136 + j] = (bf16_t)((e & 1) ? (vw[e >> 1] >> 16) : (vw[e >> 1] & 0xffffu));
    }
    __syncthreads();
#pragma unroll
    for (int ks = 0; ks < 4; ++ks) {
        if (ks <= (wave >> 1)) {
            const bf16x8 a = *(const bf16x8*)(Ks + (16 * wave + fr) * 136 + ks * 32 + 8 * fq);
#pragma unroll
            for (int nt = 0; nt < 16; ++nt) { const bf16x8 bb = *(const bf16x8*)(BIG + (16 * nt + fr) * 136 + ks * 32 + 8 * fq); O[nt] = MFMA16(a, bb, O[nt]); if ((nt & 1) == 1) __builtin_amdgcn_sched_barrier(0); }
        }
    }
    MFMA_SETTLE();
#pragma unroll
    for (int r = 0; r < 4; ++r) {
        float ss = 0.f;
#pragma unroll
        for (int nt = 0; nt < 16; ++nt) ss += O[nt][r] * O[nt][r];
        ss = row_sum16(ss);
        const float rstd = rsqrtf(ss * (1.0f / 256.0f) + EPSF);
        const size_t tok = (size_t)(row0 + 16 * wave + 4 * fq + r);
#pragma unroll
        for (int nt = 0; nt < 16; ++nt) { const int col = h * 256 + 16 * nt + fr; const float gg = bf2f(z[tok * INC + ZGR + col]);
            ob[tok * 1024 + col] = f2bf(O[nt][r] * rstd * siluf_(gg)); }
    }
    __syncthreads();
}

__device__ __forceinline__ void ret_sample_unit(const KPG& p, int l, int unit, unsigned char* lds, int wave, int lane) {
    const int tid = fresh_tid(), b = unit >> 2, h = unit & 3;
    const bf16_t* z = (const bf16_t*)(p.ws + WS_Z); const float2* rope = (const float2*)(p.ws + WS_ROPE); bf16_t* ob = (bf16_t*)(p.ws + WS_O);
    float* qT = (float*)lds; float* kT = qT + 1024; float* ktT = kT + 1024; float* vs = ktT + 1024; float* sc = vs + 2048; float* opart = sc + 64;
    const float lg2 = log2_gamma(h);
    const int row0 = MP + b * 8;
    if (tid < 64) {
        const int i = tid >> 3, dg = tid & 7;
        const bf16_t* zr = z + (size_t)(row0 + i) * INC + h * 128 + dg * 8;
        const float2* rp = rope + (size_t)(2048 + i) * 64 + dg * 8;
        float olo[8], ohi[8];
        { const u32x4 lo = *(const u32x4*)(zr + ZQ), hi = *(const u32x4*)(zr + ZQ + 64); rot8(lo, hi, rp, 1.0f, olo, ohi);
#pragma unroll
          for (int e = 0; e < 8; ++e) { qT[(dg * 8 + e) * 8 + i] = olo[e]; qT[(64 + dg * 8 + e) * 8 + i] = ohi[e]; } }
        { const u32x4 lo = *(const u32x4*)(zr + ZK), hi = *(const u32x4*)(zr + ZK + 64); rot8(lo, hi, rp, 0.08838834764831845f, olo, ohi);
          const float tl = exp2f((float)(7 - i) * lg2);
#pragma unroll
          for (int e = 0; e < 8; ++e) { kT[(dg * 8 + e) * 8 + i] = olo[e]; kT[(64 + dg * 8 + e) * 8 + i] = ohi[e]; ktT[(dg * 8 + e) * 8 + i] = olo[e] * tl; ktT[(64 + dg * 8 + e) * 8 + i] = ohi[e] * tl; } }
    }
    if (tid < 256) {
#pragma unroll
        for (int i = 0; i < 8; ++i) vs[i * 256 + tid] = bf2f(z[(size_t)(row0 + i) * INC + ZV + h * 256 + tid]);
    }
    __syncthreads();
    if (tid < 64) {
        const int i = tid >> 3, j = tid & 7; float d = 0.f;
        for (int dd = 0; dd < 128; ++dd) d += qT[dd * 8 + i] * kT[dd * 8 + j];
        sc[tid] = (j <= i) ? d * exp2f((float)(i - j) * lg2) : 0.f;
    }
    {
        const int dv4 = (tid & 63) * 4;
        f32x4 vv[8], ao[8];
#pragma unroll
        for (int j = 0; j < 8; ++j) { vv[j] = *(const f32x4*)(vs + j * 256 + dv4); ao[j] = (f32x4){0.f, 0.f, 0.f, 0.f}; }
        const size_t so = ((size_t)((l * 128 + b) * 4 + h)) * 128 * 256;
        const float* r0 = p.in[4] + so; float* rn = p.out + O_RS + so;
        const float cdec = exp2f(8.0f * lg2);
#pragma unroll 16
        for (int dd = 0; dd < 16; ++dd) {
            const int d = wave * 16 + dd;
            const f32x4 r = __builtin_nontemporal_load((const f32x4*)(r0 + (size_t)d * 256 + dv4));
            const f32x4 qa = *(const f32x4*)(qT + d * 8), qb = *(const f32x4*)(qT + d * 8 + 4), ka = *(const f32x4*)(ktT + d * 8), kb = *(const f32x4*)(ktT + d * 8 + 4);
            ao[0] += qa[0] * r; ao[1] += qa[1] * r; ao[2] += qa[2] * r; ao[3] += qa[3] * r; ao[4] += qb[0] * r; ao[5] += qb[1] * r; ao[6] += qb[2] * r; ao[7] += qb[3] * r;
            f32x4 nr = r * cdec;
            nr += ka[0] * vv[0]; nr += ka[1] * vv[1]; nr += ka[2] * vv[2]; nr += ka[3] * vv[3]; nr += kb[0] * vv[4]; nr += kb[1] * vv[5]; nr += kb[2] * vv[6]; nr += kb[3] * vv[7];
            __builtin_nontemporal_store(nr, (f32x4*)(rn + (size_t)d * 256 + dv4));
        }
#pragma unroll
        for (int i = 0; i < 8; ++i) *(f32x4*)(opart + (wave * 8 + i) * 256 + dv4) = ao[i];
    }
    __syncthreads();
    {
        const int i = wave, dv4 = (tid & 63) * 4;
        f32x4 a = (f32x4){0.f, 0.f, 0.f, 0.f};
#pragma unroll
        for (int w = 0; w < 8; ++w) a += *(const f32x4*)(opart + (w * 8 + i) * 256 + dv4);
        a = a * exp2f((float)(i + 1) * lg2);
#pragma unroll
        for (int j = 0; j < 8; ++j) { if (j <= i) a += sc[i * 8 + j] * *(const f32x4*)(vs + j * 256 + dv4); }
        const float ss = wave_sum(a[0] * a[0] + a[1] * a[1] + a[2] * a[2] + a[3] * a[3]);
        const float rstd = rsqrtf(ss * (1.0f / 256.0f) + EPSF);
        const size_t tok = (size_t)(row0 + i);
        const u32x2 gw = *(const u32x2*)(z + tok * INC + ZGR + h * 256 + dv4);
        u32x2 w; w.x = pk2(a[0] * rstd * siluf_(bflo(gw.x)), a[1] * rstd * siluf_(bfhi(gw.x))); w.y = pk2(a[2] * rstd * siluf_(bflo(gw.y)), a[3] * rstd * siluf_(bfhi(gw.y)));
        *(u32x2*)(ob + tok * 1024 + h * 256 + dv4) = w;
    }
    __syncthreads();
}

__device__ __forceinline__ void phase_convact(const KPG& p, int l) {
    const bf16_t* up = (const bf16_t*)(p.ws + WS_Z); bf16_t* act = (bf16_t*)(p.ws + WS_ACT);
    const float* cw = p.in[22] + (size_t)l * 3 * INC; const float* cb = p.in[23] + (size_t)l * INC;
    const int NT = (512 + 128) * 352;
    for (int task = fresh_bid() * 512 + fresh_tid(); task < NT; task += gridDim.x * 512) {
        const int cgp = task % 352, rc = task / 352, j0 = cgp * 8;
        int row0, nrows; bool sample = rc >= 512;
        if (!sample) { row0 = rc * 32; nrows = 32; } else { row0 = MP + (rc - 512) * 8; nrows = 8; }
        float w0v[8], w1v[8], w2v[8], bv[8], w0g[8], w1g[8], w2g[8], bg[8];
#pragma unroll
        for (int e = 0; e < 8; ++e) { w0v[e] = cw[j0 + e]; w1v[e] = cw[INC + j0 + e]; w2v[e] = cw[2 * INC + j0 + e]; bv[e] = cb[j0 + e];
            w0g[e] = cw[DFF + j0 + e]; w1g[e] = cw[INC + DFF + j0 + e]; w2g[e] = cw[2 * INC + DFF + j0 + e]; bg[e] = cb[DFF + j0 + e]; }
        float p2v[8], p1v[8], p2g[8], p1g[8];
        if (sample) {
            const float* sc = p.in[5] + ((size_t)(l * 128 + (rc - 512)) * 2) * INC;
#pragma unroll
            for (int e = 0; e < 8; ++e) { p2v[e] = sc[j0 + e]; p1v[e] = sc[INC + j0 + e]; p2g[e] = sc[DFF + j0 + e]; p1g[e] = sc[INC + DFF + j0 + e]; }
        } else if ((row0 & 2047) == 0) {
#pragma unroll
            for (int e = 0; e < 8; ++e) { p2v[e] = 0.f; p1v[e] = 0.f; p2g[e] = 0.f; p1g[e] = 0.f; }
        } else {
            const u32x4 a = *(const u32x4*)(up + (size_t)(row0 - 2) * INC + j0), b = *(const u32x4*)(up + (size_t)(row0 - 1) * INC + j0);
            const u32x4 c = *(const u32x4*)(up + (size_t)(row0 - 2) * INC + DFF + j0), d = *(const u32x4*)(up + (size_t)(row0 - 1) * INC + DFF + j0);
            const unsigned aw[4] = {a.x, a.y, a.z, a.w}, bw[4] = {b.x, b.y, b.z, b.w}, cw_[4] = {c.x, c.y, c.z, c.w}, dw[4] = {d.x, d.y, d.z, d.w};
#pragma unroll
            for (int e = 0; e < 8; ++e) { p2v[e] = (e & 1) ? bfhi(aw[e >> 1]) : bflo(aw[e >> 1]); p1v[e] = (e & 1) ? bfhi(bw[e >> 1]) : bflo(bw[e >> 1]);
                p2g[e] = (e & 1) ? bfhi(cw_[e >> 1]) : bflo(cw_[e >> 1]); p1g[e] = (e & 1) ? bfhi(dw[e >> 1]) : bflo(dw[e >> 1]); }
        }
        for (int r = 0; r < nrows; ++r) {
            const u32x4 a = *(const u32x4*)(up + (size_t)(row0 + r) * INC + j0), c = *(const u32x4*)(up + (size_t)(row0 + r) * INC + DFF + j0);
            const unsigned aw[4] = {a.x, a.y, a.z, a.w}, cw_[4] = {c.x, c.y, c.z, c.w};
            float o[8];
#pragma unroll
            for (int e = 0; e < 8; ++e) {
                const float cv = (e & 1) ? bfhi(aw[e >> 1]) : bflo(aw[e >> 1]), cg_ = (e & 1) ? bfhi(cw_[e >> 1]) : bflo(cw_[e >> 1]);
                const float val = bv[e] + w0v[e] * p2v[e] + w1v[e] * p1v[e] + w2v[e] * cv;
                const float gat = bg[e] + w0g[e] * p2g[e] + w1g[e] * p1g[e] + w2g[e] * cg_;
                o[e] = siluf_(gat) * val;
                p2v[e] = p1v[e]; p1v[e] = cv; p2g[e] = p1g[e]; p1g[e] = cg_;
            }
            u32x4 w; w.x = pk2(o[0], o[1]); w.y = pk2(o[2], o[3]); w.z = pk2(o[4], o[5]); w.w = pk2(o[6], o[7]);
            *(u32x4*)(act + (size_t)(row0 + r) * DFF + j0) = w;
        }
    }
}

#endif

__global__ void __launch_bounds__(512, 2) fwd_kernel(KP p) {
#if defined(__HIP_DEVICE_COMPILE__)
    extern __shared__ __attribute__((aligned(16))) unsigned char lds[];
    cg::grid_group grid = cg::this_grid();
    volatile LAS unsigned* barw = (volatile LAS unsigned*)((LAS unsigned char*)lds + LDS_BARW);
    if (threadIdx.x < 4) barw[threadIdx.x] = 0u;
    if (threadIdx.x == 0) {
        LAS unsigned long long* t = (LAS unsigned long long*)((LAS unsigned char*)lds + LDS_TAB);
#pragma unroll
        for (int i = 0; i < 26; ++i) t[i] = (unsigned long long)p.in[i];
        t[26] = (unsigned long long)p.out; t[27] = (unsigned long long)p.ws;
    }
    __syncthreads();
    (void)xcd_barrier_post((unsigned*)(p.ws + WS_CTL), barw);
#if USE_CG
#define GSYNC() grid.sync()
#else
#define GSYNC() do { XcdBarrier b_; b_.bar = (unsigned*)((GAS unsigned char*)ld_tab(lds, 27) + WS_CTL); b_.x = xb_xcc_id(); b_.st = (volatile LAS unsigned*)((LAS unsigned char*)lds + LDS_BARW); xcd_barrier(b_); } while (0)
#endif
#define PH_BEGIN const KPG q = load_kp(lds); const int tid_ = fresh_tid(), lane = tid_ & 63, wave = __builtin_amdgcn_readfirstlane(tid_ >> 6); (void)lane; (void)wave; \
                 const int G = gridDim.x, c = fresh_bid(); (void)G; (void)c; LAS unsigned char* glds = (LAS unsigned char*)lds; (void)glds;

    for (int l = 0; l < DEPTH; ++l) {
        {
            PH_BEGIN
#ifndef NO_PRO
            phase_prologue(q, l, lds, wave, lane);
#endif
            phase_rmsnorm(q, l, wave, lane);
        }
        if (l == 0) grid.sync();
        GSYNC();
        {
            PH_BEGIN
            unsigned char* wl = q.ws + WS_WT + (size_t)l * LW_SIZE;
            pg8::Sched S{(const char*)(q.ws + WS_H), (const char*)(wl + LW_IN), nullptr, nullptr, 16, 0, 1024, MT / 256, INC / 256, G, c};
            pg8::EpiStoreBf16 E{(bf16_t*)(q.ws + WS_Z), INC};
#if !defined(NO_GEMM) && (!defined(ONLY_GEMM) || ONLY_GEMM == 0)
            pg8::gemm_phase(glds, S, E);
#endif
        }
        GSYNC();
        {
            PH_BEGIN
#ifndef NO_RM1
            for (int u = c; u < 128; u += G) ret_m1_unit(q, l, u, lds, wave, lane);
#endif
#ifndef NO_RS
            for (int u = c - 128; u >= 0 && u < 512; u += 128) ret_sample_unit(q, l, u, lds, wave, lane);
#endif
        }
        {
            PH_BEGIN
#ifndef NO_SM1
            for (int u = c - 128; u >= 0 && u < 256; u += 128) { const int wt = u * 8 + wave; s5_m1(q, l, wt >> 8, (wt >> 3) & 31, wt & 7, lane); }
#endif
        }
        {
            PH_BEGIN
#ifndef NO_SS
            for (int u = c - 128; u >= 0 && u < 128; u += G) { const int g = (u >> 4) * 4 + (wave & 3), bq = (u & 15) * 2 + (wave >> 2);
                s5_tile<true>(q, l, g, MP + bq * 32, bq * 4, 0, (bf16_t*)(lds + wave * 8704), lane); }
#endif
        }
        GSYNC();
        {
            PH_BEGIN
#ifndef NO_RM2
            for (int u = c; u < 512; u += G) ret_m2_unit(q, l, u, lds, wave, lane);
#endif
        }
        {
            PH_BEGIN
#ifndef NO_SM2
            for (int uu = c; uu < 2048; uu += G) { const int chunk = (uu & 31) * 2 + (wave >> 2), g = ((uu >> 5) & 7) * 4 + (wave & 3), b = uu >> 8;
                s5_tile<false>(q, l, g, b * 2048 + chunk * 32, b, chunk, (bf16_t*)(lds + wave * 8704), lane); }
#endif
        }
        GSYNC();
        {
            PH_BEGIN
            unsigned char* wl = q.ws + WS_WT + (size_t)l * LW_SIZE;
            pg8::Sched S{(const char*)(q.ws + WS_YA), (const char*)(wl + LW_GLU), nullptr, nullptr, 8, 0, 512, MT / 256, 2, G, c};
            pg8::EpiGlu E{(const bf16_t*)(q.ws + WS_YA), (bf16_t*)(q.ws + WS_YA2)};
#if !defined(NO_GEMM) && (!defined(ONLY_GEMM) || ONLY_GEMM == 1)
            pg8::gemm_phase(glds, S, E);
#endif
        }
        GSYNC();
        {
            PH_BEGIN
            unsigned char* wl = q.ws + WS_WT + (size_t)l * LW_SIZE;
            pg8::Sched S{(const char*)(q.ws + WS_YA2), (const char*)(wl + LW_SSM), (const char*)(q.ws + WS_O), (const char*)(wl + LW_RET), 8, 16, 1024, MT / 256, 4, G, c};
            pg8::EpiMix E{(const bf16_t*)(q.ws + WS_Z), (bf16_t*)(q.ws + WS_MIX)};
#if !defined(NO_GEMM) && (!defined(ONLY_GEMM) || ONLY_GEMM == 2)
            pg8::gemm_phase(glds, S, E);
#endif
        }
        GSYNC();
        {
            PH_BEGIN
            unsigned char* wl = q.ws + WS_WT + (size_t)l * LW_SIZE;
            pg8::Sched S{(const char*)(q.ws + WS_MIX), (const char*)(wl + LW_O), nullptr, nullptr, 16, 0, 1024, MT / 256, 4, G, c};
            pg8::EpiRes E{l == 0 ? q.in[0] : (const float*)(q.ws + WS_X), l == 0 ? q.in[1] : (const float*)(q.ws + WS_X) + (size_t)MP * 1024, (float*)(q.ws + WS_X)};
#if !defined(NO_GEMM) && (!defined(ONLY_GEMM) || ONLY_GEMM == 3)
            pg8::gemm_phase(glds, S, E);
#endif
        }
        GSYNC();
        { PH_BEGIN phase_rmsnorm(q, 1, wave, lane); }
        GSYNC();
        {
            PH_BEGIN
            unsigned char* wl = q.ws + WS_WT + (size_t)l * LW_SIZE;
            pg8::Sched S{(const char*)(q.ws + WS_H), (const char*)(wl + LW_UP), nullptr, nullptr, 16, 0, 1024, MT / 256, INC / 256, G, c};
            pg8::EpiUp E{(bf16_t*)(q.ws + WS_Z), q.out + O_CP + (size_t)l * 8 * 2 * INC, q.out + O_CS + (size_t)l * 128 * 2 * INC};
#if !defined(NO_GEMM) && (!defined(ONLY_GEMM) || ONLY_GEMM == 4)
            pg8::gemm_phase(glds, S, E);
#endif
        }
        GSYNC();
        {
            PH_BEGIN
#ifndef NO_CONV
            phase_convact(q, l);
#endif
        }
        GSYNC();
        {
            PH_BEGIN
            unsigned char* wl = q.ws + WS_WT + (size_t)l * LW_SIZE;
            pg8::Sched S{(const char*)(q.ws + WS_ACT), (const char*)(wl + LW_DOWN), nullptr, nullptr, 44, 0, DFF, MT / 256, 4, G, c};
            pg8::EpiRes E{(const float*)(q.ws + WS_X), (const float*)(q.ws + WS_X) + (size_t)MP * 1024, (float*)(q.ws + WS_X)};
#if !defined(NO_GEMM) && (!defined(ONLY_GEMM) || ONLY_GEMM == 5)
            pg8::gemm_phase(glds, S, E);
#endif
        }
        GSYNC();
    }
    {
        PH_BEGIN
        const float* xb = (const float*)(q.ws + WS_X); const float* gf = q.in[25];
        for (int row = c * 8 + wave; row < MT; row += G * 8) {
            const f32x4* xr = (const f32x4*)(xb + (size_t)row * 1024) + lane; const f32x4* gr = (const f32x4*)gf + lane;
            f32x4 v[4]; float s = 0.f;
#pragma unroll
            for (int j = 0; j < 4; ++j) { v[j] = xr[64 * j]; s += (v[j].x * v[j].x + v[j].y * v[j].y) + (v[j].z * v[j].z + v[j].w * v[j].w); }
            const float rstd = rsqrtf(wave_sum(s) * (1.f / 1024.f) + EPSF);
            f32x4* o = (f32x4*)(q.out + O_YP + (size_t)row * 1024) + lane;
#pragma unroll
            for (int j = 0; j < 4; ++j) o[64 * j] = v[j] * rstd * gr[64 * j];
        }
    }
#endif
}

extern "C" void kernel_launch(void* const* d_in, const int* in_sizes, int n_in, void* d_out, int out_size, void* d_ws, size_t ws_size, hipStream_t stream) {
    static int grid = 0;
    if (grid == 0) {
        if (n_in != 26 || ws_size < WS_END) { fprintf(stderr, "kernel_launch: unexpected shapes (n_in %d, ws %zu < %zu)\n", n_in, ws_size, (size_t)WS_END); grid = -1; return; }
        int dev = 0, cus = 0, per_cu = 0;
        hipGetDevice(&dev);
        hipDeviceGetAttribute(&cus, hipDeviceAttributeMultiprocessorCount, dev);
        if (hipFuncSetAttribute((const void*)fwd_kernel, hipFuncAttributeMaxDynamicSharedMemorySize, LDS_BYTES) != hipSuccess) { fprintf(stderr, "kernel_launch: hipFuncSetAttribute failed\n"); grid = -1; return; }
        hipOccupancyMaxActiveBlocksPerMultiprocessor(&per_cu, (const void*)fwd_kernel, 512, LDS_BYTES);
        (void)hipGetLastError();
        if (per_cu < 1) per_cu = 1;
        grid = cus * 1;
    }
    if (grid < 0) return;
    hipMemsetAsync((char*)d_ws + WS_CTL, 0, 65536, stream);
    KP p{};
    for (int i = 0; i < 26; ++i) p.in[i] = (const float*)d_in[i];
    p.out = (float*)d_out; p.ws = (unsigned char*)d_ws;
    void* args[] = {&p};
    hipError_t e = hipLaunchCooperativeKernel((const void*)fwd_kernel, dim3(grid), dim3(512), args, LDS_BYTES, stream);
    if (e != hipSuccess) fprintf(stderr, "cooperative launch failed: %s (grid %d)\n", hipGetErrorString(e), grid);
}
```
